# Optimizing an MI355X kernel written in HIP

```python
import math
import jax
import jax.numpy as jnp
from jax import lax
import numpy as np

D_MODEL = 4096
BATCH = 2
SEQ = 8192
DEPTH = 1

CTX_LEN = 256
GRID_W = 64
HEAD_DIM = 128
N_HEADS = 16
N_KV_HEADS = 4
GQA_GROUP = N_HEADS // N_KV_HEADS
WINDOW = 128
BLOCK = 128
ROPE_BASE = 10000.0
ROPE_PAIRS = HEAD_DIM // 4
SSM_HEAD_DIM = 64
SSM_INNER = D_MODEL // 2
SSM_HEADS = SSM_INNER // SSM_HEAD_DIM
SSM_GROUPS = 4
SSM_HEADS_PER_GROUP = SSM_HEADS // SSM_GROUPS
SSM_STATE = 128
CONV_K = 5
CHUNK = 128
ATTN_WIDTH = N_HEADS * HEAD_DIM
MIX_WIDTH = ATTN_WIDTH + SSM_INNER
KV_COLS = N_KV_HEADS * HEAD_DIM
BC_COLS = SSM_GROUPS * SSM_STATE
XBC_COLS = SSM_INNER + 2 * BC_COLS
DT_COLS = 2 * SSM_HEADS
CTX_COL0 = ATTN_WIDTH + SSM_INNER
IN_COLS = CTX_COL0 + 2 * KV_COLS + XBC_COLS + DT_COLS
D_FF = 128 * ((8 * D_MODEL // 3 + 127) // 128)
N_MOD = 9
EPS = 1e-6
NEG_INF = -1e30

kernel_name = 'hymba_swa_ssd_macaron_dit_block'


def rmsnorm(t, g):
    tf = t.astype(jnp.float32)
    return (tf * lax.rsqrt(jnp.mean(tf * tf, axis=-1, keepdims=True) + EPS) * g).astype(t.dtype)


def modulate(t, shift, scale):
    return t * (1 + scale[:, None]) + shift[:, None]


def add_residual(s, y, g_post, gate, coef):
    return s + coef * gate[:, None] * rmsnorm(y, g_post)


def adaln(cv, w_mod, b_mod):
    return (jax.nn.silu(cv) @ w_mod + b_mod).reshape(cv.shape[0], N_MOD, D_MODEL)


def swiglu(h, wg, wu, wd):
    return (jax.nn.silu(h @ wg) * (h @ wu)) @ wd


def ffn_half(s, mod, slot, g_pre, g_post, wg, wu, wd):
    h = modulate(rmsnorm(s, g_pre), mod[:, 3 * slot], mod[:, 3 * slot + 1])
    return add_residual(s, swiglu(h, wg, wu, wd), g_post, mod[:, 3 * slot + 2], 0.5)


def rope_tables(rows_count):
    row = jnp.repeat(jnp.arange(rows_count), GRID_W).astype(jnp.float32)
    col = jnp.tile(jnp.arange(GRID_W), rows_count).astype(jnp.float32)
    inv = ROPE_BASE ** (-jnp.arange(ROPE_PAIRS, dtype=jnp.float32) / ROPE_PAIRS)
    ar = row[:, None] * inv
    ac = col[:, None] * inv
    ang = jnp.concatenate([ar, ar, ac, ac], axis=-1)
    return jnp.cos(ang), jnp.sin(ang)


def apply_rope(t, cos, sin):
    tf = t.astype(jnp.float32)
    seg = tf.reshape(*tf.shape[:-1], 2, 2, ROPE_PAIRS)
    rot = jnp.concatenate([-seg[..., 1:, :], seg[..., :1, :]], axis=-2).reshape(tf.shape)
    return (tf * cos[None, :, None] + rot * sin[None, :, None]).astype(t.dtype)


def sink_softmax(scores, sink):
    m = sink
    for s in scores:
        m = jnp.maximum(m, s.max(axis=-1, keepdims=True))
    ps = [jnp.exp(s - m) for s in scores]
    denom = jnp.exp(sink - m) + sum(p.sum(axis=-1, keepdims=True) for p in ps)
    return [p / denom for p in ps]


def window_attention(q, k, v, k_ctx, v_ctx, sink):
    bsz, n = q.shape[:2]
    nb = n // BLOCK
    scale = HEAD_DIM ** -0.5
    qb = q.reshape(bsz, nb, BLOCK, N_KV_HEADS, GQA_GROUP, HEAD_DIM)

    def band(t):
        tp = jnp.pad(t, ((0, 0), (BLOCK, BLOCK), (0, 0), (0, 0)))
        tp = tp.reshape(bsz, nb + 2, BLOCK, N_KV_HEADS, HEAD_DIM)
        return jnp.concatenate([tp[:, :-2], tp[:, 1:-1], tp[:, 2:]], axis=2)

    kb, vb = band(k), band(v)
    s_band = jnp.einsum('bnqkgd,bnskd->bnkgqs', qb, kb, preferred_element_type=jnp.float32) * scale
    s_ctx = jnp.einsum('bnqkgd,bskd->bnkgqs', qb, k_ctx, preferred_element_type=jnp.float32) * scale
    qi = jnp.arange(BLOCK)[:, None]
    kj = jnp.arange(3 * BLOCK)[None, :]
    in_window = jnp.abs(kj - BLOCK - qi) <= WINDOW
    key_pos = (jnp.arange(nb)[:, None] - 1) * BLOCK + jnp.arange(3 * BLOCK)[None, :]
    in_range = (key_pos >= 0) & (key_pos < n)
    mask = in_window[None] & in_range[:, None, :]
    s_band = jnp.where(mask[None, :, None, None], s_band, NEG_INF)
    sink_l = sink.astype(jnp.float32).reshape(1, 1, N_KV_HEADS, GQA_GROUP, 1, 1)
    p_band, p_ctx = sink_softmax([s_band, s_ctx], sink_l)
    o = (jnp.einsum('bnkgqs,bnskd->bnqkgd', p_band.astype(v.dtype), vb)
         + jnp.einsum('bnkgqs,bskd->bnqkgd', p_ctx.astype(v.dtype), v_ctx))
    return o.reshape(bsz, n, ATTN_WIDTH)


def context_attention(q, k, v, sink):
    bsz, lc = q.shape[:2]
    qg = q.reshape(bsz, lc, N_KV_HEADS, GQA_GROUP, HEAD_DIM)
    s = jnp.einsum('bqkgd,bskd->bkgqs', qg, k, preferred_element_type=jnp.float32) * HEAD_DIM ** -0.5
    (p,) = sink_softmax([s], sink.astype(jnp.float32).reshape(1, N_KV_HEADS, GQA_GROUP, 1, 1))
    o = jnp.einsum('bkgqs,bskd->bqkgd', p.astype(v.dtype), v)
    return o.reshape(bsz, lc, ATTN_WIDTH)


def depthwise_conv(u, w, b):
    out = lax.conv_general_dilated(
        u, w[:, None, :].astype(u.dtype), window_strides=(1,),
        padding=[(CONV_K // 2, CONV_K // 2)], dimension_numbers=('NWC', 'WIO', 'NWC'),
        feature_group_count=u.shape[-1])
    return out + b


def split_tail(p):
    bsz, L = p.shape[:2]
    k = p[..., :KV_COLS].reshape(bsz, L, N_KV_HEADS, HEAD_DIM)
    v = p[..., KV_COLS:2 * KV_COLS].reshape(bsz, L, N_KV_HEADS, HEAD_DIM)
    xbc = p[..., 2 * KV_COLS:2 * KV_COLS + XBC_COLS]
    dt_raw = p[..., 2 * KV_COLS + XBC_COLS:]
    return k, v, xbc, dt_raw


def split_ssm(xbc, dt_raw, dt_bias):
    bsz, L = xbc.shape[:2]
    xs = xbc[..., :SSM_INNER].reshape(bsz, L, SSM_GROUPS, SSM_HEADS_PER_GROUP, SSM_HEAD_DIM)
    bs = xbc[..., SSM_INNER:SSM_INNER + BC_COLS].reshape(bsz, L, SSM_GROUPS, SSM_STATE)
    cs = xbc[..., SSM_INNER + BC_COLS:].reshape(bsz, L, SSM_GROUPS, SSM_STATE)
    dt = jax.nn.softplus(
        dt_raw.astype(jnp.float32).reshape(bsz, L, 2, SSM_GROUPS, SSM_HEADS_PER_GROUP)
        + dt_bias.astype(jnp.float32).reshape(2, SSM_GROUPS, SSM_HEADS_PER_GROUP))
    return xs, bs, cs, dt[:, :, 0], dt[:, :, 1]


def ssd_scan(xs, dt, a_log, bs, cs, h0, with_y):
    bsz, n = xs.shape[:2]
    nc = n // CHUNK
    a = -jnp.exp(a_log.astype(jnp.float32))
    acs = jnp.cumsum((dt * a).reshape(bsz, nc, CHUNK, SSM_GROUPS, SSM_HEADS_PER_GROUP), axis=2)
    a_tot = acs[:, :, -1]
    xdt = (xs.astype(jnp.float32) * dt[..., None]).reshape(
        bsz, nc, CHUNK, SSM_GROUPS, SSM_HEADS_PER_GROUP, SSM_HEAD_DIM)
    bch = bs.astype(jnp.float32).reshape(bsz, nc, CHUNK, SSM_GROUPS, SSM_STATE)
    states = jnp.einsum('bcqgn,bcqgr,bcqgrp->bcgrpn', bch, jnp.exp(a_tot[:, :, None] - acs), xdt)

    def step(h, inp):
        decay, st = inp
        return decay[..., None, None] * h + st, (h if with_y else None)

    h_final, h_prev = lax.scan(step, h0, (jnp.moveaxis(jnp.exp(a_tot), 1, 0), jnp.moveaxis(states, 1, 0)))
    if not with_y:
        return None, h_final
    h_prev = jnp.moveaxis(h_prev, 0, 1)
    cch = cs.astype(jnp.float32).reshape(bsz, nc, CHUNK, SSM_GROUPS, SSM_STATE)
    y_off = jnp.einsum('bcqgn,bcgrpn->bcqgrp', cch, h_prev) * jnp.exp(acs)[..., None]
    tril = jnp.tril(jnp.ones((CHUNK, CHUNK), dtype=bool))
    seg = acs[:, :, :, None] - acs[:, :, None]
    decay_ij = jnp.exp(jnp.where(tril[:, :, None, None], seg, -jnp.inf))
    cb = jnp.einsum('bcign,bcjgn->bcijg', cch, bch)
    y_diag = jnp.einsum('bcijgr,bcjgrp->bcigrp', cb[..., None] * decay_ij, xdt)
    return (y_diag + y_off).reshape(bsz, n, SSM_GROUPS, SSM_HEADS_PER_GROUP, SSM_HEAD_DIM), h_final


def flip(t):
    return jnp.flip(t, axis=1)


def bidirectional_ssd(lat, ctx, a_log, d_skip, with_ctx_y):
    xs, bs, cs, dtf, dtb = lat
    xc, bc, cc, dtcf, dtcb = ctx
    bsz = xs.shape[0]
    h0 = jnp.zeros((bsz, SSM_GROUPS, SSM_HEADS_PER_GROUP, SSM_HEAD_DIM, SSM_STATE), jnp.float32)
    a_f = a_log[0].reshape(SSM_GROUPS, SSM_HEADS_PER_GROUP)
    a_b = a_log[1].reshape(SSM_GROUPS, SSM_HEADS_PER_GROUP)
    yc_f, hc_f = ssd_scan(xc, dtcf, a_f, bc, cc, h0, with_ctx_y)
    yc_b, hc_b = ssd_scan(flip(xc), flip(dtcb), a_b, flip(bc), flip(cc), h0, with_ctx_y)
    y_f, _ = ssd_scan(xs, dtf, a_f, bs, cs, hc_f, True)
    y_b, _ = ssd_scan(flip(xs), flip(dtb), a_b, flip(bs), flip(cs), hc_b, True)
    d = d_skip.astype(jnp.float32).reshape(SSM_GROUPS, SSM_HEADS_PER_GROUP, 1)
    y_lat = (y_f + flip(y_b) + d * xs).reshape(bsz, xs.shape[1], SSM_INNER)
    if not with_ctx_y:
        return y_lat, None
    y_ctx = (yc_f + flip(yc_b) + d * xc).reshape(bsz, xc.shape[1], SSM_INNER)
    return y_lat, y_ctx


def merge_groups(attn, y_ssm, z, attn_norm, ssm_norm, w_out):
    a = rmsnorm(attn, attn_norm)
    s = rmsnorm(y_ssm.astype(z.dtype) * jax.nn.silu(z), ssm_norm)
    return jnp.concatenate([a, s], axis=-1) @ w_out


def hybrid_mix(h_lat, h_ctx, cos, sin, w_in, sink, attn_norm, conv_w, conv_b, a_log, dt_bias,
               d_skip, ssm_norm, w_out, with_ctx_out):
    bsz, n = h_lat.shape[:2]
    lc = h_ctx.shape[1]
    p = h_lat @ w_in
    q = apply_rope(p[..., :ATTN_WIDTH].reshape(bsz, n, N_HEADS, HEAD_DIM), cos, sin)
    z = p[..., ATTN_WIDTH:CTX_COL0]
    k, v, xbc, dt_raw = split_tail(p[..., CTX_COL0:])
    k = apply_rope(k, cos, sin)
    kc, vc, xbcc, dtc = split_tail(h_ctx @ w_in[:, CTX_COL0:])
    attn = window_attention(q, k, v, kc, vc, sink)
    lat_ssm = split_ssm(jax.nn.silu(depthwise_conv(xbc, conv_w, conv_b)), dt_raw, dt_bias)
    ctx_ssm = split_ssm(jax.nn.silu(depthwise_conv(xbcc, conv_w, conv_b)), dtc, dt_bias)
    y_lat, y_ctx = bidirectional_ssd(lat_ssm, ctx_ssm, a_log, d_skip, with_ctx_out)
    out_lat = merge_groups(attn, y_lat, z, attn_norm, ssm_norm, w_out)
    if not with_ctx_out:
        return out_lat, None
    pc_head = h_ctx @ w_in[:, :CTX_COL0]
    qc = pc_head[..., :ATTN_WIDTH].reshape(bsz, lc, N_HEADS, HEAD_DIM)
    attn_c = context_attention(qc, kc, vc, sink)
    out_ctx = merge_groups(attn_c, y_ctx, pc_head[..., ATTN_WIDTH:], attn_norm, ssm_norm, w_out)
    return out_lat, out_ctx


def setup_inputs(seed: int = 0) -> dict:
    key = jax.random.key(seed)
    ks = jax.random.split(key, 21)
    f32 = jnp.float32

    def normal(k, shape, scale):
        return jax.random.normal(k, shape, f32) * scale

    dt0 = jnp.exp(jax.random.uniform(ks[17], (DEPTH, 2, SSM_HEADS), f32, math.log(1e-3), math.log(1e-1)))
    return {
        'x': normal(ks[0], (BATCH, SEQ, D_MODEL), 1.0),
        'c': normal(ks[1], (BATCH, D_MODEL), 1.0),
        'ctx': normal(ks[2], (BATCH, CTX_LEN, D_MODEL), 1.0),
        'c_ctx': normal(ks[3], (D_MODEL,), 1.0),
        'w_mod': normal(ks[4], (DEPTH, D_MODEL, N_MOD * D_MODEL), 0.5 * D_MODEL ** -0.5),
        'b_mod': normal(ks[5], (DEPTH, N_MOD * D_MODEL), 0.02),
        'norm_pre': 1.0 + normal(ks[6], (DEPTH, 3, D_MODEL), 0.1),
        'norm_post': 1.0 + normal(ks[7], (DEPTH, 3, D_MODEL), 0.1),
        'w_ffn_gate': normal(ks[8], (DEPTH, 2, D_MODEL, D_FF), D_MODEL ** -0.5),
        'w_ffn_up': normal(ks[9], (DEPTH, 2, D_MODEL, D_FF), D_MODEL ** -0.5),
        'w_ffn_down': normal(ks[10], (DEPTH, 2, D_FF, D_MODEL), D_FF ** -0.5),
        'w_in': normal(ks[11], (DEPTH, D_MODEL, IN_COLS), D_MODEL ** -0.5),
        'attn_sink': normal(ks[12], (DEPTH, N_HEADS), 1.0),
        'attn_norm': 1.0 + normal(ks[13], (DEPTH, ATTN_WIDTH), 0.1),
        'conv_w': normal(ks[14], (DEPTH, CONV_K, XBC_COLS), CONV_K ** -0.5),
        'conv_b': normal(ks[15], (DEPTH, XBC_COLS), 0.02),
        'a_log': jnp.log(jax.random.uniform(ks[16], (DEPTH, 2, SSM_HEADS), f32, 1.0, 16.0)),
        'dt_bias': dt0 + jnp.log(-jnp.expm1(-dt0)),
        'd_skip': 1.0 + normal(ks[18], (DEPTH, SSM_HEADS), 0.1),
        'ssm_norm': 1.0 + normal(ks[19], (DEPTH, SSM_INNER), 0.1),
        'w_out': normal(ks[20], (DEPTH, MIX_WIDTH, D_MODEL), MIX_WIDTH ** -0.5),
    }


def reference(x, c, ctx, c_ctx, w_mod, b_mod, norm_pre, norm_post, w_ffn_gate, w_ffn_up, w_ffn_down,
              w_in, attn_sink, attn_norm, conv_w, conv_b, a_log, dt_bias, d_skip, ssm_norm, w_out):
    ROWS = x.shape[1] // GRID_W
    cos, sin = rope_tables(ROWS)
    for layer in range(DEPTH):
        last = layer == DEPTH - 1
        mod_x = adaln(c, w_mod[layer], b_mod[layer])
        mod_c = adaln(c_ctx[None], w_mod[layer], b_mod[layer])
        ffn0 = (norm_pre[layer, 0], norm_post[layer, 0], w_ffn_gate[layer, 0], w_ffn_up[layer, 0], w_ffn_down[layer, 0])
        x = ffn_half(x, mod_x, 0, *ffn0)
        ctx = ffn_half(ctx, mod_c, 0, *ffn0)
        hx = modulate(rmsnorm(x, norm_pre[layer, 1]), mod_x[:, 3], mod_x[:, 4])
        hc = modulate(rmsnorm(ctx, norm_pre[layer, 1]), mod_c[:, 3], mod_c[:, 4])
        y_x, y_c = hybrid_mix(hx, hc, cos, sin, w_in[layer], attn_sink[layer], attn_norm[layer],
                              conv_w[layer], conv_b[layer], a_log[layer], dt_bias[layer], d_skip[layer],
                              ssm_norm[layer], w_out[layer], not last)
        x = add_residual(x, y_x, norm_post[layer, 1], mod_x[:, 5], 1.0)
        ffn1 = (norm_pre[layer, 2], norm_post[layer, 2], w_ffn_gate[layer, 1], w_ffn_up[layer, 1], w_ffn_down[layer, 1])
        x = ffn_half(x, mod_x, 2, *ffn1)
        if not last:
            ctx = add_residual(ctx, y_c, norm_post[layer, 1], mod_c[:, 5], 1.0)
            ctx = ffn_half(ctx, mod_c, 2, *ffn1)
    return x
```

```cpp
#define MK_PER_PHASE 0
#define PROBE_MASK 0
#define PROBE_P0T 1
#include <hip/hip_runtime.h>
#include <cstdio>
#include <cstdint>
namespace pg8 {
#define PG8_LAS __attribute__((address_space(3)))
typedef unsigned short bf16_t;
typedef short bf16x8 __attribute__((ext_vector_type(8)));
typedef float f32x4 __attribute__((ext_vector_type(4)));
typedef unsigned u32x4 __attribute__((ext_vector_type(4)));
constexpr int BM = 256, BK = 64, HALF = 128, HTB = HALF * BK * 2  , STAGE_BYTES = 8 * HTB, NXCD = 8, WGM = 4;

__host__ __device__ __forceinline__ int lds_byte(int r, int c) { const int st = (r >> 4) * 2 + (c >> 5), rr = r & 15, cc = c & 31, ob = rr * 64 + cc * 2; return st * 1024 + (ob ^ (((ob >> 9) & 1) << 5)); }
__host__ __device__ __forceinline__ void stage_rc(int b, int& R, int& C) { const int st = b / 1024, sb = b % 1024, swz = sb ^ (((sb >> 9) & 1) << 5); R = (st >> 1) * 16 + swz / 64; C = (st & 1) * 32 + (swz % 64) / 2; }
__host__ __device__ __forceinline__ int perm32(int rho) { const int n = rho >> 4, i = rho & 15; return 8 * (i >> 2) + 4 * n + (i & 3); }

struct Unit { int pm, pn, koff, nt, aux; };
struct Gemm { const bf16_t* A; const bf16_t* Bt; int M, N, K; };

struct StaticOrder {
    int nM, nN, nwg, G, c, nt, wgm;
    __host__ __device__ void init(int M, int N, int K, int G_, int c_, int wgm_ = WGM) { nM = M / BM; nN = N / BM; nwg = nM * nN; G = G_; c = c_; nt = K / BK; wgm = wgm_; }
    __host__ __device__ __forceinline__ bool next(int i, Unit& u) const {
        const long L = (long)i * G + c; if (L >= nwg) return false;
        int wgid = (int)L; { const int q = nwg / NXCD, r = nwg % NXCD, xcd = wgid % NXCD, off = wgid / NXCD; wgid = (xcd < r ? xcd * (q + 1) : r * (q + 1) + (xcd - r) * q) + off; }
        const int nig = wgm * nN, gid = wgid / nig, fm = gid * wgm, gsz = (nM - fm) < wgm ? (nM - fm) : wgm;
        u.pm = fm + ((wgid % nig) % gsz); u.pn = (wgid % nig) / gsz; u.koff = 0; u.nt = nt; u.aux = 0; return true;
    }
    __device__ __forceinline__ void a_ready(const Unit&) const {}
    __device__ __forceinline__ void done(const Unit&) const {}
};

__device__ __forceinline__ unsigned cvt_pk_bf16(float lo, float hi) { unsigned r; asm volatile("v_cvt_pk_bf16_f32 %0, %1, %2" : "=v"(r) : "v"(lo), "v"(hi)); return r; }
typedef float f32x2_t __attribute__((ext_vector_type(2))); typedef __bf16 bf16x2_t __attribute__((ext_vector_type(2)));
__device__ __forceinline__ unsigned pk_bf16(float lo, float hi) { const f32x2_t v = {lo, hi}; const bf16x2_t b = __builtin_convertvector(v, bf16x2_t); return __builtin_bit_cast(unsigned, b); }
#ifndef AQ_DROP
#define AQ_DROP 2
#endif
__device__ __forceinline__ float aquant(float v) {
    if (AQ_DROP == 0) return v;
    unsigned u = __builtin_bit_cast(unsigned, v); constexpr unsigned sh = 16 + AQ_DROP, half = (1u << (sh - 1)) - 1u;
    u = (u + half + ((u >> sh) & 1u)) & ~((1u << sh) - 1u); return __builtin_bit_cast(float, u);
}
__device__ __forceinline__ unsigned pk_bf16q(float lo, float hi) {
    if (AQ_DROP == 0) return pk_bf16(lo, hi);
    {
#pragma clang fp contract(off)
        const f32x2_t v = {lo, hi}; constexpr float K = (float)((1u << (16 + AQ_DROP)) + 1u);
        const f32x2_t c = v * K; const f32x2_t d = c - v; const f32x2_t h = c - d;
        return __builtin_bit_cast(unsigned, __builtin_convertvector(h, bf16x2_t));
    }
}
typedef _Float16 f16x2_t __attribute__((ext_vector_type(2)));
__device__ __forceinline__ unsigned pk_f16(float lo, float hi) { const f32x2_t v = {lo, hi}; return __builtin_bit_cast(unsigned, __builtin_convertvector(v, f16x2_t)); }
__device__ __forceinline__ float silu_f(float g) { return g * __builtin_amdgcn_rcpf(1.0f + __builtin_amdgcn_exp2f(-1.4426950408889634f * g)); }
template <bool S8>
__device__ __forceinline__ f32x2_t swiglu2(f32x2_t g, f32x2_t u) {
    const f32x2_t t = g * -1.4426950408889634f;
    const f32x2_t e = {__builtin_amdgcn_exp2f(t.x), __builtin_amdgcn_exp2f(t.y)};
    const f32x2_t d = S8 ? e * 0.125f + 0.125f : e + 1.0f;
    const f32x2_t r = {__builtin_amdgcn_rcpf(d.x), __builtin_amdgcn_rcpf(d.y)};
    return (g * u) * r;
}
__device__ __forceinline__ float softplus_f(float x) { return x > 20.f ? x : log1pf(__expf(x)); }

struct EpiPlain {
    static constexpr bool PERM = true, AFTER_DRAIN = false;
    bf16_t* O; int ldc;
    __device__ __forceinline__ void operator()(const f32x4 (&acc)[2][2][4][2], const Unit& u, int wr, int wc, int fr, int fq) const {
        const int row0 = u.pm * BM + wr * 64 + fr, col0 = u.pn * BM + wc * 32 + 8 * fq;
#pragma unroll
        for (int ai = 0; ai < 2; ++ai)
#pragma unroll
            for (int m = 0; m < 4; ++m) { bf16_t* rowp = O + (size_t)(row0 + ai * HALF + m * 16) * ldc + col0;
#pragma unroll
                for (int bj = 0; bj < 2; ++bj) { const f32x4 v0 = acc[ai][bj][m][0], v1 = acc[ai][bj][m][1];
                    u32x4 w; w.x = pk_f16(v0[0], v0[1]); w.y = pk_f16(v0[2], v0[3]); w.z = pk_f16(v1[0], v1[1]); w.w = pk_f16(v1[2], v1[3]);
                    *(u32x4*)(rowp + bj * HALF) = w; } }
    }
};
struct EpiSwiGLU {
    static constexpr bool PERM = true, AFTER_DRAIN = false;
    bf16_t* O; int ldc;
    __device__ __forceinline__ void operator()(const f32x4 (&acc)[2][2][4][2], const Unit& u, int wr, int wc, int fr, int fq) const {
        const int row0 = u.pm * BM + wr * 64 + fr, col0 = u.pn * HALF + wc * 32 + 8 * fq;
#pragma unroll
        for (int ai = 0; ai < 2; ++ai)
#pragma unroll
            for (int m = 0; m < 4; ++m) { bf16_t* rowp = O + (size_t)(row0 + ai * HALF + m * 16) * ldc + col0;
                const f32x4 g0 = acc[ai][0][m][0], g1 = acc[ai][0][m][1], u0 = acc[ai][1][m][0], u1 = acc[ai][1][m][1];
                u32x4 w;
                { const f32x2_t a = swiglu2<false>((f32x2_t){g0[0], g0[1]}, (f32x2_t){u0[0], u0[1]}), b = swiglu2<false>((f32x2_t){g0[2], g0[3]}, (f32x2_t){u0[2], u0[3]}),
                                c = swiglu2<false>((f32x2_t){g1[0], g1[1]}, (f32x2_t){u1[0], u1[1]}), d = swiglu2<false>((f32x2_t){g1[2], g1[3]}, (f32x2_t){u1[2], u1[3]});
                  w.x = pk_bf16q(a.x, a.y); w.y = pk_bf16q(b.x, b.y); w.z = pk_bf16q(c.x, c.y); w.w = pk_bf16q(d.x, d.y); }
                __builtin_nontemporal_store(w, (u32x4*)rowp); }
    }
};
struct EpiInProj {
    static constexpr bool PERM = true, AFTER_DRAIN = false;
    bf16_t* P; int ldc; float* dtf; float* dtb; const float* rcos; const float* rsin; const float* dt_bias; float qscale;
    __device__ __forceinline__ void operator()(const f32x4 (&acc)[2][2][4][2], const Unit& u, int wr, int wc, int fr, int fq) const {
        const int row0 = u.pm * BM + wr * 64 + fr;
        if (u.pn == 32) {
            if (wc < 2) {
                float* dst = (wc == 0) ? dtf : dtb; const float* bp = dt_bias + wc * 32 + 8 * fq;
                const f32x4 b0 = *(const f32x4*)bp, b1 = *(const f32x4*)(bp + 4);
#pragma unroll
                for (int ai = 0; ai < 2; ++ai)
#pragma unroll
                    for (int m = 0; m < 4; ++m) { float* rowp = dst + (size_t)(row0 + ai * HALF + m * 16) * 32 + 8 * fq;
                        f32x4 v0 = acc[ai][0][m][0] + b0, v1 = acc[ai][0][m][1] + b1;
#pragma unroll
                        for (int j = 0; j < 4; ++j) { v0[j] = softplus_f(v0[j]); v1[j] = softplus_f(v1[j]); }
                        *(f32x4*)rowp = v0; *(f32x4*)(rowp + 4) = v1; }
            }
            return;
        }
        const int col0 = u.pn * BM + wc * 32 + 8 * fq;
        const bool rope = (u.pn < 8) || (u.pn == 16) || (u.pn == 17);
        if (!rope) {
#pragma unroll
            for (int ai = 0; ai < 2; ++ai)
#pragma unroll
                for (int m = 0; m < 4; ++m) { bf16_t* rowp = P + (size_t)(row0 + ai * HALF + m * 16) * ldc + col0;
#pragma unroll
                    for (int bj = 0; bj < 2; ++bj) { const f32x4 v0 = acc[ai][bj][m][0], v1 = acc[ai][bj][m][1];
                        u32x4 w; w.x = pk_bf16(v0[0], v0[1]); w.y = pk_bf16(v0[2], v0[3]); w.z = pk_bf16(v1[0], v1[1]); w.w = pk_bf16(v1[2], v1[3]);
                        *(u32x4*)(rowp + bj * HALF) = w; } }
        } else {
            const float sc = (u.pn < 8) ? qscale : 1.0f;
            const bool lat = u.pm < 64;
            const int axis = wc >> 1, ioff = 16 * (wc & 1) + 4 * fq;
#pragma unroll
            for (int ai = 0; ai < 2; ++ai)
#pragma unroll
                for (int m = 0; m < 4; ++m) { const int row = row0 + ai * HALF + m * 16; bf16_t* rowp = P + (size_t)row * ldc + col0;
                    f32x4 cs = (f32x4){1.f, 1.f, 1.f, 1.f}, sn = (f32x4){0.f, 0.f, 0.f, 0.f};
                    if (lat) { const int t = row & 8191, pos = axis ? (t & 63) : (t >> 6); cs = *(const f32x4*)(rcos + pos * 32 + ioff); sn = *(const f32x4*)(rsin + pos * 32 + ioff); }
#pragma unroll
                    for (int bj = 0; bj < 2; ++bj) { const f32x4 x1 = acc[ai][bj][m][0], x2 = acc[ai][bj][m][1];
                        const f32x4 o1 = (x1 * cs - x2 * sn) * sc, o2 = (x2 * cs + x1 * sn) * sc;
                        u32x4 w; w.x = pk_bf16(o1[0], o1[1]); w.y = pk_bf16(o1[2], o1[3]); w.z = pk_bf16(o2[0], o2[1]); w.w = pk_bf16(o2[2], o2[3]);
                        *(u32x4*)(rowp + bj * HALF) = w; } }
        }
    }
};
struct InProjOrder {
    StaticOrder lat; int G, c;
    __host__ __device__ void init(int G_, int c_) { lat.init(16384, 8448, 4096, G_, c_); G = G_; c = c_; }
    __host__ __device__ __forceinline__ bool next(int i, Unit& u) const {
        const long L = (long)i * G + c;
        if (L < lat.nwg) return lat.next(i, u);
        const int k = (int)(L - lat.nwg); if (k >= 34) return false;
        u.pm = 64 + (k & 1); u.pn = 16 + (k >> 1); u.koff = 0; u.nt = lat.nt; u.aux = 0; return true;
    }
    __device__ __forceinline__ void a_ready(const Unit&) const {}
    __device__ __forceinline__ void done(const Unit&) const {}
};


struct CtxSplitOrder {
    int G, c;
    __host__ __device__ void init(int G_, int c_) { G = G_; c = c_; }
    __host__ __device__ __forceinline__ bool next(int i, Unit& u) const {
        const long L = (long)i * G + c; if (L >= 256) return false;
        const int k = (int)L, s = k >> 5;
        u.pm = 64 + (k & 1); u.pn = (k >> 1) & 15; u.aux = s; u.nt = (s < 6) ? 22 : 20; u.koff = 64 * ((s < 6) ? 22 * s : 132 + 20 * (s - 6)); return true;
    }
    __device__ __forceinline__ void a_ready(const Unit&) const {}
    __device__ __forceinline__ void done(const Unit&) const {}
};
struct EpiSplitF32 {
    static constexpr bool PERM = true, AFTER_DRAIN = false;
    float* YP; int ldc;
    __device__ __forceinline__ void operator()(const f32x4 (&acc)[2][2][4][2], const Unit& u, int wr, int wc, int fr, int fq) const {
        float* base = YP + (size_t)u.aux * 512 * ldc + (size_t)((u.pm - 64) * BM + wr * 64 + fr) * ldc + u.pn * BM + wc * 32 + 8 * fq;
#pragma unroll
        for (int ai = 0; ai < 2; ++ai)
#pragma unroll
            for (int m = 0; m < 4; ++m) { float* rowp = base + (size_t)(ai * HALF + m * 16) * ldc;
#pragma unroll
                for (int bj = 0; bj < 2; ++bj) { *(f32x4*)(rowp + bj * HALF) = acc[ai][bj][m][0]; *(f32x4*)(rowp + bj * HALF + 4) = acc[ai][bj][m][1]; } }
    }
};

__device__ __forceinline__ float clamp448(float v) { return __builtin_amdgcn_fmed3f(v, -448.f, 448.f); }
__device__ __forceinline__ unsigned pk4_fp8(float a, float b, float c, float d) { int p = __builtin_amdgcn_cvt_pk_fp8_f32(clamp448(a), clamp448(b), 0, false); p = __builtin_amdgcn_cvt_pk_fp8_f32(clamp448(c), clamp448(d), p, true); return (unsigned)p; }
struct EpiSwiGLU8 {
    static constexpr bool PERM = true, AFTER_DRAIN = false;
    unsigned char* O; int ldc;
    __device__ __forceinline__ void operator()(const f32x4 (&acc)[2][2][4][2], const Unit& u, int wr, int wc, int fr, int fq) const {
        const int row0 = u.pm * BM + wr * 64 + fr, col0 = u.pn * HALF + wc * 32 + 8 * fq;
#pragma unroll
        for (int ai = 0; ai < 2; ++ai)
#pragma unroll
            for (int m = 0; m < 4; ++m) { unsigned char* rowp = O + (size_t)(row0 + ai * HALF + m * 16) * ldc + col0;
                const f32x4 g0 = acc[ai][0][m][0], g1 = acc[ai][0][m][1], u0 = acc[ai][1][m][0], u1 = acc[ai][1][m][1];
                const f32x2_t a = swiglu2<true>((f32x2_t){g0[0], g0[1]}, (f32x2_t){u0[0], u0[1]}), b = swiglu2<true>((f32x2_t){g0[2], g0[3]}, (f32x2_t){u0[2], u0[3]}),
                              c = swiglu2<true>((f32x2_t){g1[0], g1[1]}, (f32x2_t){u1[0], u1[1]}), d = swiglu2<true>((f32x2_t){g1[2], g1[3]}, (f32x2_t){u1[2], u1[3]});
                typedef unsigned u32x2_t __attribute__((ext_vector_type(2)));
                u32x2_t w; w.x = pk4_fp8(a.x, a.y, b.x, b.y); w.y = pk4_fp8(c.x, c.y, d.x, d.y);
                *(u32x2_t*)rowp = w; }
    }
};
struct EpiPlainS {
    static constexpr bool PERM = true, AFTER_DRAIN = false;
    bf16_t* O; int ldc; float scale;
    __device__ __forceinline__ void operator()(const f32x4 (&acc)[2][2][4][2], const Unit& u, int wr, int wc, int fr, int fq) const {
        const int row0 = u.pm * BM + wr * 64 + fr, col0 = u.pn * BM + wc * 32 + 8 * fq;
#pragma unroll
        for (int ai = 0; ai < 2; ++ai)
#pragma unroll
            for (int m = 0; m < 4; ++m) { bf16_t* rowp = O + (size_t)(row0 + ai * HALF + m * 16) * ldc + col0;
#pragma unroll
                for (int bj = 0; bj < 2; ++bj) { const f32x4 v0 = acc[ai][bj][m][0] * scale, v1 = acc[ai][bj][m][1] * scale;
                    u32x4 w; w.x = pk_f16(v0[0], v0[1]); w.y = pk_f16(v0[2], v0[3]); w.z = pk_f16(v1[0], v1[1]); w.w = pk_f16(v1[2], v1[3]);
                    *(u32x4*)(rowp + bj * HALF) = w; } }
    }
};

struct EpiOutProj {
    static constexpr bool PERM = true, AFTER_DRAIN = false;
    bf16_t* O; int ldc; const PG8_LAS float* qt;
    __device__ __forceinline__ float keep_factor(const Unit& u, int ai, int m, int wr, int fr) const {
        const float s = qt[(u.aux & 3) * 256 + ai * HALF + wr * 64 + m * 16 + fr]; return (u.aux & 0x100) ? s : 0.0f;
    }
    __device__ __forceinline__ void operator()(const f32x4 (&acc_)[2][2][4][2], const Unit& u, int wr, int wc, int fr, int fq) const {
        if (u.aux & 0x100) return;
        const int row0 = u.pm * BM + wr * 64 + fr, col0 = u.pn * BM + wc * 32 + 8 * fq;
#pragma unroll
        for (int ai = 0; ai < 2; ++ai)
#pragma unroll
            for (int m = 0; m < 4; ++m) { bf16_t* rowp = O + (size_t)(row0 + ai * HALF + m * 16) * ldc + col0;
#pragma unroll
                for (int bj = 0; bj < 2; ++bj) { const f32x4 v0 = acc_[ai][bj][m][0], v1 = acc_[ai][bj][m][1];
                    u32x4 w; w.x = pk_f16(v0[0], v0[1]); w.y = pk_f16(v0[2], v0[3]); w.z = pk_f16(v1[0], v1[1]); w.w = pk_f16(v1[2], v1[3]);
                    *(u32x4*)(rowp + bj * HALF) = w; } }
    }
};
struct OutProjOrder {
    StaticOrder t;
    __host__ __device__ void init(int G_, int c_) { t.init(16384, 4096, 4096, G_, c_); }
    __host__ __device__ __forceinline__ bool next(int i, Unit& u) const {
        if (!t.next(i >> 1, u)) return false;
        u.nt = 32; u.koff = (i & 1) * 2048; u.aux = (i & 1) ? 0 : (0x100 | ((i >> 1) & 3)); return true;
    }
    __device__ __forceinline__ void a_ready(const Unit&) const {}
    __device__ __forceinline__ void done(const Unit&) const {}
};

struct HalfNOrder {
    StaticOrder h; int G, c, nh;
    __host__ __device__ void init(int M, int G_, int c_) { h.init(M, 43 * 256, 4096, G_, c_); G = G_; c = c_; nh = h.nwg; }
    __host__ __device__ __forceinline__ bool next(int i, Unit& u) const {
        const long L = (long)i * G + c; if (L >= 2L * nh) return false;
        const int half = L >= nh, l = (int)(L - (half ? nh : 0));
        StaticOrder t = h; t.c = l % G; if (!t.next(l / G, u)) return false;
        u.pn += 43 * half; return true;
    }
    __device__ __forceinline__ void a_ready(const Unit&) const {}
    __device__ __forceinline__ void done(const Unit&) const {}
};
typedef int v8i_t __attribute__((ext_vector_type(8))); typedef int v4i_t __attribute__((ext_vector_type(4)));
__device__ __forceinline__ v8i_t cat8(bf16x8 a, bf16x8 b) { return __builtin_shufflevector(__builtin_bit_cast(v4i_t, a), __builtin_bit_cast(v4i_t, b), 0, 1, 2, 3, 4, 5, 6, 7); }
template <class Epi, class Sched, bool ALIGN_EPI = false, bool SP2 = false, bool FP8 = false, bool KEEP = false>
__device__ __forceinline__ void gemm_phase(PG8_LAS unsigned char* lds, const Gemm g, const Sched& S, const Epi& E) {
    const int tid = threadIdx.x, wid = __builtin_amdgcn_readfirstlane(tid >> 6), lane = tid & 63, wr = wid >> 2, wc = wid & 3, fr = lane & 15, fq = lane >> 4;
    const int K = g.K;
    unsigned voffA[2], voffB[2];
#pragma unroll
    for (int i = 0; i < 2; ++i) { int R, C; stage_rc(tid * 16 + i * 8192, R, C); const int Rb = Epi::PERM ? ((R & ~31) + perm32(R & 31)) : R;
        voffA[i] = (unsigned)(R * K + C) * 2u; voffB[i] = (unsigned)(Rb * K + C) * 2u; }
    const size_t kstep = (size_t)(BK * 2);
    const size_t hstep = (size_t)HALF * K * 2;
    const size_t tstep = 2 * hstep;
    const unsigned ldsw = (unsigned)wid * 1024u;
    const int aoff = lds_byte(wr * 64 + fr, fq * 8), boff = lds_byte(wc * 32 + fr, fq * 8);
#define PG8_SA(b, h) (((b) * 2 + (h)) * HTB)
#define PG8_SB(b, h) ((4 + (b) * 2 + (h)) * HTB)
#define PG8_STAGE(bufoff, gbase, voff) do { _Pragma("unroll") for (int _i = 0; _i < 2; ++_i) \
        __builtin_amdgcn_global_load_lds((const unsigned*)((const char*)(gbase) + (voff)[_i]), (PG8_LAS unsigned*)(lds + (bufoff) + ldsw + _i * 8192), 16, 0, 0); } while (0)
#define PG8_LDA(dst, b, h) do { _Pragma("unroll") for (int m = 0; m < 4; ++m) { if constexpr (FP8) dst##8[m] = cat8(*(const PG8_LAS bf16x8*)(lds + PG8_SA(b, h) + aoff + m * 2048), *(const PG8_LAS bf16x8*)(lds + PG8_SA(b, h) + aoff + m * 2048 + 1024)); \
        else { _Pragma("unroll") for (int k = 0; k < 2; ++k) dst[m][k] = *(const PG8_LAS bf16x8*)(lds + PG8_SA(b, h) + aoff + m * 2048 + k * 1024); } } } while (0)
#define PG8_LDB(dst, b, h) do { _Pragma("unroll") for (int n = 0; n < 2; ++n) { if constexpr (FP8) dst##8[n] = cat8(*(const PG8_LAS bf16x8*)(lds + PG8_SB(b, h) + boff + n * 2048), *(const PG8_LAS bf16x8*)(lds + PG8_SB(b, h) + boff + n * 2048 + 1024)); \
        else { _Pragma("unroll") for (int k = 0; k < 2; ++k) dst[n][k] = *(const PG8_LAS bf16x8*)(lds + PG8_SB(b, h) + boff + n * 2048 + k * 1024); } } } while (0)
#ifndef PG8_BSTAT
#define PG8_BSTAT 0
#endif
#define PG8_MMA(ai, bj, At, Bt) do { __builtin_amdgcn_s_setprio(1); \
        if constexpr (FP8) { _Pragma("unroll") for (int m = 0; m < 4; ++m) _Pragma("unroll") for (int n = 0; n < 2; ++n) asm volatile("v_mfma_f32_16x16x128_f8f6f4 %0, %1, %2, %0" : "+v"(acc[ai][bj][m][n]) : "v"(Bt##8[n]), "v"(At##8[m])); } \
        else if (PG8_BSTAT) { _Pragma("unroll") for (int k = 0; k < 2; ++k) _Pragma("unroll") for (int n = 0; n < 2; ++n) _Pragma("unroll") for (int m = 0; m < 4; ++m) acc[ai][bj][m][n] = __builtin_amdgcn_mfma_f32_16x16x32_bf16(Bt[n][k], At[m][k], acc[ai][bj][m][n], 0, 0, 0); } \
        else { _Pragma("unroll") for (int m = 0; m < 4; ++m) _Pragma("unroll") for (int n = 0; n < 2; ++n) _Pragma("unroll") for (int k = 0; k < 2; ++k) acc[ai][bj][m][n] = __builtin_amdgcn_mfma_f32_16x16x32_bf16(Bt[n][k], At[m][k], acc[ai][bj][m][n], 0, 0, 0); } \
        if constexpr (FP8) asm volatile("s_nop 3");     \
        __builtin_amdgcn_s_setprio(0); } while (0)
#define PG8_WAIT_V(n) asm volatile("s_waitcnt vmcnt(" #n ")" ::: "memory")
#define PG8_WAIT_L(n) asm volatile("s_waitcnt lgkmcnt(" #n ")" ::: "memory")
#define PG8_BAR __builtin_amdgcn_s_barrier()
#define PG8_SCHED __builtin_amdgcn_sched_barrier(0)
    Unit cur, nxt; int ui = 0;
    if (!S.next(0, cur)) return;
    f32x4 acc[2][2][4][2];
#pragma unroll
    for (int a = 0; a < 2; ++a)
#pragma unroll
        for (int b = 0; b < 2; ++b)
#pragma unroll
            for (int m = 0; m < 4; ++m)
#pragma unroll
                for (int n = 0; n < 2; ++n) acc[a][b][m][n] = (f32x4){0.f, 0.f, 0.f, 0.f};
    bf16x8 At[4][2], B0[2][2], B1[2][2]; v8i_t At8[4], B08[2], B18[2];
    const char* cA = (const char*)g.A + (size_t)cur.pm * tstep + (size_t)cur.koff * 2; const char* cB = (const char*)g.Bt + (size_t)cur.pn * tstep + (size_t)cur.koff * 2;
    S.a_ready(cur);
    if constexpr (SP2) {
        PG8_STAGE(PG8_SB(0, 0), cB, voffB); PG8_STAGE(PG8_SB(0, 1), cB + hstep, voffB); PG8_STAGE(PG8_SA(0, 0), cA, voffA); PG8_STAGE(PG8_SA(0, 1), cA + hstep, voffA);
        if (wr == 1) PG8_BAR;
        PG8_WAIT_V(2); PG8_BAR;
        PG8_STAGE(PG8_SB(1, 0), cB + kstep, voffB); PG8_STAGE(PG8_SA(1, 0), cA + kstep, voffA); PG8_STAGE(PG8_SB(1, 1), cB + hstep + kstep, voffB);
        PG8_WAIT_V(6); PG8_BAR;
    } else {
        PG8_STAGE(PG8_SB(0, 0), cB, voffB); PG8_STAGE(PG8_SA(0, 0), cA, voffA); PG8_STAGE(PG8_SB(0, 1), cB + hstep, voffB); PG8_STAGE(PG8_SA(0, 1), cA + hstep, voffA);
        if (wr == 1) PG8_BAR;
        PG8_WAIT_V(4); PG8_BAR;
        PG8_STAGE(PG8_SB(1, 0), cB + kstep, voffB); PG8_STAGE(PG8_SA(1, 0), cA + kstep, voffA); PG8_STAGE(PG8_SB(1, 1), cB + hstep + kstep, voffB);
        PG8_WAIT_V(6); PG8_BAR;
    }
    for (;;) {
        const bool has_next = S.next(ui + 1, nxt);
        const char* nA = has_next ? (const char*)g.A + (size_t)nxt.pm * tstep + (size_t)nxt.koff * 2 : cA; const char* nB = has_next ? (const char*)g.Bt + (size_t)nxt.pn * tstep + (size_t)nxt.koff * 2 : cB;
        const int nt = cur.nt;
        for (int t = 0; t < nt; t += 2) {
            const bool last = (t == nt - 2);
            const char* a1 = cA + (size_t)(t + 1) * kstep;
            const char* a2 = last ? nA : cA + (size_t)(t + 2) * kstep; const char* b2 = last ? nB : cB + (size_t)(t + 2) * kstep;
            const char* a3 = a2 + kstep; const char* b3 = b2 + kstep;
            if (last && has_next) S.a_ready(nxt);
            if constexpr (SP2) {
            PG8_LDB(B0, 0, 0); PG8_LDB(B1, 0, 1); PG8_SCHED; PG8_LDA(At, 0, 0); PG8_STAGE(PG8_SA(1, 1), a1 + hstep, voffA);
            PG8_WAIT_V(8); PG8_WAIT_L(0); PG8_BAR; PG8_MMA(0, 0, At, B0); PG8_MMA(0, 1, At, B1); PG8_BAR; PG8_SCHED;
            PG8_LDA(At, 0, 1); PG8_STAGE(PG8_SB(0, 0), b2, voffB); PG8_STAGE(PG8_SB(0, 1), b2 + hstep, voffB); PG8_STAGE(PG8_SA(0, 0), a2, voffA);
            PG8_WAIT_V(8); PG8_WAIT_L(0); PG8_BAR; PG8_MMA(1, 0, At, B0); PG8_MMA(1, 1, At, B1); PG8_BAR; PG8_SCHED;
            PG8_LDB(B0, 1, 0); PG8_LDB(B1, 1, 1); PG8_SCHED; PG8_LDA(At, 1, 0); PG8_STAGE(PG8_SA(0, 1), a2 + hstep, voffA);
            PG8_WAIT_V(8); PG8_WAIT_L(0); PG8_BAR; PG8_MMA(0, 0, At, B0); PG8_MMA(0, 1, At, B1); PG8_BAR; PG8_SCHED;
            PG8_LDA(At, 1, 1); PG8_STAGE(PG8_SB(1, 0), b3, voffB); PG8_STAGE(PG8_SB(1, 1), b3 + hstep, voffB); PG8_STAGE(PG8_SA(1, 0), a3, voffA);
            PG8_WAIT_V(8); PG8_WAIT_L(0); PG8_BAR; PG8_MMA(1, 0, At, B0); PG8_MMA(1, 1, At, B1); PG8_BAR; PG8_SCHED;
            } else {
            PG8_LDB(B0, 0, 0); PG8_SCHED; PG8_LDA(At, 0, 0); PG8_STAGE(PG8_SA(1, 1), a1 + hstep, voffA);
            PG8_WAIT_L(8); PG8_BAR; PG8_WAIT_L(0); PG8_MMA(0, 0, At, B0); PG8_BAR; PG8_SCHED;
            PG8_LDB(B1, 0, 1); PG8_STAGE(PG8_SB(0, 0), b2, voffB);
            PG8_BAR; PG8_WAIT_L(0); PG8_MMA(0, 1, At, B1); PG8_BAR;
            PG8_LDA(At, 0, 1); PG8_STAGE(PG8_SA(0, 0), a2, voffA);
            PG8_BAR; PG8_WAIT_L(0); PG8_MMA(1, 0, At, B0); PG8_BAR; PG8_SCHED;
            PG8_STAGE(PG8_SB(0, 1), b2 + hstep, voffB);
            PG8_WAIT_V(6); PG8_BAR; PG8_MMA(1, 1, At, B1); PG8_BAR;
            PG8_LDB(B0, 1, 0); PG8_SCHED; PG8_LDA(At, 1, 0); PG8_STAGE(PG8_SA(0, 1), a2 + hstep, voffA);
            PG8_WAIT_L(8); PG8_BAR; PG8_WAIT_L(0); PG8_MMA(0, 0, At, B0); PG8_BAR; PG8_SCHED;
            PG8_LDB(B1, 1, 1); PG8_STAGE(PG8_SB(1, 0), b3, voffB);
            PG8_BAR; PG8_WAIT_L(0); PG8_MMA(0, 1, At, B1); PG8_BAR;
            PG8_LDA(At, 1, 1); PG8_STAGE(PG8_SA(1, 0), a3, voffA);
            PG8_BAR; PG8_WAIT_L(0); PG8_MMA(1, 0, At, B0); PG8_BAR; PG8_SCHED;
            PG8_STAGE(PG8_SB(1, 1), b3 + hstep, voffB);
            PG8_WAIT_V(6); PG8_BAR; PG8_MMA(1, 1, At, B1); PG8_BAR;
            }
        }
        if constexpr (ALIGN_EPI) { if (wr == 0) PG8_BAR; }
        if constexpr (FP8) asm volatile("s_nop 15\n\ts_nop 15" ::: "memory");
        if constexpr (!Epi::AFTER_DRAIN) { E(acc, cur, wr, wc, fr, fq); S.done(cur); }
        if (!has_next) break;
        if constexpr (KEEP) {
#pragma unroll
            for (int a = 0; a < 2; ++a)
#pragma unroll
                for (int m = 0; m < 4; ++m) { const float f = E.keep_factor(cur, a, m, wr, fr);
#pragma unroll
                    for (int b = 0; b < 2; ++b) { acc[a][b][m][0] *= f; acc[a][b][m][1] *= f; } }
        } else
#pragma unroll
        for (int a = 0; a < 2; ++a)
#pragma unroll
            for (int b = 0; b < 2; ++b)
#pragma unroll
                for (int m = 0; m < 4; ++m)
#pragma unroll
                    for (int n = 0; n < 2; ++n) acc[a][b][m][n] = (f32x4){0.f, 0.f, 0.f, 0.f};
        cur = nxt; cA = nA; cB = nB; ++ui;
        if constexpr (ALIGN_EPI) { if (wr == 1) PG8_BAR; }
    }
    PG8_WAIT_V(0);
    if constexpr (!ALIGN_EPI) { if (wr == 0) PG8_BAR; }
    PG8_BAR;
    if constexpr (Epi::AFTER_DRAIN) { E.fused(acc, cur, wr, wc, fr, fq, lds, wid, lane); S.done(cur); }
#undef PG8_SA
#undef PG8_SB
#undef PG8_STAGE
#undef PG8_LDA
#undef PG8_LDB
#undef PG8_MMA
#undef PG8_WAIT_V
#undef PG8_WAIT_L
#undef PG8_BAR
#undef PG8_SCHED
}
}
constexpr int NWAVES = 8, NTHR = NWAVES * 64;
constexpr int DM = 4096, NLAT = 16384, NCTX = 512, MROWS = NLAT + NCTX, SEQ = 8192, CTXL = 256;
constexpr int FF = 11008, NGU = 2 * FF;
constexpr int NINP = 8448;
constexpr int PQ = 0, PZ = 2048, PK = 4096, PV = 4608, PXBC = 5120;
constexpr int XBCW = 3072;
constexpr int NMOD = 9 * DM;
constexpr int NSC = 132;
constexpr float EPS = 1e-6f;
constexpr float QSCALE = 0.12751743082459868f;
constexpr float LOG2E = 1.4426950408889634f;

constexpr size_t MiB = 1u << 20;
constexpr size_t WS_CTL = 0, WS_MOD = 1 * MiB, ZERO_BYTES = 2 * MiB;
constexpr size_t WS_ROWSS = 1 * MiB + 512 * 1024;
constexpr size_t WS_ROPE = 2 * MiB;
constexpr size_t WS_DEC = 2 * MiB + 65536;
constexpr size_t WS_DTF = 4 * MiB, WS_DTB = 7 * MiB;
constexpr size_t WS_WGU0 = 16 * MiB, WS_WD0 = 188 * MiB, WS_WIN = 274 * MiB, WS_WOUT = 340 * MiB, WS_WGU1 = 372 * MiB, WS_WD1 = 544 * MiB;
constexpr size_t WS_H = 630 * MiB;
constexpr size_t WS_ACT = 762 * MiB, WS_P = 762 * MiB;
constexpr size_t WS_Y = 1117 * MiB;
constexpr size_t WS_X1 = 1249 * MiB;
constexpr size_t WS_XC = 1505 * MiB;
constexpr size_t WS_OATT = 1604 * MiB, WS_YS = 1668 * MiB;
constexpr size_t WS_SLOC = 1732 * MiB;
constexpr size_t WS_HIN = 1996 * MiB;
constexpr size_t WS_YCP = 2124 * MiB;
constexpr size_t WS_END = 2188 * MiB;
static_assert(WS_WGU0 + (size_t)NGU * DM * 2 <= WS_WD0 && WS_WD0 + (size_t)DM * FF * 2 <= WS_WIN && WS_WIN + (size_t)NINP * DM * 2 <= WS_WOUT && WS_WOUT + (size_t)DM * DM * 2 <= WS_WGU1, "ws map 1");
static_assert(WS_WGU1 + (size_t)NGU * DM * 2 <= WS_WD1 && WS_WD1 + (size_t)DM * FF * 2 <= WS_H && WS_H + (size_t)MROWS * DM * 2 <= WS_ACT && WS_ACT + (size_t)MROWS * FF * 2 <= WS_Y, "ws map 2");
static_assert(WS_P + (size_t)MROWS * NINP * 2 <= WS_Y && WS_Y + (size_t)MROWS * DM * 2 <= WS_X1 && WS_X1 + (size_t)NLAT * DM * 4 <= WS_XC && WS_XC + (size_t)MROWS * XBCW * 2 <= WS_OATT, "ws map 3");
static_assert(WS_OATT + (size_t)NLAT * 2048 * 2 <= WS_YS && WS_YS + (size_t)NLAT * 2048 * 2 <= WS_SLOC && WS_SLOC + (size_t)NSC * 2 * 32 * 8192 * 4 <= WS_HIN && WS_HIN + (size_t)128 * 2 * 32 * 8192 * 2 <= WS_END, "ws map 4");
static_assert(WS_DTF + (size_t)MROWS * 32 * 4 <= WS_DTB && WS_DTB + (size_t)MROWS * 32 * 4 <= WS_WGU0 && WS_MOD + (size_t)3 * NMOD * 4 <= ZERO_BYTES, "ws map 5");
constexpr int CW_BAR = 4096;

constexpr int RING_BYTES = 131072;
constexpr int MISC_OFF = RING_BYTES + 320;
constexpr int LDS_BYTES = 147456;

#define GAS __attribute__((address_space(1)))
#define LAS __attribute__((address_space(3)))
typedef unsigned short bf16;
typedef unsigned u32x4 __attribute__((ext_vector_type(4)));
typedef unsigned u32x2 __attribute__((ext_vector_type(2)));
typedef float f32x4 __attribute__((ext_vector_type(4)));
typedef short bf16x8 __attribute__((ext_vector_type(8)));
typedef short bf16x4 __attribute__((ext_vector_type(4)));
using pg8::pk_bf16; using pg8::pk_bf16q; using pg8::pk_f16; using pg8::silu_f;
__device__ __forceinline__ float bf_lo(unsigned w) { return __uint_as_float(w << 16); }
__device__ __forceinline__ float bf_hi(unsigned w) { return __uint_as_float(w & 0xffff0000u); }
__device__ __forceinline__ unsigned short f2bf(float f) { return (unsigned short)(pk_bf16(f, 0.f) & 0xffffu); }
__device__ __forceinline__ float row_max(float x) {
    u32x2 r = __builtin_amdgcn_permlane16_swap(__float_as_uint(x), __float_as_uint(x), false, false); x = fmaxf(__uint_as_float(r.x), __uint_as_float(r.y));
    r = __builtin_amdgcn_permlane32_swap(__float_as_uint(x), __float_as_uint(x), false, false); return fmaxf(__uint_as_float(r.x), __uint_as_float(r.y));
}
__device__ __forceinline__ float row_sum(float x) {
    u32x2 r = __builtin_amdgcn_permlane16_swap(__float_as_uint(x), __float_as_uint(x), false, false); x = __uint_as_float(r.x) + __uint_as_float(r.y);
    r = __builtin_amdgcn_permlane32_swap(__float_as_uint(x), __float_as_uint(x), false, false); return __uint_as_float(r.x) + __uint_as_float(r.y);
}
__device__ __forceinline__ float wave_sum(float v) {
    v += __uint_as_float(__builtin_amdgcn_update_dpp(0u, __float_as_uint(v), 0xB1, 0xF, 0xF, false));
    v += __uint_as_float(__builtin_amdgcn_update_dpp(0u, __float_as_uint(v), 0x4E, 0xF, 0xF, false));
    v += __uint_as_float(__builtin_amdgcn_update_dpp(0u, __float_as_uint(v), 0x141, 0xF, 0xF, false));
    v += __uint_as_float(__builtin_amdgcn_update_dpp(0u, __float_as_uint(v), 0x140, 0xF, 0xF, false));
    return row_sum(v);
}
typedef _Float16 f16x8 __attribute__((ext_vector_type(8)));
typedef _Float16 f16x2 __attribute__((ext_vector_type(2)));
typedef float f32x2 __attribute__((ext_vector_type(2)));
__device__ __forceinline__ void unpack8h(const u32x4 w, float (&f)[8]) { const f16x8 h = __builtin_bit_cast(f16x8, w);
#pragma unroll
    for (int e = 0; e < 8; ++e) f[e] = (float)h[e]; }
__device__ __forceinline__ void unpack8(const u32x4 w, float (&f)[8]) {
    f[0] = bf_lo(w.x); f[1] = bf_hi(w.x); f[2] = bf_lo(w.y); f[3] = bf_hi(w.y); f[4] = bf_lo(w.z); f[5] = bf_hi(w.z); f[6] = bf_lo(w.w); f[7] = bf_hi(w.w);
}
#define XB_TMO      128
#define XB_XCNT(j)  (256  + 64 * (j))
#define XB_XSUB(j)  (1280 + 64 * (j))
#define XB_XGEN(j)  (2304 + 64 * (j))
#define XB_TOP      3328
#define XB_TOPGEN   3392
#define XCD_BAR_WORDS 3456
#define XB_SPIN_CAP (1u << 18)

__device__ __forceinline__ unsigned xb_ld(unsigned* p)              { return __hip_atomic_load(p, __ATOMIC_RELAXED, __HIP_MEMORY_SCOPE_AGENT); }
__device__ __forceinline__ unsigned xb_add(unsigned* p, unsigned v) { return __hip_atomic_fetch_add(p, v, __ATOMIC_RELAXED, __HIP_MEMORY_SCOPE_AGENT); }
__device__ __forceinline__ unsigned xb_xcc_id() { return (unsigned)__builtin_amdgcn_s_getreg((3 << 11) | 20) & 0xFu; }
#define XB_SPIN(cond, bar) do { unsigned _sp = 0; while (cond) { __builtin_amdgcn_s_sleep(1); \
    if ((++_sp & 255u) == 0u) { if (xb_ld(&(bar)[XB_TMO])) break; if (_sp > XB_SPIN_CAP) { atomicAdd(&(bar)[XB_TMO], 1u); break; } } } } while (0)

struct XcdBarrier {
    unsigned* bar; unsigned x;
    volatile LAS unsigned* st;
};

__device__ __forceinline__ XcdBarrier xcd_barrier_post(unsigned* bar, volatile LAS unsigned* st) {
    XcdBarrier b; b.bar = bar; b.x = xb_xcc_id(); b.st = st;
    if (threadIdx.x == 0) (void)xb_add(&bar[XB_XCNT(b.x)], 1u);
    return b;
}
__device__ __forceinline__ void xcd_barrier_complete(unsigned* bar, unsigned x, unsigned& nloc, unsigned& nx) {
    const unsigned G = gridDim.x * gridDim.y * gridDim.z;
    unsigned sum, cnt, mine, sp = 0u;
    for (;;) {
        sum = 0u; cnt = 0u; mine = 0u;
#pragma unroll
        for (unsigned j = 0; j < 16; ++j) { const unsigned c = xb_ld(&bar[XB_XCNT(j)]); sum += c; cnt += (c > 0u) ? 1u : 0u; mine = (j == x) ? c : mine; }
        if (sum == G) break;
        __builtin_amdgcn_s_sleep(1);
        if ((++sp & 255u) == 0u) { if (xb_ld(&bar[XB_TMO])) break; if (sp > XB_SPIN_CAP) { atomicAdd(&bar[XB_TMO], 1u); break; } }
    }
    nloc = mine > 0u ? mine : 1u; nx = cnt > 0u ? cnt : 1u;
}

__device__ __forceinline__ void xcd_barrier(const XcdBarrier& b) {
    asm volatile("s_waitcnt vmcnt(0)" ::: "memory");
    __syncthreads();
    if (threadIdx.x == 0) {
        unsigned* bar = b.bar;
        __builtin_amdgcn_s_waitcnt(0);
        unsigned nloc = b.st[0], nx = b.st[1];
        if (nloc == 0u) { xcd_barrier_complete(bar, b.x, nloc, nx); b.st[0] = nloc; b.st[1] = nx; }
        const unsigned old = xb_add(&bar[XB_XSUB(b.x)], 1u);
        const unsigned gen = old / nloc;
        if (old + 1u == (gen + 1u) * nloc) {
            __builtin_amdgcn_fence(__ATOMIC_RELEASE, "agent");
            asm volatile("s_waitcnt vmcnt(0)" ::: "memory");
            const unsigned og = xb_add(&bar[XB_TOP], 1u);
            const unsigned tg = og / nx;
            if (og + 1u == (tg + 1u) * nx) xb_add(&bar[XB_TOPGEN], 1u);
            else XB_SPIN(xb_ld(&bar[XB_TOPGEN]) == tg, bar);
            __builtin_amdgcn_fence(__ATOMIC_ACQUIRE, "agent");
            xb_add(&bar[XB_XGEN(b.x)], 1u);
            asm volatile("s_waitcnt vmcnt(0)" ::: "memory");
        } else {
            XB_SPIN(xb_ld(&bar[XB_XGEN(b.x)]) == gen, bar);
            __builtin_amdgcn_fence(__ATOMIC_ACQUIRE, "agent");
            asm volatile("s_waitcnt vmcnt(0)" ::: "memory");
        }
    }
    __syncthreads();
}
struct Fr {
    LAS unsigned char* lds;
    int tid, lane, wave, G, bid;
    const float* in[21]; float* out; unsigned char* ws;
};
#define WSP(T, off) ((T*)(F.ws + (off)))
#define LDSW() asm volatile("s_waitcnt lgkmcnt(0)" ::: "memory")

__device__ __forceinline__ int qk_perm(int d) { const int a = d >> 6, hf = (d >> 5) & 1, i = d & 31; return 32 * (2 * a + (i >> 4)) + 8 * ((i >> 2) & 3) + 4 * hf + (i & 3); }
__device__ __forceinline__ int dst_row(int mode, int n) {
    if (mode == 1) return ((n >> 7) << 8) + (n & 127);
    if (mode == 2) return ((n >> 7) << 8) + 128 + (n & 127);
    if (mode == 3) { if (n < 2048 || (n >= 4096 && n < 4608)) return (n & ~127) + qk_perm(n & 127); return n; }
    return n;
}
#ifndef WQ_DROP
#define WQ_DROP 2
#endif
__device__ __forceinline__ float wquant(float v) {
    if (WQ_DROP == 0) return v;
    unsigned u = __float_as_uint(v); constexpr unsigned sh = 16 + WQ_DROP, half = (1u << (sh - 1)) - 1u;
    u = (u + half + ((u >> sh) & 1u)) & ~((1u << sh) - 1u); return __uint_as_float(u);
}
__device__ __forceinline__ void transpose_item(const float* W, int K, int N, bf16* WT, int mode, const float* kscale, LAS float* scr, int item, int lane) {
    const int nblk = N / 32, kb = item / nblk, nb = item - kb * nblk, k0 = 64 * kb, n0 = 32 * nb;
    float wv[32];
#pragma unroll
    for (int i = 0; i < 32; ++i) wv[i] = __builtin_nontemporal_load(W + (size_t)(k0 + 2 * i + (lane >> 5)) * N + n0 + (lane & 31));
#pragma unroll
    for (int i = 0; i < 32; ++i) { const int kk = 2 * i + (lane >> 5); float v = wv[i]; if (kscale) v *= kscale[k0 + kk]; scr[kk * 33 + (lane & 31)] = (mode & 8) ? wquant(v) : v; }
    LDSW();
    const int c = lane & 7;
#pragma unroll
    for (int j = 0; j < 4; ++j) { const int n = (lane >> 3) + 8 * j; const LAS float* s = scr + (8 * c) * 33 + n;
        u32x4 o; o.x = pk_bf16(s[0 * 33], s[1 * 33]); o.y = pk_bf16(s[2 * 33], s[3 * 33]); o.z = pk_bf16(s[4 * 33], s[5 * 33]); o.w = pk_bf16(s[6 * 33], s[7 * 33]);
        *(u32x4*)(WT + (size_t)dst_row(mode & 7, n0 + n) * K + k0 + 8 * c) = o; }
    LDSW();
}
__device__ __forceinline__ void transpose_item8(const float* W, int K, int N, unsigned char* WT, LAS float* scr, int item, int lane) {
    const int nblk = N / 32, kb = item / nblk, nb = item - kb * nblk, k0 = 64 * kb, n0 = 32 * nb;
    float wv[32];
#pragma unroll
    for (int i = 0; i < 32; ++i) wv[i] = __builtin_nontemporal_load(W + (size_t)(k0 + 2 * i + (lane >> 5)) * N + n0 + (lane & 31));
#pragma unroll
    for (int i = 0; i < 32; ++i) { const int kk = 2 * i + (lane >> 5); scr[kk * 33 + (lane & 31)] = 2048.f * wv[i]; }
    LDSW();
    const int n = lane >> 1, kh = (lane & 1) * 32; const LAS float* s = scr + kh * 33 + n;
    u32x4 o0, o1;
    o0.x = pg8::pk4_fp8(s[0 * 33], s[1 * 33], s[2 * 33], s[3 * 33]); o0.y = pg8::pk4_fp8(s[4 * 33], s[5 * 33], s[6 * 33], s[7 * 33]);
    o0.z = pg8::pk4_fp8(s[8 * 33], s[9 * 33], s[10 * 33], s[11 * 33]); o0.w = pg8::pk4_fp8(s[12 * 33], s[13 * 33], s[14 * 33], s[15 * 33]);
    o1.x = pg8::pk4_fp8(s[16 * 33], s[17 * 33], s[18 * 33], s[19 * 33]); o1.y = pg8::pk4_fp8(s[20 * 33], s[21 * 33], s[22 * 33], s[23 * 33]);
    o1.z = pg8::pk4_fp8(s[24 * 33], s[25 * 33], s[26 * 33], s[27 * 33]); o1.w = pg8::pk4_fp8(s[28 * 33], s[29 * 33], s[30 * 33], s[31 * 33]);
    unsigned char* dst = WT + (size_t)(n0 + n) * K + k0 + kh;
    *(u32x4*)dst = o0; *(u32x4*)(dst + 16) = o1;
    LDSW();
}
constexpr int CV_F = 22016, CV_IN = 64 * 258, CV_OUT = 64 * 128;
constexpr int CV_WD0 = 2 * CV_F, CV_WIN = 3 * CV_F, CV_WOUT = CV_WIN + CV_IN, CV_G1 = CV_WOUT + CV_OUT, CV_U1 = CV_G1 + CV_F, CV_WD1 = CV_U1 + CV_F, CV_END = CV_WD1 + CV_F;
constexpr int CV_Q2_LO = CV_WD0, CV_Q2_HI = CV_WOUT;
constexpr int CV_Q5_LO = CV_WOUT, CV_Q5_HI = CV_G1 + 28000;
constexpr int CV_Q13_LO = CV_WD1, CV_Q13_HI = CV_END;
constexpr int CW_Q2 = 1024, CW_Q5 = 1088, CW_Q13 = 1152;
__device__ __forceinline__ void conv_item(Fr& F, int id, LAS float* scr) {
    const size_t FW = (size_t)DM * FF;
    if (id < CV_F) { transpose_item(F.in[8], DM, FF, WSP(bf16, WS_WGU0), 1 | 8, nullptr, scr, id, F.lane); return; }
    if (id < CV_WD0) { transpose_item(F.in[9], DM, FF, WSP(bf16, WS_WGU0), 2 | 8, nullptr, scr, id - CV_F, F.lane); return; }
    if (id < CV_WIN) { transpose_item(F.in[10], FF, DM, WSP(bf16, WS_WD0), 0 | 8, nullptr, scr, id - CV_WD0, F.lane); return; }
    if (id < CV_WOUT) { transpose_item(F.in[11], DM, 8256, WSP(bf16, WS_WIN), 3, nullptr, scr, id - CV_WIN, F.lane); return; }
    if (id < CV_G1) { const int r = id - CV_WOUT, kb = r / 128; const float* ks = (kb < 32) ? F.in[13] : (F.in[19] - 2048);
        transpose_item(F.in[20], DM, DM, WSP(bf16, WS_WOUT), 0, ks, scr, r, F.lane); return; }
    if (id < CV_U1) { transpose_item(F.in[8] + FW, DM, FF, WSP(bf16, WS_WGU1), 1 | 8, nullptr, scr, id - CV_G1, F.lane); return; }
    if (id < CV_WD1) { transpose_item(F.in[9] + FW, DM, FF, WSP(bf16, WS_WGU1), 2 | 8, nullptr, scr, id - CV_U1, F.lane); return; }
    transpose_item8(F.in[10] + FW, FF, DM, WSP(unsigned char, WS_WD1), scr, id - CV_WD1, F.lane);
}
__device__ __forceinline__ void p0_prologue(Fr& F, int rep = 0) {
    const int gw = F.bid * NWAVES + F.wave, NGW = F.G * NWAVES, gt = F.bid * NTHR + F.tid, NGT = F.G * NTHR;
    LAS float* scr = (LAS float*)(F.lds + F.wave * 8448);
    LAS float* sv = (LAS float*)(F.lds + 69632);
    for (int i = F.tid; i < 3 * DM; i += NTHR) { const int r = i >> 12, k = i & 4095; const float v = (r < 2) ? F.in[1][r * DM + k] : F.in[3][k]; sv[i] = v / (1.0f + __expf(-v)); }
    for (int e = gt; e < 4096; e += NGT) {
        const int pos = e >> 5, i = e & 31; double inv = 1.0; for (int q = 0; q < i; ++q) inv *= 0.74989420933245582730;
        double a = (double)pos * inv; const double k = __builtin_rint(a * 0.15915494309189533577); a = (a - k * 6.283185307179586232) - k * 2.449293598294706414e-16;
        const double a2 = a * a; double sn = 1.0, cs = 1.0;
        for (int q = 14; q >= 1; --q) { sn = 1.0 - sn * a2 / (double)((2 * q) * (2 * q + 1)); cs = 1.0 - cs * a2 / (double)((2 * q - 1) * (2 * q)); }
        sn *= a;
        WSP(float, WS_ROPE)[e] = (float)cs; WSP(float, WS_ROPE)[4096 + e] = (float)sn;
    }
    for (int e = gt; e < 192 * DM / 8; e += NGT) WSP(u32x4, WS_WIN + (size_t)8256 * DM * 2)[e] = (u32x4){0u, 0u, 0u, 0u};
    __syncthreads();
    {
        const float* wm = F.in[4]; const float* bm = F.in[5]; float* MOD = rep ? WSP(float, WS_YCP) : WSP(float, WS_MOD);
        for (int it = gw; it < 144 * 64; it += NGW) {
            const int chunk = it % 144, ks = it / 144, n = chunk * 256 + 4 * F.lane;
            f32x4 a0 = (f32x4){0.f, 0.f, 0.f, 0.f}, a1 = a0, a2 = a0;
            if (ks == 0) { a0 = *(const f32x4*)(bm + n); a1 = a0; a2 = a0; }
            const float* wp = wm + (size_t)(ks * 64) * NMOD + n; const LAS float* s = sv + ks * 64;
#pragma unroll 8
            for (int k = 0; k < 64; ++k) { const f32x4 w = __builtin_nontemporal_load((const f32x4*)(wp + (size_t)k * NMOD)); a0 += s[k] * w; a1 += s[DM + k] * w; a2 += s[2 * DM + k] * w; }
#pragma unroll
            for (int j = 0; j < 4; ++j) {
                __hip_atomic_fetch_add(MOD + n + j, a0[j], __ATOMIC_RELAXED, __HIP_MEMORY_SCOPE_AGENT);
                __hip_atomic_fetch_add(MOD + NMOD + n + j, a1[j], __ATOMIC_RELAXED, __HIP_MEMORY_SCOPE_AGENT);
                __hip_atomic_fetch_add(MOD + 2 * NMOD + n + j, a2[j], __ATOMIC_RELAXED, __HIP_MEMORY_SCOPE_AGENT); }
        }
    }
#ifndef PROBE_P0T
#define PROBE_P0T 1
#endif
    for (int rep = 0; rep < PROBE_P0T; ++rep) {
        for (int it = gw; it < CV_Q2_LO; it += NGW) conv_item(F, it, scr);
        for (int it = CV_Q5_HI + gw; it < CV_Q13_LO; it += NGW) conv_item(F, it, scr);
    }
}
__device__ __forceinline__ void conv_queue(Fr& F, int qword, int lo, int hi) {
    LAS float* scr = (LAS float*)(F.lds + F.wave * 8448);
    unsigned* ctr = (unsigned*)(F.ws + WS_CTL) + qword;
    for (;;) {
        unsigned b = 0; if (F.lane == 0) b = __hip_atomic_fetch_add(ctr, 4u, __ATOMIC_RELAXED, __HIP_MEMORY_SCOPE_AGENT);
        const int base = lo + (int)__builtin_amdgcn_readfirstlane(b);
        if (base >= hi) break;
        for (int q = 0; q < 4 && base + q < hi; ++q) conv_item(F, base + q, scr);
    }
}

__device__ __forceinline__ void norm_mod_row(const float* xrow, const float* g, const float* scale, const float* shift, bf16* hrow, int lane) {
    f32x4 v[16]; float ss = 0.f;
#pragma unroll
    for (int j = 0; j < 8; ++j) { const float* p = xrow + 512 * j + 8 * lane; v[2 * j] = __builtin_nontemporal_load((const f32x4*)p); v[2 * j + 1] = __builtin_nontemporal_load((const f32x4*)(p + 4)); }
#pragma unroll
    for (int j = 0; j < 16; ++j) ss += (v[j][0] * v[j][0] + v[j][1] * v[j][1]) + (v[j][2] * v[j][2] + v[j][3] * v[j][3]);
    const float rstd = 1.0f / sqrtf(wave_sum(ss) * (1.0f / DM) + EPS);
#pragma unroll
    for (int j = 0; j < 8; ++j) { const int o = 512 * j + 8 * lane;
        const f32x4 g0 = *(const f32x4*)(g + o), g1 = *(const f32x4*)(g + o + 4), s0 = *(const f32x4*)(scale + o), s1 = *(const f32x4*)(scale + o + 4), t0 = *(const f32x4*)(shift + o), t1 = *(const f32x4*)(shift + o + 4);
        const f32x4 a = v[2 * j] * rstd * g0 * (1.0f + s0) + t0, b = v[2 * j + 1] * rstd * g1 * (1.0f + s1) + t1;
        u32x4 w; w.x = pk_bf16q(a[0], a[1]); w.y = pk_bf16q(a[2], a[3]); w.z = pk_bf16q(b[0], b[1]); w.w = pk_bf16q(b[2], b[3]);
        *(u32x4*)(hrow + o) = w; }
}
template <bool STORE_X, bool DO_H, bool YSPLIT = false, bool XIN_BF = false, bool XOUT_BF = false, bool HQ = false>
__device__ __forceinline__ void res_norm_row(const void* xin_, const bf16* yrow, void* xout_, bf16* hrow, float coef, const float* gate, const float* gpost,
                                             const float* gpre, const float* scale, const float* shift, int lane, const float* ysplit = nullptr, float ymul = 1.0f) {
    u32x4 yv[8]; float ssy = 0.f;
    if (YSPLIT) {
#pragma unroll
        for (int j = 0; j < 8; ++j) { f32x4 a = (f32x4){0.f, 0.f, 0.f, 0.f}, b = a;
#pragma unroll
            for (int s = 0; s < 8; ++s) { const float* p = ysplit + (size_t)s * 512 * DM + 512 * j + 8 * lane; a += *(const f32x4*)p; b += *(const f32x4*)(p + 4); }
            yv[j].x = pk_f16(a[0], a[1]); yv[j].y = pk_f16(a[2], a[3]); yv[j].z = pk_f16(b[0], b[1]); yv[j].w = pk_f16(b[2], b[3]); }
    } else {
#pragma unroll
    for (int j = 0; j < 8; ++j) yv[j] = __builtin_nontemporal_load((const u32x4*)(yrow + 512 * j + 8 * lane));
    }
    f32x4 v[16];
#pragma unroll
    for (int j = 0; j < 8; ++j) {
        if (XIN_BF) { float f[8]; unpack8h(__builtin_nontemporal_load((const u32x4*)((const bf16*)xin_ + 512 * j + 8 * lane)), f); v[2 * j] = (f32x4){f[0], f[1], f[2], f[3]}; v[2 * j + 1] = (f32x4){f[4], f[5], f[6], f[7]}; }
        else { const float* p = (const float*)xin_ + 512 * j + 8 * lane; v[2 * j] = __builtin_nontemporal_load((const f32x4*)p); v[2 * j + 1] = __builtin_nontemporal_load((const f32x4*)(p + 4)); } }
#pragma unroll
    for (int j = 0; j < 8; ++j) { float f[8]; unpack8h(yv[j], f);
#pragma unroll
        for (int e = 0; e < 8; ++e) ssy += f[e] * f[e]; }
    const float ry = coef * ymul / sqrtf(wave_sum(ssy) * (ymul * ymul) * (1.0f / DM) + EPS);
    float ss = 0.f;
#pragma unroll
    for (int j = 0; j < 8; ++j) { const int o = 512 * j + 8 * lane; float f[8]; unpack8h(yv[j], f);
        const f32x4 ga0 = *(const f32x4*)(gate + o), ga1 = *(const f32x4*)(gate + o + 4), gp0 = *(const f32x4*)(gpost + o), gp1 = *(const f32x4*)(gpost + o + 4);
        const f32x4 y0 = (f32x4){f[0], f[1], f[2], f[3]}, y1 = (f32x4){f[4], f[5], f[6], f[7]};
        v[2 * j] += ga0 * gp0 * (y0 * ry); v[2 * j + 1] += ga1 * gp1 * (y1 * ry);
        if (STORE_X) {
            if (XOUT_BF) { u32x4 w; w.x = pk_f16(v[2 * j][0], v[2 * j][1]); w.y = pk_f16(v[2 * j][2], v[2 * j][3]); w.z = pk_f16(v[2 * j + 1][0], v[2 * j + 1][1]); w.w = pk_f16(v[2 * j + 1][2], v[2 * j + 1][3]);
                __builtin_nontemporal_store(w, (u32x4*)((bf16*)xout_ + o)); }
            else { __builtin_nontemporal_store(v[2 * j], (f32x4*)((float*)xout_ + o)); __builtin_nontemporal_store(v[2 * j + 1], (f32x4*)((float*)xout_ + o + 4)); } }
        if (DO_H) ss += (v[2 * j][0] * v[2 * j][0] + v[2 * j][1] * v[2 * j][1]) + (v[2 * j][2] * v[2 * j][2] + v[2 * j][3] * v[2 * j][3])
                      + (v[2 * j + 1][0] * v[2 * j + 1][0] + v[2 * j + 1][1] * v[2 * j + 1][1]) + (v[2 * j + 1][2] * v[2 * j + 1][2] + v[2 * j + 1][3] * v[2 * j + 1][3]); }
    if (DO_H) {
        const float rstd = 1.0f / sqrtf(wave_sum(ss) * (1.0f / DM) + EPS);
#pragma unroll
        for (int j = 0; j < 8; ++j) { const int o = 512 * j + 8 * lane;
            const f32x4 g0 = *(const f32x4*)(gpre + o), g1 = *(const f32x4*)(gpre + o + 4), s0 = *(const f32x4*)(scale + o), s1 = *(const f32x4*)(scale + o + 4), t0 = *(const f32x4*)(shift + o), t1 = *(const f32x4*)(shift + o + 4);
            const f32x4 a = v[2 * j] * rstd * g0 * (1.0f + s0) + t0, b = v[2 * j + 1] * rstd * g1 * (1.0f + s1) + t1;
            u32x4 w;
            if (HQ) { w.x = pk_bf16q(a[0], a[1]); w.y = pk_bf16q(a[2], a[3]); w.z = pk_bf16q(b[0], b[1]); w.w = pk_bf16q(b[2], b[3]); }
            else { w.x = pk_bf16(a[0], a[1]); w.y = pk_bf16(a[2], a[3]); w.z = pk_bf16(b[0], b[1]); w.w = pk_bf16(b[2], b[3]); }
            *(u32x4*)(hrow + o) = w; }
    }
}
__device__ __forceinline__ int mod_row_of(int m) { return m < NLAT ? (m >> 13) : 2; }
__device__ __forceinline__ const float* xin_row(Fr& F, int m) { return m < NLAT ? F.in[0] + (size_t)m * DM : F.in[2] + (size_t)(m - NLAT) * DM; }

__device__ __forceinline__ void p1_norm(Fr& F) {
    const int gw = F.bid * NWAVES + F.wave, NGW = F.G * NWAVES; const float* MOD = WSP(float, WS_MOD);
    for (int m = gw; m < MROWS; m += NGW) { const float* md = MOD + (size_t)mod_row_of(m) * NMOD;
        norm_mod_row(xin_row(F, m), F.in[6], md + 1 * DM, md + 0 * DM, WSP(bf16, WS_H) + (size_t)m * DM, F.lane); }
}
__device__ __forceinline__ void p4_resnorm(Fr& F) {
    const int gw = F.bid * NWAVES + F.wave, NGW = F.G * NWAVES; const float* MOD = WSP(float, WS_MOD);
    for (int m = gw; m < MROWS; m += NGW) { const float* md = MOD + (size_t)mod_row_of(m) * NMOD; const bf16* y = WSP(bf16, WS_Y) + (size_t)m * DM; bf16* h = WSP(bf16, WS_H) + (size_t)m * DM;
        if (m < NLAT) res_norm_row<true, true, false, false, true>(xin_row(F, m), y, WSP(bf16, WS_X1) + (size_t)m * DM, h, 0.5f, md + 2 * DM, F.in[7], F.in[6] + DM, md + 4 * DM, md + 3 * DM, F.lane);
        else res_norm_row<false, true, true>(xin_row(F, m), y, nullptr, h, 0.5f, md + 2 * DM, F.in[7], F.in[6] + DM, md + 4 * DM, md + 3 * DM, F.lane, WSP(float, WS_YCP) + (size_t)(m - NLAT) * DM); }
}
__device__ __forceinline__ void p12_resnorm(Fr& F) {
    const int gw = F.bid * NWAVES + F.wave, NGW = F.G * NWAVES; const float* MOD = WSP(float, WS_MOD);
    for (int m = gw; m < NLAT; m += NGW) { const float* md = MOD + (size_t)(m >> 13) * NMOD;
        const float rs = 1.0f / sqrtf(WSP(float, WS_ROWSS)[NLAT + m] * (1.0f / 2048.f) + EPS);
        res_norm_row<true, true, false, true, true, true>(WSP(bf16, WS_X1) + (size_t)m * DM, WSP(bf16, WS_Y) + (size_t)m * DM, WSP(bf16, WS_X1) + (size_t)m * DM, WSP(bf16, WS_H) + (size_t)m * DM, 1.0f, md + 5 * DM, F.in[7] + DM, F.in[6] + 2 * DM, md + 7 * DM, md + 6 * DM, F.lane, nullptr, rs); }
}
__device__ __forceinline__ void p15_final(Fr& F) {
    const int gw = F.bid * NWAVES + F.wave, NGW = F.G * NWAVES; const float* MOD = WSP(float, WS_MOD);
    for (int m = gw; m < NLAT; m += NGW) { const float* md = MOD + (size_t)(m >> 13) * NMOD;
        res_norm_row<true, false, false, true, false>(WSP(bf16, WS_X1) + (size_t)m * DM, WSP(bf16, WS_Y) + (size_t)m * DM, F.out + (size_t)m * DM, nullptr, 0.5f, md + 8 * DM, F.in[7] + 2 * DM, nullptr, nullptr, nullptr, F.lane); }
}
__device__ __forceinline__ void p10_merge(Fr& F) {
    const int gw = F.bid * NWAVES + F.wave, NGW = F.G * NWAVES;
    for (int m = gw; m < NLAT; m += NGW) {
        const bf16* a = WSP(bf16, WS_OATT) + (size_t)m * 2048; const bf16* s = WSP(bf16, WS_YS) + (size_t)m * 2048; bf16* h = WSP(bf16, WS_H) + (size_t)m * DM;
        u32x4 av[4], sv[4]; float sa = 0.f, ssm = 0.f;
#pragma unroll
        for (int j = 0; j < 4; ++j) { av[j] = *(const u32x4*)(a + 512 * j + 8 * F.lane); sv[j] = *(const u32x4*)(s + 512 * j + 8 * F.lane); }
#pragma unroll
        for (int j = 0; j < 4; ++j) { float f[8], q[8]; unpack8(av[j], f); unpack8(sv[j], q);
#pragma unroll
            for (int e = 0; e < 8; ++e) { sa += f[e] * f[e]; ssm += q[e] * q[e]; } }
        const float ra = 1.0f / sqrtf(wave_sum(sa) * (1.0f / 2048.f) + EPS), rs = 1.0f / sqrtf(wave_sum(ssm) * (1.0f / 2048.f) + EPS);
#pragma unroll
        for (int j = 0; j < 4; ++j) { float f[8], q[8]; unpack8(av[j], f); unpack8(sv[j], q);
            u32x4 w; w.x = pk_bf16(f[0] * ra, f[1] * ra); w.y = pk_bf16(f[2] * ra, f[3] * ra); w.z = pk_bf16(f[4] * ra, f[5] * ra); w.w = pk_bf16(f[6] * ra, f[7] * ra);
            *(u32x4*)(h + 512 * j + 8 * F.lane) = w;
            w.x = pk_bf16(q[0] * rs, q[1] * rs); w.y = pk_bf16(q[2] * rs, q[3] * rs); w.z = pk_bf16(q[4] * rs, q[5] * rs); w.w = pk_bf16(q[6] * rs, q[7] * rs);
            *(u32x4*)(h + 2048 + 512 * j + 8 * F.lane) = w; }
    }
}

__device__ __forceinline__ void p6_conv(Fr& F) {
    const int gw = F.bid * NWAVES + F.wave, NGW = F.G * NWAVES;
    const bf16* P = WSP(bf16, WS_P); bf16* XC = WSP(bf16, WS_XC); const float* cw = F.in[14]; const float* cb = F.in[15];
    u32x4 nxt[20];
#define CV_ROWS(itx) do { const int rb_ = (itx) / 6, cgi_ = (itx) - rb_ * 6, m0_ = rb_ * 16, c0_ = (cgi_ * 64 + F.lane) * 8; \
        int s0_, s1_; if (m0_ < NLAT) { s0_ = m0_ & ~(SEQ - 1); s1_ = s0_ + SEQ; } else { s0_ = NLAT + ((m0_ - NLAT) & ~(CTXL - 1)); s1_ = s0_ + CTXL; } \
        _Pragma("unroll") for (int r = 0; r < 20; ++r) { const int row = m0_ - 2 + r; const bool ok = row >= s0_ && row < s1_; const int rc = row < s0_ ? s0_ : (row >= s1_ ? s1_ - 1 : row); \
            const u32x4 v = *(const u32x4*)(P + (size_t)rc * NINP + PXBC + c0_); nxt[r] = ok ? v : (u32x4){0u, 0u, 0u, 0u}; } } while (0)
    if (gw < (MROWS / 16) * 6) CV_ROWS(gw);
    for (int it = gw; it < (MROWS / 16) * 6; it += NGW) {
        const int rb = it / 6, cgi = it - rb * 6, m0 = rb * 16, c0 = (cgi * 64 + F.lane) * 8;
        u32x4 raw[20];
#pragma unroll
        for (int r = 0; r < 20; ++r) raw[r] = nxt[r];
        if (it + NGW < (MROWS / 16) * 6) CV_ROWS(it + NGW);
        float w[5][8], bias[8];
#pragma unroll
        for (int k = 0; k < 5; ++k) { const f32x4 a = *(const f32x4*)(cw + k * XBCW + c0), b = *(const f32x4*)(cw + k * XBCW + c0 + 4);
            w[k][0] = a[0]; w[k][1] = a[1]; w[k][2] = a[2]; w[k][3] = a[3]; w[k][4] = b[0]; w[k][5] = b[1]; w[k][6] = b[2]; w[k][7] = b[3]; }
        { const f32x4 a = *(const f32x4*)(cb + c0), b = *(const f32x4*)(cb + c0 + 4); bias[0] = a[0]; bias[1] = a[1]; bias[2] = a[2]; bias[3] = a[3]; bias[4] = b[0]; bias[5] = b[1]; bias[6] = b[2]; bias[7] = b[3]; }
#pragma unroll
        for (int t = 0; t < 16; ++t) {
            float acc[8];
#pragma unroll
            for (int e = 0; e < 8; ++e) acc[e] = bias[e];
#pragma unroll
            for (int k = 0; k < 5; ++k) { float f[8]; unpack8(raw[t + k], f);
#pragma unroll
                for (int e = 0; e < 8; ++e) acc[e] += w[k][e] * f[e]; }
            u32x4 o; o.x = pk_bf16(silu_f(acc[0]), silu_f(acc[1])); o.y = pk_bf16(silu_f(acc[2]), silu_f(acc[3])); o.z = pk_bf16(silu_f(acc[4]), silu_f(acc[5])); o.w = pk_bf16(silu_f(acc[6]), silu_f(acc[7]));
            *(u32x4*)(XC + (size_t)(m0 + t) * XBCW + c0) = o;
        }
    }
#undef CV_ROWS
}

constexpr int AT_KS = 288, AT_VS = 144, AT_K_OFF = 0, AT_V_OFF = 64 * AT_KS, AT_STG = 64 * AT_KS + 128 * AT_VS;
__device__ __forceinline__ bool attn_tile(int idx, int b, int qb, int& rowbase, int& mt) {
    if (idx < 5) { const int kt = qb + idx - 2; mt = (idx == 0) ? -1 : ((idx == 4) ? 1 : 0); rowbase = b * SEQ + kt * 64; return kt >= 0 && kt < 128; }
    mt = 0; rowbase = NLAT + b * CTXL + (idx - 5) * 64; return true;
}
#ifndef AT_DEPHASE
#define AT_DEPHASE 1
#endif
template <int ABL, int ORD>
__device__ __forceinline__ void attn_unit(Fr& F, const int u, const bool doatom) {
    const bf16* P = WSP(bf16, WS_P); bf16* O = ABL ? WSP(bf16, WS_SLOC) : WSP(bf16, WS_H); float* SSA = WSP(float, WS_ROWSS);
    const int fr = F.lane & 15, g = F.lane >> 4, w = F.wave, hg = w >> 1, half = w & 1;
    const int srow = F.tid >> 3, sd0 = (F.tid & 7) * 16;
    const int vkp = F.tid >> 4, vdq = F.tid & 15;
    const int kfo = fr * AT_KS + 16 * g, vlo0 = fr * AT_VS + (4 * g) * 2, vlo1 = fr * AT_VS + ((4 * g) ^ 8) * 2;
    int vhi0 = vlo0, vhi1 = vlo1; asm volatile("" : "+v"(vhi0), "+v"(vhi1));
    {
        const int qb = u & 127, kvh = (u >> 7) & 3, b = u >> 9, head = kvh * 4 + hg;
        const int r0 = b * SEQ + qb * 64 + half * 32;
        bf16x8 qf[2][4];
#pragma unroll
        for (int m = 0; m < 2; ++m)
#pragma unroll
            for (int ks = 0; ks < 4; ++ks) qf[m][ks] = *(const bf16x8*)(P + (size_t)(r0 + 16 * m + fr) * NINP + PQ + head * 128 + 32 * ks + 8 * g);
        f32x4 accO[8][2];
#pragma unroll
        for (int n = 0; n < 8; ++n) { accO[n][0] = (f32x4){0.f, 0.f, 0.f, 0.f}; accO[n][1] = (f32x4){0.f, 0.f, 0.f, 0.f}; }
        const float sink = F.in[12][head] * LOG2E;
        float mrun[2] = {sink, sink}, lpart[2] = {g == 0 ? 1.0f : 0.0f, g == 0 ? 1.0f : 0.0f};
        int idx = 0, rowbase = 0, mt = 0;
        while (!attn_tile(idx, b, qb, rowbase, mt)) ++idx;
        int nidx = idx + 1, nrow = 0, nmt = 0;
        while (nidx < 9 && !attn_tile(nidx, b, qb, nrow, nmt)) ++nidx;
        u32x4 kr[2][2], vr[2][2];
#define AT_LOAD(rb, S_) do { const bf16* kp = P + (size_t)((rb) + srow) * NINP + PK + kvh * 128 + sd0; kr[S_][0] = *(const u32x4*)kp; kr[S_][1] = *(const u32x4*)(kp + 8); \
                         const bf16* vp = P + (size_t)((rb) + 2 * vkp) * NINP + PV + kvh * 128 + 8 * vdq; vr[S_][0] = *(const u32x4*)vp; vr[S_][1] = *(const u32x4*)(vp + NINP); } while (0)
#define AT_WRITE(st, S_) do { LAS unsigned char* kt_ = F.lds + (st) * AT_STG; LAS unsigned char* vt_ = kt_ + AT_V_OFF; \
            *(LAS u32x4*)(kt_ + srow * AT_KS + sd0 * 2) = kr[S_][0]; *(LAS u32x4*)(kt_ + srow * AT_KS + sd0 * 2 + 16) = kr[S_][1]; \
            const unsigned va_[4] = {vr[S_][0].x, vr[S_][0].y, vr[S_][0].z, vr[S_][0].w}, vb2_[4] = {vr[S_][1].x, vr[S_][1].y, vr[S_][1].z, vr[S_][1].w}; const int vsw_ = ((2 * vkp) ^ (8 * (vdq >> 1))) * 2;     \
            _Pragma("unroll") for (int j = 0; j < 4; ++j) { *(LAS unsigned*)(vt_ + (8 * vdq + 2 * j) * AT_VS + vsw_) = __builtin_amdgcn_perm(vb2_[j], va_[j], 0x05040100u); *(LAS unsigned*)(vt_ + (8 * vdq + 2 * j + 1) * AT_VS + vsw_) = __builtin_amdgcn_perm(vb2_[j], va_[j], 0x07060302u); } } while (0)
        int n2 = (nidx < 9) ? nidx + 1 : 9, n2row = 0, n2mt = 0;
        while (n2 < 9 && !attn_tile(n2, b, qb, n2row, n2mt)) ++n2;
        AT_LOAD(rowbase, 0);
        if (nidx < 9) AT_LOAD(nrow, 1);
        __syncthreads();
        AT_WRITE(0, 0);
        if (n2 < 9) AT_LOAD(n2row, 0);
        __syncthreads();
        int st = 0;
        bf16x8 pf[2][2];
        LAS unsigned char* VTp = F.lds + AT_V_OFF;
        if (ORD) {
#pragma unroll
            for (int m = 0; m < 2; ++m)
#pragma unroll
                for (int s = 0; s < 2; ++s) pf[m][s] = (bf16x8){0, 0, 0, 0, 0, 0, 0, 0}; }
        for (;;) {
#pragma unroll
          for (int par = 0; par < 2; ++par) {
            LAS unsigned char* Kt = F.lds + st * AT_STG; LAS unsigned char* VT = Kt + AT_V_OFF;
#define AT_KF(n, ks) (*(const LAS bf16x8*)(Kt + kfo + (16 * (n)) * AT_KS + (32 * (ks)) * 2))
#define AT_VF(i, dst) do { const LAS unsigned char* vb_ = VT + ((((i) & 7) & 1) ? vlo1 : vlo0) + (16 * ((i) & 7)) * AT_VS; const LAS unsigned char* vc_ = VT + ((((i) & 7) & 1) ? vhi1 : vhi0) + (16 * ((i) & 7)) * AT_VS; \
                const u32x2 v0_ = *(const LAS u32x2*)(vb_ + ((32 * ((i) >> 3)) ^ ((8 * ((i) & 7)) & 48)) * 2), v1_ = *(const LAS u32x2*)(vc_ + ((32 * ((i) >> 3) + 16) ^ ((8 * ((i) & 7)) & 48)) * 2); \
                dst = __builtin_bit_cast(bf16x8, (u32x4){v0_.x, v0_.y, v1_.x, v1_.y}); } while (0)
#define AT_QK(M0, M1) \
            f32x4 accS[4][2]; \
            _Pragma("unroll") for (int n = 0; n < 4; ++n) _Pragma("unroll") for (int m = M0; m < M1; ++m) accS[n][m] = (f32x4){0.f, 0.f, 0.f, 0.f}; \
            bf16x8 kf[2][4]; \
            _Pragma("unroll") for (int n = 0; n < 4; ++n) kf[0][n] = AT_KF(n, 0); \
            __builtin_amdgcn_s_setprio(1); \
            _Pragma("unroll") for (int ks = 0; ks < 4; ++ks) { \
                if (ks < 3) { _Pragma("unroll") for (int n = 0; n < 4; ++n) kf[(ks + 1) & 1][n] = AT_KF(n, ks + 1); } \
                __builtin_amdgcn_sched_barrier(0); \
                _Pragma("unroll") for (int n = 0; n < 4; ++n) _Pragma("unroll") for (int m = M0; m < M1; ++m) accS[n][m] = __builtin_amdgcn_mfma_f32_16x16x32_bf16(kf[ks & 1][n], qf[m][ks], accS[n][m], 0, 0, 0); \
                __builtin_amdgcn_sched_barrier(0); } \
            __builtin_amdgcn_s_setprio(0);
#define AT_VPRE() \
            if (ABL != 2) { _Pragma("unroll") for (int i = 0; i < 3; ++i) AT_VF(i, vq[i]); }     \
            __builtin_amdgcn_sched_barrier(0);
#define AT_SMX(M0, M1) \
            if (mt != 0) {   \
                _Pragma("unroll") for (int m = M0; m < M1; ++m) { const int ii = half * 32 + 16 * m + fr; \
                    _Pragma("unroll") for (int n = 0; n < 4; ++n) _Pragma("unroll") for (int r = 0; r < 4; ++r) { const int jj = 16 * n + 4 * g + r; const bool ok = (mt < 0) ? (jj >= ii) : (jj <= ii); if (!ok) accS[n][m][r] = -1e30f; } } } \
            _Pragma("unroll") for (int m = M0; m < M1; ++m) { \
                if (ABL == 0) { \
                    float mx = __builtin_fmaxf(__builtin_fmaxf(accS[0][m][0], accS[0][m][1]), __builtin_fmaxf(accS[0][m][2], accS[0][m][3])); \
                    _Pragma("unroll") for (int n = 1; n < 4; ++n) { mx = __builtin_fmaxf(__builtin_fmaxf(mx, accS[n][m][0]), accS[n][m][1]); mx = __builtin_fmaxf(__builtin_fmaxf(mx, accS[n][m][2]), accS[n][m][3]); } \
                    mx = row_max(mx); \
                    const float mn = __any(mx > mrun[m] + 8.0f) ? fmaxf(mrun[m], mx) : mrun[m];     \
                    const float alpha = __builtin_amdgcn_exp2f(mrun[m] - mn); mrun[m] = mn; \
                    f32x4 ps4 = (f32x4){0.f, 0.f, 0.f, 0.f}; \
                    _Pragma("unroll") for (int n = 0; n < 4; ++n) { const f32x4 d = accS[n][m] - mn; f32x4 pv; \
                        pv[0] = __builtin_amdgcn_exp2f(d[0]); pv[1] = __builtin_amdgcn_exp2f(d[1]); pv[2] = __builtin_amdgcn_exp2f(d[2]); pv[3] = __builtin_amdgcn_exp2f(d[3]); \
                        accS[n][m] = pv; ps4 += pv; } \
                    lpart[m] = lpart[m] * alpha + ((ps4[0] + ps4[1]) + (ps4[2] + ps4[3])); \
                    if (!__all(alpha == 1.0f)) { _Pragma("unroll") for (int n = 0; n < 8; ++n) accO[n][m] *= alpha; } \
                } \
                _Pragma("unroll") for (int s = 0; s < 2; ++s) { u32x4 t; t.x = pk_bf16(accS[2 * s][m][0], accS[2 * s][m][1]); t.y = pk_bf16(accS[2 * s][m][2], accS[2 * s][m][3]); \
                    t.z = pk_bf16(accS[2 * s + 1][m][0], accS[2 * s + 1][m][1]); t.w = pk_bf16(accS[2 * s + 1][m][2], accS[2 * s + 1][m][3]); pf[m][s] = __builtin_bit_cast(bf16x8, t); } }
#define AT_PVX(M0, M1) \
            __builtin_amdgcn_sched_barrier(0); \
            __builtin_amdgcn_s_setprio(1); \
            if (ABL != 2) { _Pragma("unroll") for (int i = 0; i < 16; ++i) { \
                if (i + 3 < 16) AT_VF(i + 3, vq[(i + 3) % 6]);     \
                __builtin_amdgcn_sched_barrier(0); \
                _Pragma("unroll") for (int m = M0; m < M1; ++m) accO[i & 7][m] = __builtin_amdgcn_mfma_f32_16x16x32_bf16(vq[i % 6], pf[m][i >> 3], accO[i & 7][m], 0, 0, 0); \
                __builtin_amdgcn_sched_barrier(0); } } \
            __builtin_amdgcn_s_setprio(0);
            bf16x8 vq[6];
            if (ORD == 0) { AT_QK(0, 2); AT_VPRE(); AT_SMX(0, 2); AT_PVX(0, 2); }
            else {
                { LAS unsigned char* VT = VTp; AT_VPRE(); AT_PVX(0, 2); }
                AT_QK(0, 2); AT_SMX(0, 2);
                VTp = VT; }
            if (nidx >= 9) goto at_done;
            const int sn = (st == 2) ? 0 : st + 1;
            AT_WRITE(sn, par ^ 1);
            int n3 = (n2 < 9) ? n2 + 1 : 9, n3row = 0, n3mt = 0;
            while (n3 < 9 && !attn_tile(n3, b, qb, n3row, n3mt)) ++n3;
            if (n3 < 9) AT_LOAD(n3row, par ^ 1);
            __syncthreads();
            st = sn; mt = nmt; nidx = n2; nmt = n2mt; n2 = n3; n2mt = n3mt;
          }
        }
        at_done:
        if (ORD) { bf16x8 vq[6]; LAS unsigned char* VT = VTp; AT_VPRE(); AT_PVX(0, 2); }
#undef AT_QK
#undef AT_VPRE
#undef AT_SMX
#undef AT_PVX
#undef AT_VF
#undef AT_KF
#undef AT_LOAD
#undef AT_WRITE
#pragma unroll
        for (int m = 0; m < 2; ++m) {
            const float l = row_sum(lpart[m]), inv = 1.0f / l;
            bf16* op = O + (size_t)(r0 + 16 * m + fr) * DM + head * 128 + 4 * g; float ss = 0.f;
#pragma unroll
            for (int n = 0; n < 8; ++n) { const f32x4 o = accO[n][m] * inv; ss += (o[0] * o[0] + o[1] * o[1]) + (o[2] * o[2] + o[3] * o[3]);
                u32x2 t; t.x = pk_bf16(o[0], o[1]); t.y = pk_bf16(o[2], o[3]); *(u32x2*)(op + 16 * n) = t; }
            ss = row_sum(ss);
            if (g == 0 && doatom) __hip_atomic_fetch_add(SSA + r0 + 16 * m + fr, ss, __ATOMIC_RELAXED, __HIP_MEMORY_SCOPE_AGENT);
        }
    }
}
template <int ABL = 0>
__device__ __forceinline__ void p6_attn(Fr& F, bool doatom = true) {
    for (int u = F.bid; u < 1024; u += F.G) { if (AT_DEPHASE && F.wave < 4) attn_unit<ABL, 1>(F, u, doatom); else attn_unit<ABL, 0>(F, u, doatom); }
    __syncthreads();
}
__device__ __forceinline__ void chunk_scan(const float* dtp  , float a, bool rev, int lane, int& t0, int& t1, float& d0, float& d1, float& c0, float& c1, float& total) {
    t0 = rev ? 127 - 2 * lane : 2 * lane; t1 = rev ? 126 - 2 * lane : 2 * lane + 1;
    d0 = dtp[(size_t)t0 * 32]; d1 = dtp[(size_t)t1 * 32];
    const float v0 = d0 * a, v1 = d1 * a; float s = v0 + v1;
#pragma unroll
    for (int o = 1; o < 64; o <<= 1) { const float t = __shfl_up(s, o); if (lane >= o) s += t; }
    const float ex = s - (v0 + v1); c0 = ex + v0; c1 = s; total = __shfl(s, 63);
}
constexpr int SS = 272;
__device__ __forceinline__ int sc_row0(int sc) { return sc < 128 ? sc * 128 : NLAT + (sc - 128) * 128; }

__device__ __forceinline__ void p7_states(Fr& F) {
    const bf16* XC = WSP(bf16, WS_XC); bf16* SL = WSP(bf16, WS_SLOC); float* DEC = WSP(float, WS_DEC);
    const int fr = F.lane & 15, g4 = F.lane >> 4, w = F.wave;
    LAS unsigned char* BT = F.lds; LAS unsigned char* XTf = F.lds + 34816; LAS unsigned char* XTb = F.lds + 52224; LAS float* WF = (LAS float*)(F.lds + 69632); LAS float* WB = WF + 8 * 128;
    const int sj = F.tid >> 2, sps = (F.tid & 3) * 16;
    for (int u = F.bid; u < 512 + 64; u += F.G) {
        const int uq = u - 512;
        const int grp = (u < 512) ? (u & 3) : ((uq >> 2) & 3), sc = (u < 512) ? (u >> 2) : (128 + (uq >> 4)), m0 = sc_row0(sc);
        const int h_lo = (u < 512) ? 0 : (uq & 3) * 2, h_hi = (u < 512) ? 8 : h_lo + 2;
        __syncthreads();
        { const int ns = (F.tid & 3) * 32; const bf16* bp = XC + (size_t)(m0 + sj) * XBCW + 2048 + grp * 128 + ns;
#pragma unroll
          for (int q = 0; q < 4; ++q) { const u32x4 v = *(const u32x4*)(bp + 8 * q); const unsigned vw[4] = {v.x, v.y, v.z, v.w};
#pragma unroll
              for (int e = 0; e < 4; ++e) { *(LAS unsigned short*)(BT + (ns + 8 * q + 2 * e) * SS + sj * 2) = (unsigned short)(vw[e] & 0xffffu); *(LAS unsigned short*)(BT + (ns + 8 * q + 2 * e + 1) * SS + sj * 2) = (unsigned short)(vw[e] >> 16); } } }
        if (w >= h_lo && w < h_hi) { const int h = grp * 8 + w;
#pragma unroll
          for (int dir = 0; dir < 2; ++dir) { const float a = -__expf(F.in[16][dir * 32 + h]); int t0, t1; float d0, d1, c0, c1, tot;
              chunk_scan(WSP(float, dir ? WS_DTB : WS_DTF) + (size_t)m0 * 32 + h, a, dir == 1, F.lane, t0, t1, d0, d1, c0, c1, tot);
              LAS float* wa = (dir ? WB : WF) + w * 128; wa[t0] = __expf(tot - c0) * d0; wa[t1] = __expf(tot - c1) * d1;
              if (F.lane == 0) DEC[(sc * 2 + dir) * 32 + h] = __expf(tot); } }
        u32x4 xr[2];
        { const bf16* xp = XC + (size_t)(m0 + sj) * XBCW + (grp * 8 + h_lo) * 64 + sps; xr[0] = *(const u32x4*)xp; xr[1] = *(const u32x4*)(xp + 8); }
        __syncthreads();
        for (int hh = h_lo; hh < h_hi; ++hh) {
            const int h = grp * 8 + hh;
            { const float wf = WF[hh * 128 + sj], wb = WB[hh * 128 + sj];
#pragma unroll
              for (int q = 0; q < 2; ++q) { float f[8]; unpack8(xr[q], f);
#pragma unroll
                  for (int e = 0; e < 8; ++e) { *(LAS unsigned short*)(XTf + (sps + 8 * q + e) * SS + sj * 2) = f2bf(f[e] * wf); *(LAS unsigned short*)(XTb + (sps + 8 * q + e) * SS + sj * 2) = f2bf(f[e] * wb); } } }
            __syncthreads();
            if (hh < h_hi - 1) { const bf16* xp = XC + (size_t)(m0 + sj) * XBCW + (h + 1) * 64 + sps; xr[0] = *(const u32x4*)xp; xr[1] = *(const u32x4*)(xp + 8); }
            const int pt = w & 3, ntb = (w >> 2) * 4;
            f32x4 aF[4], aB[4];
#pragma unroll
            for (int n = 0; n < 4; ++n) { aF[n] = (f32x4){0.f, 0.f, 0.f, 0.f}; aB[n] = (f32x4){0.f, 0.f, 0.f, 0.f}; }
#pragma unroll
            for (int ks = 0; ks < 4; ++ks) {
                const bf16x8 xf = *(const LAS bf16x8*)(XTf + (16 * pt + fr) * SS + (32 * ks + 8 * g4) * 2), xb = *(const LAS bf16x8*)(XTb + (16 * pt + fr) * SS + (32 * ks + 8 * g4) * 2);
#pragma unroll
                for (int n = 0; n < 4; ++n) { const bf16x8 bt = *(const LAS bf16x8*)(BT + (16 * (ntb + n) + fr) * SS + (32 * ks + 8 * g4) * 2);
                    aF[n] = __builtin_amdgcn_mfma_f32_16x16x32_bf16(bt, xf, aF[n], 0, 0, 0); aB[n] = __builtin_amdgcn_mfma_f32_16x16x32_bf16(bt, xb, aB[n], 0, 0, 0); }
            }
            bf16* sf = SL + ((size_t)(sc * 2 + 0) * 32 + h) * 8192 + (16 * pt + fr) * 128 + 4 * g4; bf16* sb = SL + ((size_t)(sc * 2 + 1) * 32 + h) * 8192 + (16 * pt + fr) * 128 + 4 * g4;
#pragma unroll
            for (int n = 0; n < 4; ++n) { u32x2 o; o.x = pk_bf16(aF[n][0], aF[n][1]); o.y = pk_bf16(aF[n][2], aF[n][3]); *(u32x2*)(sf + 16 * (ntb + n)) = o;
                o.x = pk_bf16(aB[n][0], aB[n][1]); o.y = pk_bf16(aB[n][2], aB[n][3]); *(u32x2*)(sb + 16 * (ntb + n)) = o; }
            __syncthreads();
        }
    }
}

__device__ __forceinline__ void p8_scan(Fr& F) {
    const bf16* SL = WSP(bf16, WS_SLOC); const float* DEC = WSP(float, WS_DEC); bf16* HIN = WSP(bf16, WS_HIN);
    for (int e = F.bid * NTHR + F.tid; e < 2 * 2 * 32 * 1024; e += F.G * NTHR) {
        const int el = (e & 1023) * 8, h = (e >> 10) & 31, dir = (e >> 15) & 1, b = e >> 16;
        const int sA = 128 + 2 * b + (dir ? 1 : 0), sB = 128 + 2 * b + (dir ? 0 : 1);
        float fa[8], fb[8], hc[8];
        unpack8(*(const u32x4*)(SL + ((size_t)(sA * 2 + dir) * 32 + h) * 8192 + el), fa); unpack8(*(const u32x4*)(SL + ((size_t)(sB * 2 + dir) * 32 + h) * 8192 + el), fb);
        const float db = DEC[(sB * 2 + dir) * 32 + h];
#pragma unroll
        for (int q = 0; q < 8; ++q) hc[q] = fb[q] + db * fa[q];
        u32x4 qs[8]; float qd[8];
#define P8_LD(cc_, slot_) do { const int c_ = dir ? 63 - (cc_) : (cc_), sc_ = b * 64 + c_; qs[slot_] = *(const u32x4*)(SL + ((size_t)(sc_ * 2 + dir) * 32 + h) * 8192 + el); qd[slot_] = DEC[(sc_ * 2 + dir) * 32 + h]; } while (0)
#pragma unroll
        for (int i = 0; i < 8; ++i) P8_LD(i, i);
        for (int cb = 0; cb < 64; cb += 8)
#pragma unroll
        for (int j = 0; j < 8; ++j) { const int cc = cb + j;
            const int c = dir ? 63 - cc : cc, sc = b * 64 + c; const size_t off = ((size_t)(sc * 2 + dir) * 32 + h) * 8192 + el;
            float s[8]; unpack8(qs[j], s); const float d = qd[j];
            if (cc + 8 < 64) P8_LD(cc + 8, j);
            u32x4 o; o.x = pk_bf16(hc[0], hc[1]); o.y = pk_bf16(hc[2], hc[3]); o.z = pk_bf16(hc[4], hc[5]); o.w = pk_bf16(hc[6], hc[7]);
            *(u32x4*)(HIN + off) = o;
#pragma unroll
            for (int q = 0; q < 8; ++q) hc[q] = d * hc[q] + s[q];
        }
#undef P8_LD
    }
}

__device__ __forceinline__ void p9_ssd_out(Fr& F, bool doatom = true) {
    const bf16* XC = WSP(bf16, WS_XC); const bf16* P = WSP(bf16, WS_P); const bf16* HIN = WSP(bf16, WS_HIN); bf16* YS = WSP(bf16, WS_H) + 2048; float* SSS = WSP(float, WS_ROWSS) + NLAT;
    const int fr = F.lane & 15, g4 = F.lane >> 4, w = F.wave;
    LAS unsigned char* Cs = F.lds; LAS unsigned char* Bm = F.lds + 34816;
    LAS unsigned char* XT = F.lds + 34816; LAS unsigned char* Hf = F.lds + 52224; LAS unsigned char* Hb = F.lds + 69632;
    LAS float* ACF = (LAS float*)(F.lds + 87040); LAS float* ACB = ACF + 1024; LAS float* DFA = ACF + 2048; LAS float* DBA = ACF + 3072;
    const int sj = F.tid >> 2, sps = (F.tid & 3) * 16, hp = F.tid >> 3, hn0 = (F.tid & 7) * 16;
    for (int u = F.bid; u < 512; u += F.G) {
        const int grp = u & 3, sc = u >> 2, m0 = sc * 128;
        __syncthreads();
        { const int ns = (F.tid & 3) * 32; const bf16* bp = XC + (size_t)(m0 + sj) * XBCW + 2048 + grp * 128 + ns; const bf16* cp = bp + 512;
#pragma unroll
          for (int q = 0; q < 4; ++q) { *(LAS u32x4*)(Bm + sj * SS + (ns + 8 * q) * 2) = *(const u32x4*)(bp + 8 * q); *(LAS u32x4*)(Cs + sj * SS + (ns + 8 * q) * 2) = *(const u32x4*)(cp + 8 * q); } }
        { const int h = grp * 8 + w;
#pragma unroll
          for (int dir = 0; dir < 2; ++dir) { const float a = -__expf(F.in[16][dir * 32 + h]); int t0, t1; float d0, d1, c0, c1, tot;
              chunk_scan(WSP(float, dir ? WS_DTB : WS_DTF) + (size_t)m0 * 32 + h, a, dir == 1, F.lane, t0, t1, d0, d1, c0, c1, tot);
              LAS float* ca = (dir ? ACB : ACF) + w * 128; LAS float* da = (dir ? DBA : DFA) + w * 128; ca[t0] = c0; ca[t1] = c1; da[t0] = d0; da[t1] = d1; } }
        __syncthreads();
        bf16x8 cfr[4]; f32x4 G[8];
#pragma unroll
        for (int ks = 0; ks < 4; ++ks) cfr[ks] = *(const LAS bf16x8*)(Cs + (16 * w + fr) * SS + (32 * ks + 8 * g4) * 2);
#pragma unroll
        for (int n = 0; n < 8; ++n) { G[n] = (f32x4){0.f, 0.f, 0.f, 0.f};
#pragma unroll
            for (int ks = 0; ks < 4; ++ks) { const bf16x8 bf = *(const LAS bf16x8*)(Bm + (16 * n + fr) * SS + (32 * ks + 8 * g4) * 2); G[n] = __builtin_amdgcn_mfma_f32_16x16x32_bf16(bf, cfr[ks], G[n], 0, 0, 0); } }
        const int i = 16 * w + fr;
        float rowss = 0.f;
        u32x4 xr[2], hfr[2], hbr[2];
        { const int h = grp * 8; const bf16* xp = XC + (size_t)(m0 + sj) * XBCW + h * 64 + sps; xr[0] = *(const u32x4*)xp; xr[1] = *(const u32x4*)(xp + 8);
          const bf16* hf = HIN + ((size_t)(sc * 2 + 0) * 32 + h) * 8192 + hp * 128 + hn0; const bf16* hb = HIN + ((size_t)(sc * 2 + 1) * 32 + h) * 8192 + hp * 128 + hn0;
          hfr[0] = *(const u32x4*)hf; hfr[1] = *(const u32x4*)(hf + 8); hbr[0] = *(const u32x4*)hb; hbr[1] = *(const u32x4*)(hb + 8); }
        u32x2 zn[4];
#define P9_ZLD(hd) do { _Pragma("unroll") for (int pt = 0; pt < 4; ++pt) zn[pt] = *(const u32x2*)(P + (size_t)(m0 + i) * NINP + PZ + (grp * 8 + (hd)) * 64 + 16 * pt + 4 * g4); } while (0)
        P9_ZLD(0);
        __syncthreads();
        for (int hh = 0; hh < 8; ++hh) {
            const int h = grp * 8 + hh;
            {
#pragma unroll
              for (int q = 0; q < 2; ++q) { const unsigned vw[4] = {xr[q].x, xr[q].y, xr[q].z, xr[q].w};
#pragma unroll
                  for (int e = 0; e < 4; ++e) { *(LAS unsigned short*)(XT + (sps + 8 * q + 2 * e) * SS + sj * 2) = (unsigned short)(vw[e] & 0xffffu); *(LAS unsigned short*)(XT + (sps + 8 * q + 2 * e + 1) * SS + sj * 2) = (unsigned short)(vw[e] >> 16); } }
              *(LAS u32x4*)(Hf + hp * SS + hn0 * 2) = hfr[0]; *(LAS u32x4*)(Hf + hp * SS + hn0 * 2 + 16) = hfr[1];
              *(LAS u32x4*)(Hb + hp * SS + hn0 * 2) = hbr[0]; *(LAS u32x4*)(Hb + hp * SS + hn0 * 2 + 16) = hbr[1]; }
            __syncthreads();
            if (hh < 7) { const bf16* xp = XC + (size_t)(m0 + sj) * XBCW + (h + 1) * 64 + sps; xr[0] = *(const u32x4*)xp; xr[1] = *(const u32x4*)(xp + 8);
                const bf16* hf = HIN + ((size_t)(sc * 2 + 0) * 32 + h + 1) * 8192 + hp * 128 + hn0; const bf16* hb = HIN + ((size_t)(sc * 2 + 1) * 32 + h + 1) * 8192 + hp * 128 + hn0;
                hfr[0] = *(const u32x4*)hf; hfr[1] = *(const u32x4*)(hf + 8); hbr[0] = *(const u32x4*)hb; hbr[1] = *(const u32x4*)(hb + 8); }
            bf16x8 xq[2], hfq[2], hbq[2];
#define P9_LD(st_) do { const int pt_ = (st_) >> 2, s_ = (st_) & 3; \
                const u32x2 v0_ = *(const LAS u32x2*)(XT + (16 * pt_ + fr) * SS + (32 * s_ + 4 * g4) * 2), v1_ = *(const LAS u32x2*)(XT + (16 * pt_ + fr) * SS + (32 * s_ + 16 + 4 * g4) * 2); \
                xq[(st_) & 1] = __builtin_bit_cast(bf16x8, (u32x4){v0_.x, v0_.y, v1_.x, v1_.y}); \
                hfq[(st_) & 1] = *(const LAS bf16x8*)(Hf + (16 * pt_ + fr) * SS + (32 * s_ + 8 * g4) * 2); hbq[(st_) & 1] = *(const LAS bf16x8*)(Hb + (16 * pt_ + fr) * SS + (32 * s_ + 8 * g4) * 2); } while (0)
            u32x2 zv[4];
#pragma unroll
            for (int pt = 0; pt < 4; ++pt) zv[pt] = zn[pt];
            if (hh < 7) P9_ZLD(hh + 1);
            const LAS float* acf = ACF + hh * 128; const LAS float* acb = ACB + hh * 128; const LAS float* dfa = DFA + hh * 128; const LAS float* dba = DBA + hh * 128;
            const float aif = acf[i], aib = acb[i];
            bf16x8 pf[4];
#pragma unroll
            for (int s = 0; s < 4; ++s) { unsigned pw[4];
#pragma unroll
                for (int t = 0; t < 2; ++t) { const int n = 2 * s + t, j0 = 16 * n + 4 * g4;
                    float gw[4];
                    if (n < w) {
                        const f32x4 cf = *(const LAS f32x4*)(acf + j0), df = *(const LAS f32x4*)(dfa + j0);
#pragma unroll
                        for (int r = 0; r < 4; ++r) gw[r] = G[n][r] * (__expf(aif - cf[r]) * df[r]);
                    } else if (n > w) {
                        const f32x4 cb = *(const LAS f32x4*)(acb + j0), db = *(const LAS f32x4*)(dba + j0);
#pragma unroll
                        for (int r = 0; r < 4; ++r) gw[r] = G[n][r] * (__expf(aib - cb[r]) * db[r]);
                    } else {
                        const f32x4 cf = *(const LAS f32x4*)(acf + j0), cb = *(const LAS f32x4*)(acb + j0), df = *(const LAS f32x4*)(dfa + j0), db = *(const LAS f32x4*)(dba + j0);
#pragma unroll
                        for (int r = 0; r < 4; ++r) { const int j = j0 + r;
                            const float wf = (j <= i) ? __expf(aif - cf[r]) * df[r] : 0.f, wb = (j >= i) ? __expf(aib - cb[r]) * db[r] : 0.f;
                            gw[r] = G[n][r] * (wf + wb); }
                    }
                    pw[2 * t] = pk_bf16(gw[0], gw[1]); pw[2 * t + 1] = pk_bf16(gw[2], gw[3]); }
                pf[s] = __builtin_bit_cast(bf16x8, (u32x4){pw[0], pw[1], pw[2], pw[3]}); }
            const float ef = __expf(aif), eb = __expf(aib), dsk = F.in[18][h];
#pragma unroll
            for (int hf2 = 0; hf2 < 2; ++hf2) {
                f32x4 aY[2], aF[2], aB[2];
#pragma unroll
                for (int q = 0; q < 2; ++q) { aY[q] = (f32x4){0.f, 0.f, 0.f, 0.f}; aF[q] = aY[q]; aB[q] = aY[q]; }
                P9_LD(8 * hf2);
                __builtin_amdgcn_s_setprio(1);
#pragma unroll
                for (int st = 8 * hf2; st < 8 * hf2 + 8; ++st) {
                    if (st + 1 < 8 * hf2 + 8) P9_LD(st + 1);
                    __builtin_amdgcn_sched_barrier(0);
                    aY[(st >> 2) & 1] = __builtin_amdgcn_mfma_f32_16x16x32_bf16(xq[st & 1], pf[st & 3], aY[(st >> 2) & 1], 0, 0, 0);
                    aF[(st >> 2) & 1] = __builtin_amdgcn_mfma_f32_16x16x32_bf16(hfq[st & 1], cfr[st & 3], aF[(st >> 2) & 1], 0, 0, 0); aB[(st >> 2) & 1] = __builtin_amdgcn_mfma_f32_16x16x32_bf16(hbq[st & 1], cfr[st & 3], aB[(st >> 2) & 1], 0, 0, 0);
                    __builtin_amdgcn_sched_barrier(0);
                }
                __builtin_amdgcn_s_setprio(0);
#pragma unroll
                for (int q = 0; q < 2; ++q) { const int pt = 2 * hf2 + q, col = h * 64 + 16 * pt + 4 * g4;
                    const LAS unsigned char* xtp = XT + (16 * pt + 4 * g4) * SS + i * 2;
                    const float x4[4] = {__uint_as_float((unsigned)*(const LAS unsigned short*)xtp << 16), __uint_as_float((unsigned)*(const LAS unsigned short*)(xtp + SS) << 16),
                                         __uint_as_float((unsigned)*(const LAS unsigned short*)(xtp + 2 * SS) << 16), __uint_as_float((unsigned)*(const LAS unsigned short*)(xtp + 3 * SS) << 16)};
                    const float z4[4] = {bf_lo(zv[pt].x), bf_hi(zv[pt].x), bf_lo(zv[pt].y), bf_hi(zv[pt].y)};
                    float y4[4];
#pragma unroll
                    for (int r = 0; r < 4; ++r) { y4[r] = (aY[q][r] + ef * aF[q][r] + eb * aB[q][r] + dsk * x4[r]) * silu_f(z4[r]); rowss += y4[r] * y4[r]; }
                    u32x2 o; o.x = pk_bf16(y4[0], y4[1]); o.y = pk_bf16(y4[2], y4[3]); *(u32x2*)(YS + (size_t)(m0 + i) * DM + col) = o; }
            }
#undef P9_LD
#undef P9_ZLD
            __syncthreads();
        }
        rowss = row_sum(rowss);
        if (g4 == 0 && doatom) __hip_atomic_fetch_add(SSS + m0 + i, rowss, __ATOMIC_RELAXED, __HIP_MEMORY_SCOPE_AGENT);
    }
}
#ifndef MK_PER_PHASE
#define MK_PER_PHASE 0
#endif
constexpr int N_PHASES = 16;
#ifndef WGM_DOWN
#define WGM_DOWN 2
#endif
#ifndef PROBE_MASK
#define PROBE_MASK 0
#endif
#define REP(k) _Pragma("unroll") for (int _rep = 0; _rep < (((PROBE_MASK >> (k)) & 1) ? 2 : 1); ++_rep)
struct Args { const float* in[21]; float* out; unsigned char* ws; int ph_lo, ph_hi, li, pad; };
__global__ void __launch_bounds__(NTHR, 2) fwd(Args args) {
    extern __shared__ __attribute__((aligned(16))) unsigned char lds_raw[];
    Fr F;
    F.lds = (LAS unsigned char*)lds_raw;
    F.tid = threadIdx.x; F.lane = F.tid & 63; F.wave = __builtin_amdgcn_readfirstlane(F.tid >> 6);
    F.G = gridDim.x; F.bid = blockIdx.x;
#pragma unroll
    for (int i = 0; i < 21; ++i) F.in[i] = args.in[i];
    F.out = args.out; F.ws = args.ws;
    volatile LAS unsigned* MISC = (volatile LAS unsigned*)(F.lds + MISC_OFF);
    if (F.tid < 32) MISC[F.tid] = 0u;
    __syncthreads();
    unsigned* ctl = (unsigned*)(F.ws + WS_CTL);
    XcdBarrier bar = xcd_barrier_post(ctl + CW_BAR + args.li * XCD_BAR_WORDS, MISC + 8);
    const int lo = args.ph_lo, hi = args.ph_hi;
#define IN(k) (lo <= (k) && (k) < hi)
#define SEAM(k) do { if (IN(k) && IN((k) + 1)) xcd_barrier(bar); } while (0)
    LAS unsigned char* ring = F.lds;

    if (IN(0)) REP(0) { p0_prologue(F, _rep); } SEAM(0);
    if (IN(1)) REP(1) { p1_norm(F); } SEAM(1);
    if (IN(2)) REP(2) {
        pg8::Gemm g{WSP(bf16, WS_H), WSP(bf16, WS_WGU0), MROWS, NGU, DM}; pg8::HalfNOrder S; S.init(MROWS, F.G, F.bid);
        pg8::EpiSwiGLU E{WSP(bf16, WS_ACT), FF};
        pg8::gemm_phase<pg8::EpiSwiGLU, pg8::HalfNOrder, true, true>(ring, g, S, E);
        if (_rep == 0) conv_queue(F, CW_Q2, CV_Q2_LO, CV_Q2_HI);
    } SEAM(2);
    if (IN(3)) REP(3) {
        pg8::Gemm g{WSP(bf16, WS_ACT), WSP(bf16, WS_WD0), MROWS, DM, FF};
        { pg8::StaticOrder S; S.init(NLAT, DM, FF, F.G, F.bid, WGM_DOWN); pg8::EpiPlain E{WSP(bf16, WS_Y), DM};
          pg8::gemm_phase<pg8::EpiPlain, pg8::StaticOrder, true, true>(ring, g, S, E); }
        { pg8::CtxSplitOrder S; S.init(F.G, F.bid); pg8::EpiSplitF32 E{WSP(float, WS_YCP), DM};
          pg8::gemm_phase<pg8::EpiSplitF32, pg8::CtxSplitOrder, true, true>(ring, g, S, E); }
    } SEAM(3);
    if (IN(4)) REP(4) { p4_resnorm(F); } SEAM(4);
    if (IN(5)) REP(5) {
        pg8::Gemm g{WSP(bf16, WS_H), WSP(bf16, WS_WIN), MROWS, NINP, DM}; pg8::InProjOrder S; S.init(F.G, F.bid);
        pg8::EpiInProj E{WSP(bf16, WS_P), NINP, WSP(float, WS_DTF), WSP(float, WS_DTB), WSP(float, WS_ROPE), WSP(float, WS_ROPE) + 4096, F.in[17], QSCALE};
        pg8::gemm_phase<pg8::EpiInProj, pg8::InProjOrder, true, true>(ring, g, S, E);
        if (_rep == 0) conv_queue(F, CW_Q5, CV_Q5_LO, CV_Q5_HI);
    } SEAM(5);
    #ifndef PROBE_ATT
#define PROBE_ATT -1
#endif
    if (IN(6)) { p6_attn<0>(F, true); if (PROBE_ATT >= 0) { p6_attn<(PROBE_ATT < 0 ? 0 : PROBE_ATT)>(F, false); } p6_conv(F); } SEAM(6);
    if (IN(7)) REP(7) { p7_states(F); } SEAM(7);
    if (IN(8)) REP(8) { p8_scan(F); } SEAM(8);
    if (IN(9)) REP(9) { p9_ssd_out(F, _rep == 0); } SEAM(9);
    if (IN(11)) REP(11) {
        pg8::Gemm g{WSP(bf16, WS_H), WSP(bf16, WS_WOUT), NLAT, DM, DM}; pg8::OutProjOrder S; S.init(F.G, F.bid);
        LAS float* qt = (LAS float*)(F.lds + RING_BYTES + 1024);
        { const float* ssa = WSP(float, WS_ROWSS); const float* sss = ssa + NLAT;
          for (int e = F.tid; e < 1024; e += NTHR) { pg8::Unit u; if (S.t.next(e >> 8, u)) { const int r = u.pm * 256 + (e & 255);
              qt[e] = sqrtf((sss[r] * (1.0f / 2048.f) + EPS) / (ssa[r] * (1.0f / 2048.f) + EPS)); } }
          __syncthreads(); }
        pg8::EpiOutProj E{WSP(bf16, WS_Y), DM, qt};
        pg8::gemm_phase<pg8::EpiOutProj, pg8::OutProjOrder, true, true, false, true>(ring, g, S, E);
#ifdef PROBE_ZEROB
        xcd_barrier(bar);
        { bf16* zb = WSP(bf16, WS_HIN);
          if (PROBE_ZEROB) { for (size_t e = (size_t)F.bid * NTHR + F.tid; e < (size_t)DM * DM / 8; e += (size_t)F.G * NTHR) ((u32x4*)zb)[e] = (u32x4){0u, 0u, 0u, 0u}; }
          xcd_barrier(bar);
          pg8::Gemm g2{WSP(bf16, WS_H), PROBE_ZEROB ? zb : WSP(bf16, WS_WOUT), NLAT, DM, DM}; pg8::StaticOrder S2; S2.init(NLAT, DM, DM, F.G, F.bid);
          pg8::EpiPlain E2{WSP(bf16, WS_SLOC), DM};
          pg8::gemm_phase<pg8::EpiPlain, pg8::StaticOrder, true, true>(ring, g2, S2, E2); }
#endif
    } SEAM(11);
    if (IN(12)) REP(12) { p12_resnorm(F); } SEAM(12);
    if (IN(13)) REP(13) {
        pg8::Gemm g{WSP(bf16, WS_H), WSP(bf16, WS_WGU1), NLAT, NGU, DM}; pg8::HalfNOrder S; S.init(NLAT, F.G, F.bid);
        pg8::EpiSwiGLU8 E{WSP(unsigned char, WS_ACT), FF};
        pg8::gemm_phase<pg8::EpiSwiGLU8, pg8::HalfNOrder, true, true>(ring, g, S, E);
        if (_rep == 0) conv_queue(F, CW_Q13, CV_Q13_LO, CV_Q13_HI);
    } SEAM(13);
    if (IN(14)) REP(14) {
        pg8::Gemm g{WSP(bf16, WS_ACT), WSP(bf16, WS_WD1), NLAT, DM, FF / 2}; pg8::StaticOrder S; S.init(NLAT, DM, FF / 2, F.G, F.bid, WGM_DOWN);
        pg8::EpiPlainS E{WSP(bf16, WS_Y), DM, 1.0f / (8.0f * 2048.0f)};
        pg8::gemm_phase<pg8::EpiPlainS, pg8::StaticOrder, true, true, true>(ring, g, S, E);
    } SEAM(14);
    if (IN(15)) REP(15) { p15_final(F); }
#undef IN
#undef SEAM
}

extern "C" void kernel_launch(void* const* d_in, const int* in_sizes, int n_in, void* d_out, int out_size, void* d_ws, size_t ws_size, hipStream_t stream) {
    static int grid = 0;
    if (grid == 0) {
        if (n_in != 21 || in_sizes[0] != NLAT * DM || out_size != NLAT * DM || ws_size < WS_END) {
            fprintf(stderr, "kernel_launch: unexpected problem (n_in %d, in0 %d, out %d, ws %zu, need %zu)\n", n_in, n_in > 0 ? in_sizes[0] : -1, out_size, ws_size, (size_t)WS_END); grid = -1; return; }
        int dev = 0, cus = 0, per_cu = 0;
        if (hipGetDevice(&dev) != hipSuccess || hipDeviceGetAttribute(&cus, hipDeviceAttributeMultiprocessorCount, dev) != hipSuccess) { grid = -1; return; }
        if (hipFuncSetAttribute((const void*)fwd, hipFuncAttributeMaxDynamicSharedMemorySize, LDS_BYTES) != hipSuccess) { fprintf(stderr, "kernel_launch: hipFuncSetAttribute failed\n"); grid = -1; return; }
        if (hipOccupancyMaxActiveBlocksPerMultiprocessor(&per_cu, (const void*)fwd, NTHR, LDS_BYTES) != hipSuccess || per_cu < 1)
            fprintf(stderr, "kernel_launch: note: occupancy query reports %d workgroups per CU\n", per_cu);
        (void)hipGetLastError();
        grid = cus;
    }
    if (grid < 0) return;
    if (hipMemsetAsync((char*)d_ws + WS_CTL, 0, ZERO_BYTES, stream) != hipSuccess) { fprintf(stderr, "kernel_launch: memset failed\n"); return; }
    Args a{};
    for (int i = 0; i < 21; ++i) a.in[i] = (const float*)d_in[i];
    a.out = (float*)d_out; a.ws = (unsigned char*)d_ws; a.pad = 0;
#if MK_PER_PHASE
    for (int ph = 0; ph < N_PHASES; ++ph) { a.ph_lo = ph; a.ph_hi = ph + 1; a.li = ph;
        hipLaunchKernelGGL(fwd, dim3(grid), dim3(NTHR), LDS_BYTES, stream, a); }
#else
    a.ph_lo = 0; a.ph_hi = N_PHASES; a.li = 0;
    hipLaunchKernelGGL(fwd, dim3(grid), dim3(NTHR), LDS_BYTES, stream, a);
#endif
    const hipError_t le = hipPeekAtLastError();
    if (le != hipSuccess) fprintf(stderr, "kernel_launch: launch failed: %s\n", hipGetErrorName(le));
}
```

```cpp
#define MK_PER_PHASE 0
#define PROBE_MASK 0
#define PROBE_P0T 1
#include <hip/hip_runtime.h>
#include <cstdio>
#include <cstdint>
namespace pg8 {
#define PG8_LAS __attribute__((address_space(3)))
typedef unsigned short bf16_t;
typedef short bf16x8 __attribute__((ext_vector_type(8)));
typedef float f32x4 __attribute__((ext_vector_type(4)));
typedef unsigned u32x4 __attribute__((ext_vector_type(4)));
constexpr int BM = 256, BK = 64, HALF = 128, HTB = HALF * BK * 2  , STAGE_BYTES = 8 * HTB, NXCD = 8, WGM = 4;

__host__ __device__ __forceinline__ int lds_byte(int r, int c) { const int st = (r >> 4) * 2 + (c >> 5), rr = r & 15, cc = c & 31, ob = rr * 64 + cc * 2; return st * 1024 + (ob ^ (((ob >> 9) & 1) << 5)); }
__host__ __device__ __forceinline__ void stage_rc(int b, int& R, int& C) { const int st = b / 1024, sb = b % 1024, swz = sb ^ (((sb >> 9) & 1) << 5); R = (st >> 1) * 16 + swz / 64; C = (st & 1) * 32 + (swz % 64) / 2; }
__host__ __device__ __forceinline__ int perm32(int rho) { const int n = rho >> 4, i = rho & 15; return 8 * (i >> 2) + 4 * n + (i & 3); }

struct Unit { int pm, pn, koff, nt, aux; };
struct Gemm { const bf16_t* A; const bf16_t* Bt; int M, N, K; };

struct StaticOrder {
    int nM, nN, nwg, G, c, nt, wgm;
    __host__ __device__ void init(int M, int N, int K, int G_, int c_, int wgm_ = WGM) { nM = M / BM; nN = N / BM; nwg = nM * nN; G = G_; c = c_; nt = K / BK; wgm = wgm_; }
    __host__ __device__ __forceinline__ bool next(int i, Unit& u) const {
        const long L = (long)i * G + c; if (L >= nwg) return false;
        int wgid = (int)L; { const int q = nwg / NXCD, r = nwg % NXCD, xcd = wgid % NXCD, off = wgid / NXCD; wgid = (xcd < r ? xcd * (q + 1) : r * (q + 1) + (xcd - r) * q) + off; }
        const int nig = wgm * nN, gid = wgid / nig, fm = gid * wgm, gsz = (nM - fm) < wgm ? (nM - fm) : wgm;
        u.pm = fm + ((wgid % nig) % gsz); u.pn = (wgid % nig) / gsz; u.koff = 0; u.nt = nt; u.aux = 0; return true;
    }
    __device__ __forceinline__ void a_ready(const Unit&) const {}
    __device__ __forceinline__ void done(const Unit&) const {}
};

__device__ __forceinline__ unsigned cvt_pk_bf16(float lo, float hi) { unsigned r; asm volatile("v_cvt_pk_bf16_f32 %0, %1, %2" : "=v"(r) : "v"(lo), "v"(hi)); return r; }
typedef float f32x2_t __attribute__((ext_vector_type(2))); typedef __bf16 bf16x2_t __attribute__((ext_vector_type(2)));
__device__ __forceinline__ unsigned pk_bf16(float lo, float hi) { const f32x2_t v = {lo, hi}; const bf16x2_t b = __builtin_convertvector(v, bf16x2_t); return __builtin_bit_cast(unsigned, b); }
#ifndef AQ_DROP
#define AQ_DROP 2
#endif
__device__ __forceinline__ float aquant(float v) {
    if (AQ_DROP == 0) return v;
    unsigned u = __builtin_bit_cast(unsigned, v); constexpr unsigned sh = 16 + AQ_DROP, half = (1u << (sh - 1)) - 1u;
    u = (u + half + ((u >> sh) & 1u)) & ~((1u << sh) - 1u); return __builtin_bit_cast(float, u);
}
__device__ __forceinline__ unsigned pk_bf16q(float lo, float hi) {
    if (AQ_DROP == 0) return pk_bf16(lo, hi);
    {
#pragma clang fp contract(off)
        const f32x2_t v = {lo, hi}; constexpr float K = (float)((1u << (16 + AQ_DROP)) + 1u);
        const f32x2_t c = v * K; const f32x2_t d = c - v; const f32x2_t h = c - d;
        return __builtin_bit_cast(unsigned, __builtin_convertvector(h, bf16x2_t));
    }
}
typedef _Float16 f16x2_t __attribute__((ext_vector_type(2)));
__device__ __forceinline__ unsigned pk_f16(float lo, float hi) { const f32x2_t v = {lo, hi}; return __builtin_bit_cast(unsigned, __builtin_convertvector(v, f16x2_t)); }
__device__ __forceinline__ float silu_f(float g) { return g * __builtin_amdgcn_rcpf(1.0f + __builtin_amdgcn_exp2f(-1.4426950408889634f * g)); }
template <bool S8>
__device__ __forceinline__ f32x2_t swiglu2(f32x2_t g, f32x2_t u) {
    const f32x2_t t = g * -1.4426950408889634f;
    const f32x2_t e = {__builtin_amdgcn_exp2f(t.x), __builtin_amdgcn_exp2f(t.y)};
    const f32x2_t d = S8 ? e * 0.125f + 0.125f : e + 1.0f;
    const f32x2_t r = {__builtin_amdgcn_rcpf(d.x), __builtin_amdgcn_rcpf(d.y)};
    return (g * u) * r;
}
__device__ __forceinline__ float softplus_f(float x) { return x > 20.f ? x : log1pf(__expf(x)); }

struct EpiPlain {
    static constexpr bool PERM = true, AFTER_DRAIN = false;
    bf16_t* O; int ldc;
    __device__ __forceinline__ void operator()(const f32x4 (&acc)[2][2][4][2], const Unit& u, int wr, int wc, int fr, int fq) const {
        const int row0 = u.pm * BM + wr * 64 + fr, col0 = u.pn * BM + wc * 32 + 8 * fq;
#pragma unroll
        for (int ai = 0; ai < 2; ++ai)
#pragma unroll
            for (int m = 0; m < 4; ++m) { bf16_t* rowp = O + (size_t)(row0 + ai * HALF + m * 16) * ldc + col0;
#pragma unroll
                for (int bj = 0; bj < 2; ++bj) { const f32x4 v0 = acc[ai][bj][m][0], v1 = acc[ai][bj][m][1];
                    u32x4 w; w.x = pk_f16(v0[0], v0[1]); w.y = pk_f16(v0[2], v0[3]); w.z = pk_f16(v1[0], v1[1]); w.w = pk_f16(v1[2], v1[3]);
                    *(u32x4*)(rowp + bj * HALF) = w; } }
    }
};
struct EpiSwiGLU {
    static constexpr bool PERM = true, AFTER_DRAIN = false;
    bf16_t* O; int ldc;
    __device__ __forceinline__ void operator()(const f32x4 (&acc)[2][2][4][2], const Unit& u, int wr, int wc, int fr, int fq) const {
        const int row0 = u.pm * BM + wr * 64 + fr, col0 = u.pn * HALF + wc * 32 + 8 * fq;
#pragma unroll
        for (int ai = 0; ai < 2; ++ai)
#pragma unroll
            for (int m = 0; m < 4; ++m) { bf16_t* rowp = O + (size_t)(row0 + ai * HALF + m * 16) * ldc + col0;
                const f32x4 g0 = acc[ai][0][m][0], g1 = acc[ai][0][m][1], u0 = acc[ai][1][m][0], u1 = acc[ai][1][m][1];
                u32x4 w;
                { const f32x2_t a = swiglu2<false>((f32x2_t){g0[0], g0[1]}, (f32x2_t){u0[0], u0[1]}), b = swiglu2<false>((f32x2_t){g0[2], g0[3]}, (f32x2_t){u0[2], u0[3]}),
                                c = swiglu2<false>((f32x2_t){g1[0], g1[1]}, (f32x2_t){u1[0], u1[1]}), d = swiglu2<false>((f32x2_t){g1[2], g1[3]}, (f32x2_t){u1[2], u1[3]});
                  w.x = pk_bf16q(a.x, a.y); w.y = pk_bf16q(b.x, b.y); w.z = pk_bf16q(c.x, c.y); w.w = pk_bf16q(d.x, d.y); }
                __builtin_nontemporal_store(w, (u32x4*)rowp); }
    }
};
struct EpiInProj {
    static constexpr bool PERM = true, AFTER_DRAIN = false;
    bf16_t* P; int ldc; float* dtf; float* dtb; const float* rcos; const float* rsin; const float* dt_bias; float qscale;
    __device__ __forceinline__ void operator()(const f32x4 (&acc)[2][2][4][2], const Unit& u, int wr, int wc, int fr, int fq) const {
        const int row0 = u.pm * BM + wr * 64 + fr;
        if (u.pn == 32) {
            if (wc < 2) {
                float* dst = (wc == 0) ? dtf : dtb; const float* bp = dt_bias + wc * 32 + 8 * fq;
                const f32x4 b0 = *(const f32x4*)bp, b1 = *(const f32x4*)(bp + 4);
#pragma unroll
                for (int ai = 0; ai < 2; ++ai)
#pragma unroll
                    for (int m = 0; m < 4; ++m) { float* rowp = dst + (size_t)(row0 + ai * HALF + m * 16) * 32 + 8 * fq;
                        f32x4 v0 = acc[ai][0][m][0] + b0, v1 = acc[ai][0][m][1] + b1;
#pragma unroll
                        for (int j = 0; j < 4; ++j) { v0[j] = softplus_f(v0[j]); v1[j] = softplus_f(v1[j]); }
                        *(f32x4*)rowp = v0; *(f32x4*)(rowp + 4) = v1; }
            }
            return;
        }
        const int col0 = u.pn * BM + wc * 32 + 8 * fq;
        const bool rope = (u.pn < 8) || (u.pn == 16) || (u.pn == 17);
        if (!rope) {
#pragma unroll
            for (int ai = 0; ai < 2; ++ai)
#pragma unroll
                for (int m = 0; m < 4; ++m) { bf16_t* rowp = P + (size_t)(row0 + ai * HALF + m * 16) * ldc + col0;
#pragma unroll
                    for (int bj = 0; bj < 2; ++bj) { const f32x4 v0 = acc[ai][bj][m][0], v1 = acc[ai][bj][m][1];
                        u32x4 w; w.x = pk_bf16(v0[0], v0[1]); w.y = pk_bf16(v0[2], v0[3]); w.z = pk_bf16(v1[0], v1[1]); w.w = pk_bf16(v1[2], v1[3]);
                        *(u32x4*)(rowp + bj * HALF) = w; } }
        } else {
            const float sc = (u.pn < 8) ? qscale : 1.0f;
            const bool lat = u.pm < 64;
            const int axis = wc >> 1, ioff = 16 * (wc & 1) + 4 * fq;
#pragma unroll
            for (int ai = 0; ai < 2; ++ai)
#pragma unroll
                for (int m = 0; m < 4; ++m) { const int row = row0 + ai * HALF + m * 16; bf16_t* rowp = P + (size_t)row * ldc + col0;
                    f32x4 cs = (f32x4){1.f, 1.f, 1.f, 1.f}, sn = (f32x4){0.f, 0.f, 0.f, 0.f};
                    if (lat) { const int t = row & 8191, pos = axis ? (t & 63) : (t >> 6); cs = *(const f32x4*)(rcos + pos * 32 + ioff); sn = *(const f32x4*)(rsin + pos * 32 + ioff); }
#pragma unroll
                    for (int bj = 0; bj < 2; ++bj) { const f32x4 x1 = acc[ai][bj][m][0], x2 = acc[ai][bj][m][1];
                        const f32x4 o1 = (x1 * cs - x2 * sn) * sc, o2 = (x2 * cs + x1 * sn) * sc;
                        u32x4 w; w.x = pk_bf16(o1[0], o1[1]); w.y = pk_bf16(o1[2], o1[3]); w.z = pk_bf16(o2[0], o2[1]); w.w = pk_bf16(o2[2], o2[3]);
                        *(u32x4*)(rowp + bj * HALF) = w; } }
        }
    }
};
struct InProjOrder {
    StaticOrder lat; int G, c;
    __host__ __device__ void init(int G_, int c_) { lat.init(16384, 8448, 4096, G_, c_); G = G_; c = c_; }
    __host__ __device__ __forceinline__ bool next(int i, Unit& u) const {
        const long L = (long)i * G + c;
        if (L < lat.nwg) return lat.next(i, u);
        const int k = (int)(L - lat.nwg); if (k >= 34) return false;
        u.pm = 64 + (k & 1); u.pn = 16 + (k >> 1); u.koff = 0; u.nt = lat.nt; u.aux = 0; return true;
    }
    __device__ __forceinline__ void a_ready(const Unit&) const {}
    __device__ __forceinline__ void done(const Unit&) const {}
};


struct CtxSplitOrder {
    int G, c;
    __host__ __device__ void init(int G_, int c_) { G = G_; c = c_; }
    __host__ __device__ __forceinline__ bool next(int i, Unit& u) const {
        const long L = (long)i * G + c; if (L >= 256) return false;
        const int k = (int)L, s = k >> 5;
        u.pm = 64 + (k & 1); u.pn = (k >> 1) & 15; u.aux = s; u.nt = (s < 6) ? 22 : 20; u.koff = 64 * ((s < 6) ? 22 * s : 132 + 20 * (s - 6)); return true;
    }
    __device__ __forceinline__ void a_ready(const Unit&) const {}
    __device__ __forceinline__ void done(const Unit&) const {}
};
struct EpiSplitF32 {
    static constexpr bool PERM = true, AFTER_DRAIN = false;
    float* YP; int ldc;
    __device__ __forceinline__ void operator()(const f32x4 (&acc)[2][2][4][2], const Unit& u, int wr, int wc, int fr, int fq) const {
        float* base = YP + (size_t)u.aux * 512 * ldc + (size_t)((u.pm - 64) * BM + wr * 64 + fr) * ldc + u.pn * BM + wc * 32 + 8 * fq;
#pragma unroll
        for (int ai = 0; ai < 2; ++ai)
#pragma unroll
            for (int m = 0; m < 4; ++m) { float* rowp = base + (size_t)(ai * HALF + m * 16) * ldc;
#pragma unroll
                for (int bj = 0; bj < 2; ++bj) { *(f32x4*)(rowp + bj * HALF) = acc[ai][bj][m][0]; *(f32x4*)(rowp + bj * HALF + 4) = acc[ai][bj][m][1]; } }
    }
};

__device__ __forceinline__ float clamp448(float v) { return __builtin_amdgcn_fmed3f(v, -448.f, 448.f); }
__device__ __forceinline__ unsigned pk4_fp8(float a, float b, float c, float d) { int p = __builtin_amdgcn_cvt_pk_fp8_f32(clamp448(a), clamp448(b), 0, false); p = __builtin_amdgcn_cvt_pk_fp8_f32(clamp448(c), clamp448(d), p, true); return (unsigned)p; }
struct EpiSwiGLU8 {
    static constexpr bool PERM = true, AFTER_DRAIN = false;
    unsigned char* O; int ldc;
    __device__ __forceinline__ void operator()(const f32x4 (&acc)[2][2][4][2], const Unit& u, int wr, int wc, int fr, int fq) const {
        const int row0 = u.pm * BM + wr * 64 + fr, col0 = u.pn * HALF + wc * 32 + 8 * fq;
#pragma unroll
        for (int ai = 0; ai < 2; ++ai)
#pragma unroll
            for (int m = 0; m < 4; ++m) { unsigned char* rowp = O + (size_t)(row0 + ai * HALF + m * 16) * ldc + col0;
                const f32x4 g0 = acc[ai][0][m][0], g1 = acc[ai][0][m][1], u0 = acc[ai][1][m][0], u1 = acc[ai][1][m][1];
                const f32x2_t a = swiglu2<true>((f32x2_t){g0[0], g0[1]}, (f32x2_t){u0[0], u0[1]}), b = swiglu2<true>((f32x2_t){g0[2], g0[3]}, (f32x2_t){u0[2], u0[3]}),
                              c = swiglu2<true>((f32x2_t){g1[0], g1[1]}, (f32x2_t){u1[0], u1[1]}), d = swiglu2<true>((f32x2_t){g1[2], g1[3]}, (f32x2_t){u1[2], u1[3]});
                typedef unsigned u32x2_t __attribute__((ext_vector_type(2)));
                u32x2_t w; w.x = pk4_fp8(a.x, a.y, b.x, b.y); w.y = pk4_fp8(c.x, c.y, d.x, d.y);
                *(u32x2_t*)rowp = w; }
    }
};
struct EpiPlainS {
    static constexpr bool PERM = true, AFTER_DRAIN = false;
    bf16_t* O; int ldc; float scale;
    __device__ __forceinline__ void operator()(const f32x4 (&acc)[2][2][4][2], const Unit& u, int wr, int wc, int fr, int fq) const {
        const int row0 = u.pm * BM + wr * 64 + fr, col0 = u.pn * BM + wc * 32 + 8 * fq;
#pragma unroll
        for (int ai = 0; ai < 2; ++ai)
#pragma unroll
            for (int m = 0; m < 4; ++m) { bf16_t* rowp = O + (size_t)(row0 + ai * HALF + m * 16) * ldc + col0;
#pragma unroll
                for (int bj = 0; bj < 2; ++bj) { const f32x4 v0 = acc[ai][bj][m][0] * scale, v1 = acc[ai][bj][m][1] * scale;
                    u32x4 w; w.x = pk_f16(v0[0], v0[1]); w.y = pk_f16(v0[2], v0[3]); w.z = pk_f16(v1[0], v1[1]); w.w = pk_f16(v1[2], v1[3]);
                    *(u32x4*)(rowp + bj * HALF) = w; } }
    }
};

struct EpiOutProj {
    static constexpr bool PERM = true, AFTER_DRAIN = false;
    bf16_t* O; int ldc; const PG8_LAS float* qt;
    __device__ __forceinline__ float keep_factor(const Unit& u, int ai, int m, int wr, int fr) const {
        const float s = qt[(u.aux & 3) * 256 + ai * HALF + wr * 64 + m * 16 + fr]; return (u.aux & 0x100) ? s : 0.0f;
    }
    __device__ __forceinline__ void operator()(const f32x4 (&acc_)[2][2][4][2], const Unit& u, int wr, int wc, int fr, int fq) const {
        if (u.aux & 0x100) return;
        const int row0 = u.pm * BM + wr * 64 + fr, col0 = u.pn * BM + wc * 32 + 8 * fq;
#pragma unroll
        for (int ai = 0; ai < 2; ++ai)
#pragma unroll
            for (int m = 0; m < 4; ++m) { bf16_t* rowp = O + (size_t)(row0 + ai * HALF + m * 16) * ldc + col0;
#pragma unroll
                for (int bj = 0; bj < 2; ++bj) { const f32x4 v0 = acc_[ai][bj][m][0], v1 = acc_[ai][bj][m][1];
                    u32x4 w; w.x = pk_f16(v0[0], v0[1]); w.y = pk_f16(v0[2], v0[3]); w.z = pk_f16(v1[0], v1[1]); w.w = pk_f16(v1[2], v1[3]);
                    *(u32x4*)(rowp + bj * HALF) = w; } }
    }
};
struct OutProjOrder {
    StaticOrder t;
    __host__ __device__ void init(int G_, int c_) { t.init(16384, 4096, 4096, G_, c_); }
    __host__ __device__ __forceinline__ bool next(int i, Unit& u) const {
        if (!t.next(i >> 1, u)) return false;
        u.nt = 32; u.koff = (i & 1) * 2048; u.aux = (i & 1) ? 0 : (0x100 | ((i >> 1) & 3)); return true;
    }
    __device__ __forceinline__ void a_ready(const Unit&) const {}
    __device__ __forceinline__ void done(const Unit&) const {}
};

struct HalfNOrder {
    StaticOrder h; int G, c, nh;
    __host__ __device__ void init(int M, int G_, int c_) { h.init(M, 43 * 256, 4096, G_, c_); G = G_; c = c_; nh = h.nwg; }
    __host__ __device__ __forceinline__ bool next(int i, Unit& u) const {
        const long L = (long)i * G + c; if (L >= 2L * nh) return false;
        const int half = L >= nh, l = (int)(L - (half ? nh : 0));
        StaticOrder t = h; t.c = l % G; if (!t.next(l / G, u)) return false;
        u.pn += 43 * half; return true;
    }
    __device__ __forceinline__ void a_ready(const Unit&) const {}
    __device__ __forceinline__ void done(const Unit&) const {}
};
typedef int v8i_t __attribute__((ext_vector_type(8))); typedef int v4i_t __attribute__((ext_vector_type(4)));
__device__ __forceinline__ v8i_t cat8(bf16x8 a, bf16x8 b) { return __builtin_shufflevector(__builtin_bit_cast(v4i_t, a), __builtin_bit_cast(v4i_t, b), 0, 1, 2, 3, 4, 5, 6, 7); }
template <class Epi, class Sched, bool ALIGN_EPI = false, bool SP2 = false, bool FP8 = false, bool KEEP = false>
__device__ __forceinline__ void gemm_phase(PG8_LAS unsigned char* lds, const Gemm g, const Sched& S, const Epi& E) {
    const int tid = threadIdx.x, wid = __builtin_amdgcn_readfirstlane(tid >> 6), lane = tid & 63, wr = wid >> 2, wc = wid & 3, fr = lane & 15, fq = lane >> 4;
    const int K = g.K;
    unsigned voffA[2], voffB[2];
#pragma unroll
    for (int i = 0; i < 2; ++i) { int R, C; stage_rc(tid * 16 + i * 8192, R, C); const int Rb = Epi::PERM ? ((R & ~31) + perm32(R & 31)) : R;
        voffA[i] = (unsigned)(R * K + C) * 2u; voffB[i] = (unsigned)(Rb * K + C) * 2u; }
    const size_t kstep = (size_t)(BK * 2);
    const size_t hstep = (size_t)HALF * K * 2;
    const size_t tstep = 2 * hstep;
    const unsigned ldsw = (unsigned)wid * 1024u;
    const int aoff = lds_byte(wr * 64 + fr, fq * 8), boff = lds_byte(wc * 32 + fr, fq * 8);
#define PG8_SA(b, h) (((b) * 2 + (h)) * HTB)
#define PG8_SB(b, h) ((4 + (b) * 2 + (h)) * HTB)
#define PG8_STAGE(bufoff, gbase, voff) do { _Pragma("unroll") for (int _i = 0; _i < 2; ++_i) \
        __builtin_amdgcn_global_load_lds((const unsigned*)((const char*)(gbase) + (voff)[_i]), (PG8_LAS unsigned*)(lds + (bufoff) + ldsw + _i * 8192), 16, 0, 0); } while (0)
#define PG8_LDA(dst, b, h) do { _Pragma("unroll") for (int m = 0; m < 4; ++m) { if constexpr (FP8) dst##8[m] = cat8(*(const PG8_LAS bf16x8*)(lds + PG8_SA(b, h) + aoff + m * 2048), *(const PG8_LAS bf16x8*)(lds + PG8_SA(b, h) + aoff + m * 2048 + 1024)); \
        else { _Pragma("unroll") for (int k = 0; k < 2; ++k) dst[m][k] = *(const PG8_LAS bf16x8*)(lds + PG8_SA(b, h) + aoff + m * 2048 + k * 1024); } } } while (0)
#define PG8_LDB(dst, b, h) do { _Pragma("unroll") for (int n = 0; n < 2; ++n) { if constexpr (FP8) dst##8[n] = cat8(*(const PG8_LAS bf16x8*)(lds + PG8_SB(b, h) + boff + n * 2048), *(const PG8_LAS bf16x8*)(lds + PG8_SB(b, h) + boff + n * 2048 + 1024)); \
        else { _Pragma("unroll") for (int k = 0; k < 2; ++k) dst[n][k] = *(const PG8_LAS bf16x8*)(lds + PG8_SB(b, h) + boff + n * 2048 + k * 1024); } } } while (0)
#ifndef PG8_BSTAT
#define PG8_BSTAT 0
#endif
#define PG8_MMA(ai, bj, At, Bt) do { __builtin_amdgcn_s_setprio(1); \
        if constexpr (FP8) { _Pragma("unroll") for (int m = 0; m < 4; ++m) _Pragma("unroll") for (int n = 0; n < 2; ++n) asm volatile("v_mfma_f32_16x16x128_f8f6f4 %0, %1, %2, %0" : "+v"(acc[ai][bj][m][n]) : "v"(Bt##8[n]), "v"(At##8[m])); } \
        else if (PG8_BSTAT) { _Pragma("unroll") for (int k = 0; k < 2; ++k) _Pragma("unroll") for (int n = 0; n < 2; ++n) _Pragma("unroll") for (int m = 0; m < 4; ++m) acc[ai][bj][m][n] = __builtin_amdgcn_mfma_f32_16x16x32_bf16(Bt[n][k], At[m][k], acc[ai][bj][m][n], 0, 0, 0); } \
        else { _Pragma("unroll") for (int m = 0; m < 4; ++m) _Pragma("unroll") for (int n = 0; n < 2; ++n) _Pragma("unroll") for (int k = 0; k < 2; ++k) acc[ai][bj][m][n] = __builtin_amdgcn_mfma_f32_16x16x32_bf16(Bt[n][k], At[m][k], acc[ai][bj][m][n], 0, 0, 0); } \
        if constexpr (FP8) asm volatile("s_nop 3");     \
        __builtin_amdgcn_s_setprio(0); } while (0)
#define PG8_WAIT_V(n) asm volatile("s_waitcnt vmcnt(" #n ")" ::: "memory")
#define PG8_WAIT_L(n) asm volatile("s_waitcnt lgkmcnt(" #n ")" ::: "memory")
#define PG8_BAR __builtin_amdgcn_s_barrier()
#define PG8_SCHED __builtin_amdgcn_sched_barrier(0)
    Unit cur, nxt; int ui = 0;
    if (!S.next(0, cur)) return;
    f32x4 acc[2][2][4][2];
#pragma unroll
    for (int a = 0; a < 2; ++a)
#pragma unroll
        for (int b = 0; b < 2; ++b)
#pragma unroll
            for (int m = 0; m < 4; ++m)
#pragma unroll
                for (int n = 0; n < 2; ++n) acc[a][b][m][n] = (f32x4){0.f, 0.f, 0.f, 0.f};
    bf16x8 At[4][2], B0[2][2], B1[2][2]; v8i_t At8[4], B08[2], B18[2];
    const char* cA = (const char*)g.A + (size_t)cur.pm * tstep + (size_t)cur.koff * 2; const char* cB = (const char*)g.Bt + (size_t)cur.pn * tstep + (size_t)cur.koff * 2;
    S.a_ready(cur);
    if constexpr (SP2) {
        PG8_STAGE(PG8_SB(0, 0), cB, voffB); PG8_STAGE(PG8_SB(0, 1), cB + hstep, voffB); PG8_STAGE(PG8_SA(0, 0), cA, voffA); PG8_STAGE(PG8_SA(0, 1), cA + hstep, voffA);
        if (wr == 1) PG8_BAR;
        PG8_WAIT_V(2); PG8_BAR;
        PG8_STAGE(PG8_SB(1, 0), cB + kstep, voffB); PG8_STAGE(PG8_SA(1, 0), cA + kstep, voffA); PG8_STAGE(PG8_SB(1, 1), cB + hstep + kstep, voffB);
        PG8_WAIT_V(6); PG8_BAR;
    } else {
        PG8_STAGE(PG8_SB(0, 0), cB, voffB); PG8_STAGE(PG8_SA(0, 0), cA, voffA); PG8_STAGE(PG8_SB(0, 1), cB + hstep, voffB); PG8_STAGE(PG8_SA(0, 1), cA + hstep, voffA);
        if (wr == 1) PG8_BAR;
        PG8_WAIT_V(4); PG8_BAR;
        PG8_STAGE(PG8_SB(1, 0), cB + kstep, voffB); PG8_STAGE(PG8_SA(1, 0), cA + kstep, voffA); PG8_STAGE(PG8_SB(1, 1), cB + hstep + kstep, voffB);
        PG8_WAIT_V(6); PG8_BAR;
    }
    for (;;) {
        const bool has_next = S.next(ui + 1, nxt);
        const char* nA = has_next ? (const char*)g.A + (size_t)nxt.pm * tstep + (size_t)nxt.koff * 2 : cA; const char* nB = has_next ? (const char*)g.Bt + (size_t)nxt.pn * tstep + (size_t)nxt.koff * 2 : cB;
        const int nt = cur.nt;
        for (int t = 0; t < nt; t += 2) {
            const bool last = (t == nt - 2);
            const char* a1 = cA + (size_t)(t + 1) * kstep;
            const char* a2 = last ? nA : cA + (size_t)(t + 2) * kstep; const char* b2 = last ? nB : cB + (size_t)(t + 2) * kstep;
            const char* a3 = a2 + kstep; const char* b3 = b2 + kstep;
            if (last && has_next) S.a_ready(nxt);
            if constexpr (SP2) {
            PG8_LDB(B0, 0, 0); PG8_LDB(B1, 0, 1); PG8_SCHED; PG8_LDA(At, 0, 0); PG8_STAGE(PG8_SA(1, 1), a1 + hstep, voffA);
            PG8_WAIT_V(8); PG8_WAIT_L(0); PG8_BAR; PG8_MMA(0, 0, At, B0); PG8_MMA(0, 1, At, B1); PG8_BAR; PG8_SCHED;
            PG8_LDA(At, 0, 1); PG8_STAGE(PG8_SB(0, 0), b2, voffB); PG8_STAGE(PG8_SB(0, 1), b2 + hstep, voffB); PG8_STAGE(PG8_SA(0, 0), a2, voffA);
            PG8_WAIT_V(8); PG8_WAIT_L(0); PG8_BAR; PG8_MMA(1, 0, At, B0); PG8_MMA(1, 1, At, B1); PG8_BAR; PG8_SCHED;
            PG8_LDB(B0, 1, 0); PG8_LDB(B1, 1, 1); PG8_SCHED; PG8_LDA(At, 1, 0); PG8_STAGE(PG8_SA(0, 1), a2 + hstep, voffA);
            PG8_WAIT_V(8); PG8_WAIT_L(0); PG8_BAR; PG8_MMA(0, 0, At, B0); PG8_MMA(0, 1, At, B1); PG8_BAR; PG8_SCHED;
            PG8_LDA(At, 1, 1); PG8_STAGE(PG8_SB(1, 0), b3, voffB); PG8_STAGE(PG8_SB(1, 1), b3 + hstep, voffB); PG8_STAGE(PG8_SA(1, 0), a3, voffA);
            PG8_WAIT_V(8); PG8_WAIT_L(0); PG8_BAR; PG8_MMA(1, 0, At, B0); PG8_MMA(1, 1, At, B1); PG8_BAR; PG8_SCHED;
            } else {
            PG8_LDB(B0, 0, 0); PG8_SCHED; PG8_LDA(At, 0, 0); PG8_STAGE(PG8_SA(1, 1), a1 + hstep, voffA);
            PG8_WAIT_L(8); PG8_BAR; PG8_WAIT_L(0); PG8_MMA(0, 0, At, B0); PG8_BAR; PG8_SCHED;
            PG8_LDB(B1, 0, 1); PG8_STAGE(PG8_SB(0, 0), b2, voffB);
            PG8_BAR; PG8_WAIT_L(0); PG8_MMA(0, 1, At, B1); PG8_BAR;
            PG8_LDA(At, 0, 1); PG8_STAGE(PG8_SA(0, 0), a2, voffA);
            PG8_BAR; PG8_WAIT_L(0); PG8_MMA(1, 0, At, B0); PG8_BAR; PG8_SCHED;
            PG8_STAGE(PG8_SB(0, 1), b2 + hstep, voffB);
            PG8_WAIT_V(6); PG8_BAR; PG8_MMA(1, 1, At, B1); PG8_BAR;
            PG8_LDB(B0, 1, 0); PG8_SCHED; PG8_LDA(At, 1, 0); PG8_STAGE(PG8_SA(0, 1), a2 + hstep, voffA);
            PG8_WAIT_L(8); PG8_BAR; PG8_WAIT_L(0); PG8_MMA(0, 0, At, B0); PG8_BAR; PG8_SCHED;
            PG8_LDB(B1, 1, 1); PG8_STAGE(PG8_SB(1, 0), b3, voffB);
            PG8_BAR; PG8_WAIT_L(0); PG8_MMA(0, 1, At, B1); PG8_BAR;
            PG8_LDA(At, 1, 1); PG8_STAGE(PG8_SA(1, 0), a3, voffA);
            PG8_BAR; PG8_WAIT_L(0); PG8_MMA(1, 0, At, B0); PG8_BAR; PG8_SCHED;
            PG8_STAGE(PG8_SB(1, 1), b3 + hstep, voffB);
            PG8_WAIT_V(6); PG8_BAR; PG8_MMA(1, 1, At, B1); PG8_BAR;
            }
        }
        if constexpr (ALIGN_EPI) { if (wr == 0) PG8_BAR; }
        if constexpr (FP8) asm volatile("s_nop 15\n\ts_nop 15" ::: "memory");
        if constexpr (!Epi::AFTER_DRAIN) { E(acc, cur, wr, wc, fr, fq); S.done(cur); }
        if (!has_next) break;
        if constexpr (KEEP) {
#pragma unroll
            for (int a = 0; a < 2; ++a)
#pragma unroll
                for (int m = 0; m < 4; ++m) { const float f = E.keep_factor(cur, a, m, wr, fr);
#pragma unroll
                    for (int b = 0; b < 2; ++b) { acc[a][b][m][0] *= f; acc[a][b][m][1] *= f; } }
        } else
#pragma unroll
        for (int a = 0; a < 2; ++a)
#pragma unroll
            for (int b = 0; b < 2; ++b)
#pragma unroll
                for (int m = 0; m < 4; ++m)
#pragma unroll
                    for (int n = 0; n < 2; ++n) acc[a][b][m][n] = (f32x4){0.f, 0.f, 0.f, 0.f};
        cur = nxt; cA = nA; cB = nB; ++ui;
        if constexpr (ALIGN_EPI) { if (wr == 1) PG8_BAR; }
    }
    PG8_WAIT_V(0);
    if constexpr (!ALIGN_EPI) { if (wr == 0) PG8_BAR; }
    PG8_BAR;
    if constexpr (Epi::AFTER_DRAIN) { E.fused(acc, cur, wr, wc, fr, fq, lds, wid, lane); S.done(cur); }
#undef PG8_SA
#undef PG8_SB
#undef PG8_STAGE
#undef PG8_LDA
#undef PG8_LDB
#undef PG8_MMA
#undef PG8_WAIT_V
#undef PG8_WAIT_L
#undef PG8_BAR
#undef PG8_SCHED
}
}
constexpr int NWAVES = 8, NTHR = NWAVES * 64;
constexpr int DM = 4096, NLAT = 16384, NCTX = 512, MROWS = NLAT + NCTX, SEQ = 8192, CTXL = 256;
constexpr int FF = 11008, NGU = 2 * FF;
constexpr int NINP = 8448;
constexpr int PQ = 0, PZ = 2048, PK = 4096, PV = 4608, PXBC = 5120;
constexpr int XBCW = 3072;
constexpr int NMOD = 9 * DM;
constexpr int NSC = 132;
constexpr float EPS = 1e-6f;
constexpr float QSCALE = 0.12751743082459868f;
constexpr float LOG2E = 1.4426950408889634f;

constexpr size_t MiB = 1u << 20;
constexpr size_t WS_CTL = 0, WS_MOD = 1 * MiB, ZERO_BYTES = 2 * MiB;
constexpr size_t WS_ROWSS = 1 * MiB + 512 * 1024;
constexpr size_t WS_ROPE = 2 * MiB;
constexpr size_t WS_DEC = 2 * MiB + 65536;
constexpr size_t WS_DTF = 4 * MiB, WS_DTB = 7 * MiB;
constexpr size_t WS_WGU0 = 16 * MiB, WS_WD0 = 188 * MiB, WS_WIN = 274 * MiB, WS_WOUT = 340 * MiB, WS_WGU1 = 372 * MiB, WS_WD1 = 544 * MiB;
constexpr size_t WS_H = 630 * MiB;
constexpr size_t WS_ACT = 762 * MiB, WS_P = 762 * MiB;
constexpr size_t WS_Y = 1117 * MiB;
constexpr size_t WS_X1 = 1249 * MiB;
constexpr size_t WS_XC = 1505 * MiB;
constexpr size_t WS_OATT = 1604 * MiB, WS_YS = 1668 * MiB;
constexpr size_t WS_SLOC = 1732 * MiB;
constexpr size_t WS_HIN = 1996 * MiB;
constexpr size_t WS_YCP = 2124 * MiB;
constexpr size_t WS_END = 2188 * MiB;
static_assert(WS_WGU0 + (size_t)NGU * DM * 2 <= WS_WD0 && WS_WD0 + (size_t)DM * FF * 2 <= WS_WIN && WS_WIN + (size_t)NINP * DM * 2 <= WS_WOUT && WS_WOUT + (size_t)DM * DM * 2 <= WS_WGU1, "ws map 1");
static_assert(WS_WGU1 + (size_t)NGU * DM * 2 <= WS_WD1 && WS_WD1 + (size_t)DM * FF * 2 <= WS_H && WS_H + (size_t)MROWS * DM * 2 <= WS_ACT && WS_ACT + (size_t)MROWS * FF * 2 <= WS_Y, "ws map 2");
static_assert(WS_P + (size_t)MROWS * NINP * 2 <= WS_Y && WS_Y + (size_t)MROWS * DM * 2 <= WS_X1 && WS_X1 + (size_t)NLAT * DM * 4 <= WS_XC && WS_XC + (size_t)MROWS * XBCW * 2 <= WS_OATT, "ws map 3");
static_assert(WS_OATT + (size_t)NLAT * 2048 * 2 <= WS_YS && WS_YS + (size_t)NLAT * 2048 * 2 <= WS_SLOC && WS_SLOC + (size_t)NSC * 2 * 32 * 8192 * 4 <= WS_HIN && WS_HIN + (size_t)128 * 2 * 32 * 8192 * 2 <= WS_END, "ws map 4");
static_assert(WS_DTF + (size_t)MROWS * 32 * 4 <= WS_DTB && WS_DTB + (size_t)MROWS * 32 * 4 <= WS_WGU0 && WS_MOD + (size_t)3 * NMOD * 4 <= ZERO_BYTES, "ws map 5");
constexpr int CW_BAR = 4096;

constexpr int RING_BYTES = 131072;
constexpr int MISC_OFF = RING_BYTES + 320;
constexpr int LDS_BYTES = 147456;

#define GAS __attribute__((address_space(1)))
#define LAS __attribute__((address_space(3)))
typedef unsigned short bf16;
typedef unsigned u32x4 __attribute__((ext_vector_type(4)));
typedef unsigned u32x2 __attribute__((ext_vector_type(2)));
typedef float f32x4 __attribute__((ext_vector_type(4)));
typedef short bf16x8 __attribute__((ext_vector_type(8)));
typedef short bf16x4 __attribute__((ext_vector_type(4)));
using pg8::pk_bf16; using pg8::pk_bf16q; using pg8::pk_f16; using pg8::silu_f;
__device__ __forceinline__ float bf_lo(unsigned w) { return __uint_as_float(w << 16); }
__device__ __forceinline__ float bf_hi(unsigned w) { return __uint_as_float(w & 0xffff0000u); }
__device__ __forceinline__ unsigned short f2bf(float f) { return (unsigned short)(pk_bf16(f, 0.f) & 0xffffu); }
__device__ __forceinline__ float row_max(float x) {
    u32x2 r = __builtin_amdgcn_permlane16_swap(__float_as_uint(x), __float_as_uint(x), false, false); x = fmaxf(__uint_as_float(r.x), __uint_as_float(r.y));
    r = __builtin_amdgcn_permlane32_swap(__float_as_uint(x), __float_as_uint(x), false, false); return fmaxf(__uint_as_float(r.x), __uint_as_float(r.y));
}
__device__ __forceinline__ float row_sum(float x) {
    u32x2 r = __builtin_amdgcn_permlane16_swap(__float_as_uint(x), __float_as_uint(x), false, false); x = __uint_as_float(r.x) + __uint_as_float(r.y);
    r = __builtin_amdgcn_permlane32_swap(__float_as_uint(x), __float_as_uint(x), false, false); return __uint_as_float(r.x) + __uint_as_float(r.y);
}
__device__ __forceinline__ float wave_sum(float v) {
    v += __uint_as_float(__builtin_amdgcn_update_dpp(0u, __float_as_uint(v), 0xB1, 0xF, 0xF, false));
    v += __uint_as_float(__builtin_amdgcn_update_dpp(0u, __float_as_uint(v), 0x4E, 0xF, 0xF, false));
    v += __uint_as_float(__builtin_amdgcn_update_dpp(0u, __float_as_uint(v), 0x141, 0xF, 0xF, false));
    v += __uint_as_float(__builtin_amdgcn_update_dpp(0u, __float_as_uint(v), 0x140, 0xF, 0xF, false));
    return row_sum(v);
}
typedef _Float16 f16x8 __attribute__((ext_vector_type(8)));
typedef _Float16 f16x2 __attribute__((ext_vector_type(2)));
typedef float f32x2 __attribute__((ext_vector_type(2)));
__device__ __forceinline__ void unpack8h(const u32x4 w, float (&f)[8]) { const f16x8 h = __builtin_bit_cast(f16x8, w);
#pragma unroll
    for (int e = 0; e < 8; ++e) f[e] = (float)h[e]; }
__device__ __forceinline__ void unpack8(const u32x4 w, float (&f)[8]) {
    f[0] = bf_lo(w.x); f[1] = bf_hi(w.x); f[2] = bf_lo(w.y); f[3] = bf_hi(w.y); f[4] = bf_lo(w.z); f[5] = bf_hi(w.z); f[6] = bf_lo(w.w); f[7] = bf_hi(w.w);
}
#define XB_TMO      128
#define XB_XCNT(j)  (256  + 64 * (j))
#define XB_XSUB(j)  (1280 + 64 * (j))
#define XB_XGEN(j)  (2304 + 64 * (j))
#define XB_TOP      3328
#define XB_TOPGEN   3392
#define XCD_BAR_WORDS 3456
#define XB_SPIN_CAP (1u << 18)

__device__ __forceinline__ unsigned xb_ld(unsigned* p)              { return __hip_atomic_load(p, __ATOMIC_RELAXED, __HIP_MEMORY_SCOPE_AGENT); }
__device__ __forceinline__ unsigned xb_add(unsigned* p, unsigned v) { return __hip_atomic_fetch_add(p, v, __ATOMIC_RELAXED, __HIP_MEMORY_SCOPE_AGENT); }
__device__ __forceinline__ unsigned xb_xcc_id() { return (unsigned)__builtin_amdgcn_s_getreg((3 << 11) | 20) & 0xFu; }
#define XB_SPIN(cond, bar) do { unsigned _sp = 0; while (cond) { __builtin_amdgcn_s_sleep(1); \
    if ((++_sp & 255u) == 0u) { if (xb_ld(&(bar)[XB_TMO])) break; if (_sp > XB_SPIN_CAP) { atomicAdd(&(bar)[XB_TMO], 1u); break; } } } } while (0)

struct XcdBarrier {
    unsigned* bar; unsigned x;
    volatile LAS unsigned* st;
};

__device__ __forceinline__ XcdBarrier xcd_barrier_post(unsigned* bar, volatile LAS unsigned* st) {
    XcdBarrier b; b.bar = bar; b.x = xb_xcc_id(); b.st = st;
    if (threadIdx.x == 0) (void)xb_add(&bar[XB_XCNT(b.x)], 1u);
    return b;
}
__device__ __forceinline__ void xcd_barrier_complete(unsigned* bar, unsigned x, unsigned& nloc, unsigned& nx) {
    const unsigned G = gridDim.x * gridDim.y * gridDim.z;
    unsigned sum, cnt, mine, sp = 0u;
    for (;;) {
        sum = 0u; cnt = 0u; mine = 0u;
#pragma unroll
        for (unsigned j = 0; j < 16; ++j) { const unsigned c = xb_ld(&bar[XB_XCNT(j)]); sum += c; cnt += (c > 0u) ? 1u : 0u; mine = (j == x) ? c : mine; }
        if (sum == G) break;
        __builtin_amdgcn_s_sleep(1);
        if ((++sp & 255u) == 0u) { if (xb_ld(&bar[XB_TMO])) break; if (sp > XB_SPIN_CAP) { atomicAdd(&bar[XB_TMO], 1u); break; } }
    }
    nloc = mine > 0u ? mine : 1u; nx = cnt > 0u ? cnt : 1u;
}

__device__ __forceinline__ void xcd_barrier(const XcdBarrier& b) {
    asm volatile("s_waitcnt vmcnt(0)" ::: "memory");
    __syncthreads();
    if (threadIdx.x == 0) {
        unsigned* bar = b.bar;
        __builtin_amdgcn_s_waitcnt(0);
        unsigned nloc = b.st[0], nx = b.st[1];
        if (nloc == 0u) { xcd_barrier_complete(bar, b.x, nloc, nx); b.st[0] = nloc; b.st[1] = nx; }
        const unsigned old = xb_add(&bar[XB_XSUB(b.x)], 1u);
        const unsigned gen = old / nloc;
        if (old + 1u == (gen + 1u) * nloc) {
            __builtin_amdgcn_fence(__ATOMIC_RELEASE, "agent");
            asm volatile("s_waitcnt vmcnt(0)" ::: "memory");
            const unsigned og = xb_add(&bar[XB_TOP], 1u);
            const unsigned tg = og / nx;
            if (og + 1u == (tg + 1u) * nx) xb_add(&bar[XB_TOPGEN], 1u);
            else XB_SPIN(xb_ld(&bar[XB_TOPGEN]) == tg, bar);
            __builtin_amdgcn_fence(__ATOMIC_ACQUIRE, "agent");
            xb_add(&bar[XB_XGEN(b.x)], 1u);
            asm volatile("s_waitcnt vmcnt(0)" ::: "memory");
        } else {
            XB_SPIN(xb_ld(&bar[XB_XGEN(b.x)]) == gen, bar);
            __builtin_amdgcn_fence(__ATOMIC_ACQUIRE, "agent");
            asm volatile("s_waitcnt vmcnt(0)" ::: "memory");
        }
    }
    __syncthreads();
}
struct Fr {
    LAS unsigned char* lds;
    int tid, lane, wave, G, bid;
    const float* in[21]; float* out; unsigned char* ws;
};
#define WSP(T, off) ((T*)(F.ws + (off)))
#define LDSW() asm volatile("s_waitcnt lgkmcnt(0)" ::: "memory")

__device__ __forceinline__ int qk_perm(int d) { const int a = d >> 6, hf = (d >> 5) & 1, i = d & 31; return 32 * (2 * a + (i >> 4)) + 8 * ((i >> 2) & 3) + 4 * hf + (i & 3); }
__device__ __forceinline__ int dst_row(int mode, int n) {
    if (mode == 1) return ((n >> 7) << 8) + (n & 127);
    if (mode == 2) return ((n >> 7) << 8) + 128 + (n & 127);
    if (mode == 3) { if (n < 2048 || (n >= 4096 && n < 4608)) return (n & ~127) + qk_perm(n & 127); return n; }
    return n;
}
#ifndef WQ_DROP
#define WQ_DROP 2
#endif
__device__ __forceinline__ float wquant(float v) {
    if (WQ_DROP == 0) return v;
    unsigned u = __float_as_uint(v); constexpr unsigned sh = 16 + WQ_DROP, half = (1u << (sh - 1)) - 1u;
    u = (u + half + ((u >> sh) & 1u)) & ~((1u << sh) - 1u); return __uint_as_float(u);
}
__device__ __forceinline__ void transpose_item(const float* W, int K, int N, bf16* WT, int mode, const float* kscale, LAS float* scr, int item, int lane) {
    const int nblk = N / 32, kb = item / nblk, nb = item - kb * nblk, k0 = 64 * kb, n0 = 32 * nb;
    float wv[32];
#pragma unroll
    for (int i = 0; i < 32; ++i) wv[i] = __builtin_nontemporal_load(W + (size_t)(k0 + 2 * i + (lane >> 5)) * N + n0 + (lane & 31));
#pragma unroll
    for (int i = 0; i < 32; ++i) { const int kk = 2 * i + (lane >> 5); float v = wv[i]; if (kscale) v *= kscale[k0 + kk]; scr[kk * 33 + (lane & 31)] = (mode & 8) ? wquant(v) : v; }
    LDSW();
    const int c = lane & 7;
#pragma unroll
    for (int j = 0; j < 4; ++j) { const int n = (lane >> 3) + 8 * j; const LAS float* s = scr + (8 * c) * 33 + n;
        u32x4 o; o.x = pk_bf16(s[0 * 33], s[1 * 33]); o.y = pk_bf16(s[2 * 33], s[3 * 33]); o.z = pk_bf16(s[4 * 33], s[5 * 33]); o.w = pk_bf16(s[6 * 33], s[7 * 33]);
        *(u32x4*)(WT + (size_t)dst_row(mode & 7, n0 + n) * K + k0 + 8 * c) = o; }
    LDSW();
}
__device__ __forceinline__ void transpose_item8(const float* W, int K, int N, unsigned char* WT, LAS float* scr, int item, int lane) {
    const int nblk = N / 32, kb = item / nblk, nb = item - kb * nblk, k0 = 64 * kb, n0 = 32 * nb;
    float wv[32];
#pragma unroll
    for (int i = 0; i < 32; ++i) wv[i] = __builtin_nontemporal_load(W + (size_t)(k0 + 2 * i + (lane >> 5)) * N + n0 + (lane & 31));
#pragma unroll
    for (int i = 0; i < 32; ++i) { const int kk = 2 * i + (lane >> 5); scr[kk * 33 + (lane & 31)] = 2048.f * wv[i]; }
    LDSW();
    const int n = lane >> 1, kh = (lane & 1) * 32; const LAS float* s = scr + kh * 33 + n;
    u32x4 o0, o1;
    o0.x = pg8::pk4_fp8(s[0 * 33], s[1 * 33], s[2 * 33], s[3 * 33]); o0.y = pg8::pk4_fp8(s[4 * 33], s[5 * 33], s[6 * 33], s[7 * 33]);
    o0.z = pg8::pk4_fp8(s[8 * 33], s[9 * 33], s[10 * 33], s[11 * 33]); o0.w = pg8::pk4_fp8(s[12 * 33], s[13 * 33], s[14 * 33], s[15 * 33]);
    o1.x = pg8::pk4_fp8(s[16 * 33], s[17 * 33], s[18 * 33], s[19 * 33]); o1.y = pg8::pk4_fp8(s[20 * 33], s[21 * 33], s[22 * 33], s[23 * 33]);
    o1.z = pg8::pk4_fp8(s[24 * 33], s[25 * 33], s[26 * 33], s[27 * 33]); o1.w = pg8::pk4_fp8(s[28 * 33], s[29 * 33], s[30 * 33], s[31 * 33]);
    unsigned char* dst = WT + (size_t)(n0 + n) * K + k0 + kh;
    *(u32x4*)dst = o0; *(u32x4*)(dst + 16) = o1;
    LDSW();
}
constexpr int CV_F = 22016, CV_IN = 64 * 258, CV_OUT = 64 * 128;
constexpr int CV_WD0 = 2 * CV_F, CV_WIN = 3 * CV_F, CV_WOUT = CV_WIN + CV_IN, CV_G1 = CV_WOUT + CV_OUT, CV_U1 = CV_G1 + CV_F, CV_WD1 = CV_U1 + CV_F, CV_END = CV_WD1 + CV_F;
constexpr int CV_Q2_LO = CV_WD0, CV_Q2_HI = CV_WOUT;
constexpr int CV_Q5_LO = CV_WOUT, CV_Q5_HI = CV_G1 + 28000;
constexpr int CV_Q13_LO = CV_WD1, CV_Q13_HI = CV_END;
constexpr int CW_Q2 = 1024, CW_Q5 = 1088, CW_Q13 = 1152;
__device__ __forceinline__ void conv_item(Fr& F, int id, LAS float* scr) {
    const size_t FW = (size_t)DM * FF;
    if (id < CV_F) { transpose_item(F.in[8], DM, FF, WSP(bf16, WS_WGU0), 1 | 8, nullptr, scr, id, F.lane); return; }
    if (id < CV_WD0) { transpose_item(F.in[9], DM, FF, WSP(bf16, WS_WGU0), 2 | 8, nullptr, scr, id - CV_F, F.lane); return; }
    if (id < CV_WIN) { transpose_item(F.in[10], FF, DM, WSP(bf16, WS_WD0), 0 | 8, nullptr, scr, id - CV_WD0, F.lane); return; }
    if (id < CV_WOUT) { transpose_item(F.in[11], DM, 8256, WSP(bf16, WS_WIN), 3, nullptr, scr, id - CV_WIN, F.lane); return; }
    if (id < CV_G1) { const int r = id - CV_WOUT, kb = r / 128; const float* ks = (kb < 32) ? F.in[13] : (F.in[19] - 2048);
        transpose_item(F.in[20], DM, DM, WSP(bf16, WS_WOUT), 0, ks, scr, r, F.lane); return; }
    if (id < CV_U1) { transpose_item(F.in[8] + FW, DM, FF, WSP(bf16, WS_WGU1), 1 | 8, nullptr, scr, id - CV_G1, F.lane); return; }
    if (id < CV_WD1) { transpose_item(F.in[9] + FW, DM, FF, WSP(bf16, WS_WGU1), 2 | 8, nullptr, scr, id - CV_U1, F.lane); return; }
    transpose_item8(F.in[10] + FW, FF, DM, WSP(unsigned char, WS_WD1), scr, id - CV_WD1, F.lane);
}
__device__ __forceinline__ void p0_prologue(Fr& F, int rep = 0) {
    const int gw = F.bid * NWAVES + F.wave, NGW = F.G * NWAVES, gt = F.bid * NTHR + F.tid, NGT = F.G * NTHR;
    LAS float* scr = (LAS float*)(F.lds + F.wave * 8448);
    LAS float* sv = (LAS float*)(F.lds + 69632);
    for (int i = F.tid; i < 3 * DM; i += NTHR) { const int r = i >> 12, k = i & 4095; const float v = (r < 2) ? F.in[1][r * DM + k] : F.in[3][k]; sv[i] = v / (1.0f + __expf(-v)); }
    for (int e = gt; e < 4096; e += NGT) {
        const int pos = e >> 5, i = e & 31; double inv = 1.0; for (int q = 0; q < i; ++q) inv *= 0.74989420933245582730;
        double a = (double)pos * inv; const double k = __builtin_rint(a * 0.15915494309189533577); a = (a - k * 6.283185307179586232) - k * 2.449293598294706414e-16;
        const double a2 = a * a; double sn = 1.0, cs = 1.0;
        for (int q = 14; q >= 1; --q) { sn = 1.0 - sn * a2 / (double)((2 * q) * (2 * q + 1)); cs = 1.0 - cs * a2 / (double)((2 * q - 1) * (2 * q)); }
        sn *= a;
        WSP(float, WS_ROPE)[e] = (float)cs; WSP(float, WS_ROPE)[4096 + e] = (float)sn;
    }
    for (int e = gt; e < 192 * DM / 8; e += NGT) WSP(u32x4, WS_WIN + (size_t)8256 * DM * 2)[e] = (u32x4){0u, 0u, 0u, 0u};
    __syncthreads();
    {
        const float* wm = F.in[4]; const float* bm = F.in[5]; float* MOD = rep ? WSP(float, WS_YCP) : WSP(float, WS_MOD);
        for (int it = gw; it < 144 * 64; it += NGW) {
            const int chunk = it % 144, ks = it / 144, n = chunk * 256 + 4 * F.lane;
            f32x4 a0 = (f32x4){0.f, 0.f, 0.f, 0.f}, a1 = a0, a2 = a0;
            if (ks == 0) { a0 = *(const f32x4*)(bm + n); a1 = a0; a2 = a0; }
            const float* wp = wm + (size_t)(ks * 64) * NMOD + n; const LAS float* s = sv + ks * 64;
#pragma unroll 8
            for (int k = 0; k < 64; ++k) { const f32x4 w = __builtin_nontemporal_load((const f32x4*)(wp + (size_t)k * NMOD)); a0 += s[k] * w; a1 += s[DM + k] * w; a2 += s[2 * DM + k] * w; }
#pragma unroll
            for (int j = 0; j < 4; ++j) {
                __hip_atomic_fetch_add(MOD + n + j, a0[j], __ATOMIC_RELAXED, __HIP_MEMORY_SCOPE_AGENT);
                __hip_atomic_fetch_add(MOD + NMOD + n + j, a1[j], __ATOMIC_RELAXED, __HIP_MEMORY_SCOPE_AGENT);
                __hip_atomic_fetch_add(MOD + 2 * NMOD + n + j, a2[j], __ATOMIC_RELAXED, __HIP_MEMORY_SCOPE_AGENT); }
        }
    }
#ifndef PROBE_P0T
#define PROBE_P0T 1
#endif
    for (int rep = 0; rep < PROBE_P0T; ++rep) {
        for (int it = gw; it < CV_Q2_LO; it += NGW) conv_item(F, it, scr);
        for (int it = CV_Q5_HI + gw; it < CV_Q13_LO; it += NGW) conv_item(F, it, scr);
    }
}
__device__ __forceinline__ void conv_queue(Fr& F, int qword, int lo, int hi) {
    LAS float* scr = (LAS float*)(F.lds + F.wave * 8448);
    unsigned* ctr = (unsigned*)(F.ws + WS_CTL) + qword;
    for (;;) {
        unsigned b = 0; if (F.lane == 0) b = __hip_atomic_fetch_add(ctr, 4u, __ATOMIC_RELAXED, __HIP_MEMORY_SCOPE_AGENT);
        const int base = lo + (int)__builtin_amdgcn_readfirstlane(b);
        if (base >= hi) break;
        for (int q = 0; q < 4 && base + q < hi; ++q) conv_item(F, base + q, scr);
    }
}

__device__ __forceinline__ void norm_mod_row(const float* xrow, const float* g, const float* scale, const float* shift, bf16* hrow, int lane) {
    f32x4 v[16]; float ss = 0.f;
#pragma unroll
    for (int j = 0; j < 8; ++j) { const float* p = xrow + 512 * j + 8 * lane; v[2 * j] = __builtin_nontemporal_load((const f32x4*)p); v[2 * j + 1] = __builtin_nontemporal_load((const f32x4*)(p + 4)); }
#pragma unroll
    for (int j = 0; j < 16; ++j) ss += (v[j][0] * v[j][0] + v[j][1] * v[j][1]) + (v[j][2] * v[j][2] + v[j][3] * v[j][3]);
    const float rstd = 1.0f / sqrtf(wave_sum(ss) * (1.0f / DM) + EPS);
#pragma unroll
    for (int j = 0; j < 8; ++j) { const int o = 512 * j + 8 * lane;
        const f32x4 g0 = *(const f32x4*)(g + o), g1 = *(const f32x4*)(g + o + 4), s0 = *(const f32x4*)(scale + o), s1 = *(const f32x4*)(scale + o + 4), t0 = *(const f32x4*)(shift + o), t1 = *(const f32x4*)(shift + o + 4);
        const f32x4 a = v[2 * j] * rstd * g0 * (1.0f + s0) + t0, b = v[2 * j + 1] * rstd * g1 * (1.0f + s1) + t1;
        u32x4 w; w.x = pk_bf16q(a[0], a[1]); w.y = pk_bf16q(a[2], a[3]); w.z = pk_bf16q(b[0], b[1]); w.w = pk_bf16q(b[2], b[3]);
        *(u32x4*)(hrow + o) = w; }
}
template <bool STORE_X, bool DO_H, bool YSPLIT = false, bool XIN_BF = false, bool XOUT_BF = false, bool HQ = false>
__device__ __forceinline__ void res_norm_row(const void* xin_, const bf16* yrow, void* xout_, bf16* hrow, float coef, const float* gate, const float* gpost,
                                             const float* gpre, const float* scale, const float* shift, int lane, const float* ysplit = nullptr, float ymul = 1.0f) {
    u32x4 yv[8]; float ssy = 0.f;
    if (YSPLIT) {
#pragma unroll
        for (int j = 0; j < 8; ++j) { f32x4 a = (f32x4){0.f, 0.f, 0.f, 0.f}, b = a;
#pragma unroll
            for (int s = 0; s < 8; ++s) { const float* p = ysplit + (size_t)s * 512 * DM + 512 * j + 8 * lane; a += *(const f32x4*)p; b += *(const f32x4*)(p + 4); }
            yv[j].x = pk_f16(a[0], a[1]); yv[j].y = pk_f16(a[2], a[3]); yv[j].z = pk_f16(b[0], b[1]); yv[j].w = pk_f16(b[2], b[3]); }
    } else {
#pragma unroll
    for (int j = 0; j < 8; ++j) yv[j] = __builtin_nontemporal_load((const u32x4*)(yrow + 512 * j + 8 * lane));
    }
    f32x4 v[16];
#pragma unroll
    for (int j = 0; j < 8; ++j) {
        if (XIN_BF) { float f[8]; unpack8h(__builtin_nontemporal_load((const u32x4*)((const bf16*)xin_ + 512 * j + 8 * lane)), f); v[2 * j] = (f32x4){f[0], f[1], f[2], f[3]}; v[2 * j + 1] = (f32x4){f[4], f[5], f[6], f[7]}; }
        else { const float* p = (const float*)xin_ + 512 * j + 8 * lane; v[2 * j] = __builtin_nontemporal_load((const f32x4*)p); v[2 * j + 1] = __builtin_nontemporal_load((const f32x4*)(p + 4)); } }
#pragma unroll
    for (int j = 0; j < 8; ++j) { float f[8]; unpack8h(yv[j], f);
#pragma unroll
        for (int e = 0; e < 8; ++e) ssy += f[e] * f[e]; }
    const float ry = coef * ymul / sqrtf(wave_sum(ssy) * (ymul * ymul) * (1.0f / DM) + EPS);
    float ss = 0.f;
#pragma unroll
    for (int j = 0; j < 8; ++j) { const int o = 512 * j + 8 * lane; float f[8]; unpack8h(yv[j], f);
        const f32x4 ga0 = *(const f32x4*)(gate + o), ga1 = *(const f32x4*)(gate + o + 4), gp0 = *(const f32x4*)(gpost + o), gp1 = *(const f32x4*)(gpost + o + 4);
        const f32x4 y0 = (f32x4){f[0], f[1], f[2], f[3]}, y1 = (f32x4){f[4], f[5], f[6], f[7]};
        v[2 * j] += ga0 * gp0 * (y0 * ry); v[2 * j + 1] += ga1 * gp1 * (y1 * ry);
        if (STORE_X) {
            if (XOUT_BF) { u32x4 w; w.x = pk_f16(v[2 * j][0], v[2 * j][1]); w.y = pk_f16(v[2 * j][2], v[2 * j][3]); w.z = pk_f16(v[2 * j + 1][0], v[2 * j + 1][1]); w.w = pk_f16(v[2 * j + 1][2], v[2 * j + 1][3]);
                __builtin_nontemporal_store(w, (u32x4*)((bf16*)xout_ + o)); }
            else { __builtin_nontemporal_store(v[2 * j], (f32x4*)((float*)xout_ + o)); __builtin_nontemporal_store(v[2 * j + 1], (f32x4*)((float*)xout_ + o + 4)); } }
        if (DO_H) ss += (v[2 * j][0] * v[2 * j][0] + v[2 * j][1] * v[2 * j][1]) + (v[2 * j][2] * v[2 * j][2] + v[2 * j][3] * v[2 * j][3])
                      + (v[2 * j + 1][0] * v[2 * j + 1][0] + v[2 * j + 1][1] * v[2 * j + 1][1]) + (v[2 * j + 1][2] * v[2 * j + 1][2] + v[2 * j + 1][3] * v[2 * j + 1][3]); }
    if (DO_H) {
        const float rstd = 1.0f / sqrtf(wave_sum(ss) * (1.0f / DM) + EPS);
#pragma unroll
        for (int j = 0; j < 8; ++j) { const int o = 512 * j + 8 * lane;
            const f32x4 g0 = *(const f32x4*)(gpre + o), g1 = *(const f32x4*)(gpre + o + 4), s0 = *(const f32x4*)(scale + o), s1 = *(const f32x4*)(scale + o + 4), t0 = *(const f32x4*)(shift + o), t1 = *(const f32x4*)(shift + o + 4);
            const f32x4 a = v[2 * j] * rstd * g0 * (1.0f + s0) + t0, b = v[2 * j + 1] * rstd * g1 * (1.0f + s1) + t1;
            u32x4 w;
            if (HQ) { w.x = pk_bf16q(a[0], a[1]); w.y = pk_bf16q(a[2], a[3]); w.z = pk_bf16q(b[0], b[1]); w.w = pk_bf16q(b[2], b[3]); }
            else { w.x = pk_bf16(a[0], a[1]); w.y = pk_bf16(a[2], a[3]); w.z = pk_bf16(b[0], b[1]); w.w = pk_bf16(b[2], b[3]); }
            *(u32x4*)(hrow + o) = w; }
    }
}
__device__ __forceinline__ int mod_row_of(int m) { return m < NLAT ? (m >> 13) : 2; }
__device__ __forceinline__ const float* xin_row(Fr& F, int m) { return m < NLAT ? F.in[0] + (size_t)m * DM : F.in[2] + (size_t)(m - NLAT) * DM; }

__device__ __forceinline__ void p1_norm(Fr& F) {
    const int gw = F.bid * NWAVES + F.wave, NGW = F.G * NWAVES; const float* MOD = WSP(float, WS_MOD);
    for (int m = gw; m < MROWS; m += NGW) { const float* md = MOD + (size_t)mod_row_of(m) * NMOD;
        norm_mod_row(xin_row(F, m), F.in[6], md + 1 * DM, md + 0 * DM, WSP(bf16, WS_H) + (size_t)m * DM, F.lane); }
}
__device__ __forceinline__ void p4_resnorm(Fr& F) {
    const int gw = F.bid * NWAVES + F.wave, NGW = F.G * NWAVES; const float* MOD = WSP(float, WS_MOD);
    for (int m = gw; m < MROWS; m += NGW) { const float* md = MOD + (size_t)mod_row_of(m) * NMOD; const bf16* y = WSP(bf16, WS_Y) + (size_t)m * DM; bf16* h = WSP(bf16, WS_H) + (size_t)m * DM;
        if (m < NLAT) res_norm_row<true, true, false, false, true>(xin_row(F, m), y, WSP(bf16, WS_X1) + (size_t)m * DM, h, 0.5f, md + 2 * DM, F.in[7], F.in[6] + DM, md + 4 * DM, md + 3 * DM, F.lane);
        else res_norm_row<false, true, true>(xin_row(F, m), y, nullptr, h, 0.5f, md + 2 * DM, F.in[7], F.in[6] + DM, md + 4 * DM, md + 3 * DM, F.lane, WSP(float, WS_YCP) + (size_t)(m - NLAT) * DM); }
}
__device__ __forceinline__ void p12_resnorm(Fr& F) {
    const int gw = F.bid * NWAVES + F.wave, NGW = F.G * NWAVES; const float* MOD = WSP(float, WS_MOD);
    for (int m = gw; m < NLAT; m += NGW) { const float* md = MOD + (size_t)(m >> 13) * NMOD;
        const float rs = 1.0f / sqrtf(WSP(float, WS_ROWSS)[NLAT + m] * (1.0f / 2048.f) + EPS);
        res_norm_row<true, true, false, true, true, true>(WSP(bf16, WS_X1) + (size_t)m * DM, WSP(bf16, WS_Y) + (size_t)m * DM, WSP(bf16, WS_X1) + (size_t)m * DM, WSP(bf16, WS_H) + (size_t)m * DM, 1.0f, md + 5 * DM, F.in[7] + DM, F.in[6] + 2 * DM, md + 7 * DM, md + 6 * DM, F.lane, nullptr, rs); }
}
__device__ __forceinline__ void p15_final(Fr& F) {
    const int gw = F.bid * NWAVES + F.wave, NGW = F.G * NWAVES; const float* MOD = WSP(float, WS_MOD);
    for (int m = gw; m < NLAT; m += NGW) { const float* md = MOD + (size_t)(m >> 13) * NMOD;
        res_norm_row<true, false, false, true, false>(WSP(bf16, WS_X1) + (size_t)m * DM, WSP(bf16, WS_Y) + (size_t)m * DM, F.out + (size_t)m * DM, nullptr, 0.5f, md + 8 * DM, F.in[7] + 2 * DM, nullptr, nullptr, nullptr, F.lane); }
}
__device__ __forceinline__ void p10_merge(Fr& F) {
    const int gw = F.bid * NWAVES + F.wave, NGW = F.G * NWAVES;
    for (int m = gw; m < NLAT; m += NGW) {
        const bf16* a = WSP(bf16, WS_OATT) + (size_t)m * 2048; const bf16* s = WSP(bf16, WS_YS) + (size_t)m * 2048; bf16* h = WSP(bf16, WS_H) + (size_t)m * DM;
        u32x4 av[4], sv[4]; float sa = 0.f, ssm = 0.f;
#pragma unroll
        for (int j = 0; j < 4; ++j) { av[j] = *(const u32x4*)(a + 512 * j + 8 * F.lane); sv[j] = *(const u32x4*)(s + 512 * j + 8 * F.lane); }
#pragma unroll
        for (int j = 0; j < 4; ++j) { float f[8], q[8]; unpack8(av[j], f); unpack8(sv[j], q);
#pragma unroll
            for (int e = 0; e < 8; ++e) { sa += f[e] * f[e]; ssm += q[e] * q[e]; } }
        const float ra = 1.0f / sqrtf(wave_sum(sa) * (1.0f / 2048.f) + EPS), rs = 1.0f / sqrtf(wave_sum(ssm) * (1.0f / 2048.f) + EPS);
#pragma unroll
        for (int j = 0; j < 4; ++j) { float f[8], q[8]; unpack8(av[j], f); unpack8(sv[j], q);
            u32x4 w; w.x = pk_bf16(f[0] * ra, f[1] * ra); w.y = pk_bf16(f[2] * ra, f[3] * ra); w.z = pk_bf16(f[4] * ra, f[5] * ra); w.w = pk_bf16(f[6] * ra, f[7] * ra);
            *(u32x4*)(h + 512 * j + 8 * F.lane) = w;
            w.x = pk_bf16(q[0] * rs, q[1] * rs); w.y = pk_bf16(q[2] * rs, q[3] * rs); w.z = pk_bf16(q[4] * rs, q[5] * rs); w.w = pk_bf16(q[6] * rs, q[7] * rs);
            *(u32x4*)(h + 2048 + 512 * j + 8 * F.lane) = w; }
    }
}

__device__ __forceinline__ void p6_conv(Fr& F) {
    const int gw = F.bid * NWAVES + F.wave, NGW = F.G * NWAVES;
    const bf16* P = WSP(bf16, WS_P); bf16* XC = WSP(bf16, WS_XC); const float* cw = F.in[14]; const float* cb = F.in[15];
    u32x4 nxt[20];
#define CV_ROWS(itx) do { const int rb_ = (itx) / 6, cgi_ = (itx) - rb_ * 6, m0_ = rb_ * 16, c0_ = (cgi_ * 64 + F.lane) * 8; \
        int s0_, s1_; if (m0_ < NLAT) { s0_ = m0_ & ~(SEQ - 1); s1_ = s0_ + SEQ; } else { s0_ = NLAT + ((m0_ - NLAT) & ~(CTXL - 1)); s1_ = s0_ + CTXL; } \
        _Pragma("unroll") for (int r = 0; r < 20; ++r) { const int row = m0_ - 2 + r; const bool ok = row >= s0_ && row < s1_; const int rc = row < s0_ ? s0_ : (row >= s1_ ? s1_ - 1 : row); \
            const u32x4 v = *(const u32x4*)(P + (size_t)rc * NINP + PXBC + c0_); nxt[r] = ok ? v : (u32x4){0u, 0u, 0u, 0u}; } } while (0)
    if (gw < (MROWS / 16) * 6) CV_ROWS(gw);
    for (int it = gw; it < (MROWS / 16) * 6; it += NGW) {
        const int rb = it / 6, cgi = it - rb * 6, m0 = rb * 16, c0 = (cgi * 64 + F.lane) * 8;
        u32x4 raw[20];
#pragma unroll
        for (int r = 0; r < 20; ++r) raw[r] = nxt[r];
        if (it + NGW < (MROWS / 16) * 6) CV_ROWS(it + NGW);
        float w[5][8], bias[8];
#pragma unroll
        for (int k = 0; k < 5; ++k) { const f32x4 a = *(const f32x4*)(cw + k * XBCW + c0), b = *(const f32x4*)(cw + k * XBCW + c0 + 4);
            w[k][0] = a[0]; w[k][1] = a[1]; w[k][2] = a[2]; w[k][3] = a[3]; w[k][4] = b[0]; w[k][5] = b[1]; w[k][6] = b[2]; w[k][7] = b[3]; }
        { const f32x4 a = *(const f32x4*)(cb + c0), b = *(const f32x4*)(cb + c0 + 4); bias[0] = a[0]; bias[1] = a[1]; bias[2] = a[2]; bias[3] = a[3]; bias[4] = b[0]; bias[5] = b[1]; bias[6] = b[2]; bias[7] = b[3]; }
#pragma unroll
        for (int t = 0; t < 16; ++t) {
            float acc[8];
#pragma unroll
            for (int e = 0; e < 8; ++e) acc[e] = bias[e];
#pragma unroll
            for (int k = 0; k < 5; ++k) { float f[8]; unpack8(raw[t + k], f);
#pragma unroll
                for (int e = 0; e < 8; ++e) acc[e] += w[k][e] * f[e]; }
            u32x4 o; o.x = pk_bf16(silu_f(acc[0]), silu_f(acc[1])); o.y = pk_bf16(silu_f(acc[2]), silu_f(acc[3])); o.z = pk_bf16(silu_f(acc[4]), silu_f(acc[5])); o.w = pk_bf16(silu_f(acc[6]), silu_f(acc[7]));
            *(u32x4*)(XC + (size_t)(m0 + t) * XBCW + c0) = o;
        }
    }
#undef CV_ROWS
}

constexpr int AT_KS = 288, AT_VS = 144, AT_K_OFF = 0, AT_V_OFF = 64 * AT_KS, AT_STG = 64 * AT_KS + 128 * AT_VS;
__device__ __forceinline__ bool attn_tile(int idx, int b, int qb, int& rowbase, int& mt) {
    if (idx < 5) { const int kt = qb + idx - 2; mt = (idx == 0) ? -1 : ((idx == 4) ? 1 : 0); rowbase = b * SEQ + kt * 64; return kt >= 0 && kt < 128; }
    mt = 0; rowbase = NLAT + b * CTXL + (idx - 5) * 64; return true;
}
#ifndef AT_DEPHASE
#define AT_DEPHASE 0
#endif
template <int ABL, int ORD>
__device__ __forceinline__ void attn_unit(Fr& F, const int u, const bool doatom) {
    const bf16* P = WSP(bf16, WS_P); bf16* O = ABL ? WSP(bf16, WS_SLOC) : WSP(bf16, WS_H); float* SSA = WSP(float, WS_ROWSS);
    const int fr = F.lane & 15, g = F.lane >> 4, w = F.wave, hg = w >> 1, half = w & 1;
    const int srow = F.tid >> 3, sd0 = (F.tid & 7) * 16;
    const int vkp = F.tid >> 4, vdq = F.tid & 15;
    const int kfo = fr * AT_KS + 16 * g, vlo0 = fr * AT_VS + (4 * g) * 2, vlo1 = fr * AT_VS + ((4 * g) ^ 8) * 2;
    int vhi0 = vlo0, vhi1 = vlo1; asm volatile("" : "+v"(vhi0), "+v"(vhi1));
    {
        const int qb = u & 127, kvh = (u >> 7) & 3, b = u >> 9, head = kvh * 4 + hg;
        const int r0 = b * SEQ + qb * 64 + half * 32;
        bf16x8 qf[2][4];
#pragma unroll
        for (int m = 0; m < 2; ++m)
#pragma unroll
            for (int ks = 0; ks < 4; ++ks) qf[m][ks] = *(const bf16x8*)(P + (size_t)(r0 + 16 * m + fr) * NINP + PQ + head * 128 + 32 * ks + 8 * g);
        f32x4 accO[8][2];
#pragma unroll
        for (int n = 0; n < 8; ++n) { accO[n][0] = (f32x4){0.f, 0.f, 0.f, 0.f}; accO[n][1] = (f32x4){0.f, 0.f, 0.f, 0.f}; }
        const float sink = F.in[12][head] * LOG2E;
        float mrun[2] = {sink, sink}, lpart[2] = {g == 0 ? 1.0f : 0.0f, g == 0 ? 1.0f : 0.0f};
        int idx = 0, rowbase = 0, mt = 0;
        while (!attn_tile(idx, b, qb, rowbase, mt)) ++idx;
        int nidx = idx + 1, nrow = 0, nmt = 0;
        while (nidx < 9 && !attn_tile(nidx, b, qb, nrow, nmt)) ++nidx;
        u32x4 kr[2][2], vr[2][2];
#define AT_LOAD(rb, S_) do { const bf16* kp = P + (size_t)((rb) + srow) * NINP + PK + kvh * 128 + sd0; kr[S_][0] = *(const u32x4*)kp; kr[S_][1] = *(const u32x4*)(kp + 8); \
                         const bf16* vp = P + (size_t)((rb) + 2 * vkp) * NINP + PV + kvh * 128 + 8 * vdq; vr[S_][0] = *(const u32x4*)vp; vr[S_][1] = *(const u32x4*)(vp + NINP); } while (0)
#define AT_WRITE(st, S_) do { LAS unsigned char* kt_ = F.lds + (st) * AT_STG; LAS unsigned char* vt_ = kt_ + AT_V_OFF; \
            *(LAS u32x4*)(kt_ + srow * AT_KS + sd0 * 2) = kr[S_][0]; *(LAS u32x4*)(kt_ + srow * AT_KS + sd0 * 2 + 16) = kr[S_][1]; \
            const unsigned va_[4] = {vr[S_][0].x, vr[S_][0].y, vr[S_][0].z, vr[S_][0].w}, vb2_[4] = {vr[S_][1].x, vr[S_][1].y, vr[S_][1].z, vr[S_][1].w}; const int vsw_ = ((2 * vkp) ^ (8 * (vdq >> 1))) * 2;     \
            _Pragma("unroll") for (int j = 0; j < 4; ++j) { *(LAS unsigned*)(vt_ + (8 * vdq + 2 * j) * AT_VS + vsw_) = __builtin_amdgcn_perm(vb2_[j], va_[j], 0x05040100u); *(LAS unsigned*)(vt_ + (8 * vdq + 2 * j + 1) * AT_VS + vsw_) = __builtin_amdgcn_perm(vb2_[j], va_[j], 0x07060302u); } } while (0)
        int n2 = (nidx < 9) ? nidx + 1 : 9, n2row = 0, n2mt = 0;
        while (n2 < 9 && !attn_tile(n2, b, qb, n2row, n2mt)) ++n2;
        AT_LOAD(rowbase, 0);
        if (nidx < 9) AT_LOAD(nrow, 1);
        __syncthreads();
        AT_WRITE(0, 0);
        if (n2 < 9) AT_LOAD(n2row, 0);
        __syncthreads();
        int st = 0;
        bf16x8 pf[2][2];
        LAS unsigned char* VTp = F.lds + AT_V_OFF;
        if (ORD) {
#pragma unroll
            for (int m = 0; m < 2; ++m)
#pragma unroll
                for (int s = 0; s < 2; ++s) pf[m][s] = (bf16x8){0, 0, 0, 0, 0, 0, 0, 0}; }
        for (;;) {
#pragma unroll
          for (int par = 0; par < 2; ++par) {
            LAS unsigned char* Kt = F.lds + st * AT_STG; LAS unsigned char* VT = Kt + AT_V_OFF;
#define AT_KF(n, ks) (*(const LAS bf16x8*)(Kt + kfo + (16 * (n)) * AT_KS + (32 * (ks)) * 2))
#define AT_VF(i, dst) do { const LAS unsigned char* vb_ = VT + ((((i) & 7) & 1) ? vlo1 : vlo0) + (16 * ((i) & 7)) * AT_VS; const LAS unsigned char* vc_ = VT + ((((i) & 7) & 1) ? vhi1 : vhi0) + (16 * ((i) & 7)) * AT_VS; \
                const u32x2 v0_ = *(const LAS u32x2*)(vb_ + ((32 * ((i) >> 3)) ^ ((8 * ((i) & 7)) & 48)) * 2), v1_ = *(const LAS u32x2*)(vc_ + ((32 * ((i) >> 3) + 16) ^ ((8 * ((i) & 7)) & 48)) * 2); \
                dst = __builtin_bit_cast(bf16x8, (u32x4){v0_.x, v0_.y, v1_.x, v1_.y}); } while (0)
#define AT_QK(M0, M1) \
            f32x4 accS[4][2]; \
            _Pragma("unroll") for (int n = 0; n < 4; ++n) _Pragma("unroll") for (int m = M0; m < M1; ++m) accS[n][m] = (f32x4){0.f, 0.f, 0.f, 0.f}; \
            bf16x8 kf[2][4]; \
            _Pragma("unroll") for (int n = 0; n < 4; ++n) kf[0][n] = AT_KF(n, 0); \
            __builtin_amdgcn_s_setprio(1); \
            _Pragma("unroll") for (int ks = 0; ks < 4; ++ks) { \
                if (ks < 3) { _Pragma("unroll") for (int n = 0; n < 4; ++n) kf[(ks + 1) & 1][n] = AT_KF(n, ks + 1); } \
                __builtin_amdgcn_sched_barrier(0); \
                _Pragma("unroll") for (int n = 0; n < 4; ++n) _Pragma("unroll") for (int m = M0; m < M1; ++m) accS[n][m] = __builtin_amdgcn_mfma_f32_16x16x32_bf16(kf[ks & 1][n], qf[m][ks], accS[n][m], 0, 0, 0); \
                __builtin_amdgcn_sched_barrier(0); } \
            __builtin_amdgcn_s_setprio(0);
#define AT_VPRE() \
            if (ABL != 2) { _Pragma("unroll") for (int i = 0; i < 3; ++i) AT_VF(i, vq[i]); }     \
            __builtin_amdgcn_sched_barrier(0);
#define AT_SMX(M0, M1) \
            if (mt != 0) {   \
                _Pragma("unroll") for (int m = M0; m < M1; ++m) { const int ii = half * 32 + 16 * m + fr; \
                    _Pragma("unroll") for (int n = 0; n < 4; ++n) _Pragma("unroll") for (int r = 0; r < 4; ++r) { const int jj = 16 * n + 4 * g + r; const bool ok = (mt < 0) ? (jj >= ii) : (jj <= ii); if (!ok) accS[n][m][r] = -1e30f; } } } \
            _Pragma("unroll") for (int m = M0; m < M1; ++m) { \
                if (ABL == 0) { \
                    float mx = __builtin_fmaxf(__builtin_fmaxf(accS[0][m][0], accS[0][m][1]), __builtin_fmaxf(accS[0][m][2], accS[0][m][3])); \
                    _Pragma("unroll") for (int n = 1; n < 4; ++n) { mx = __builtin_fmaxf(__builtin_fmaxf(mx, accS[n][m][0]), accS[n][m][1]); mx = __builtin_fmaxf(__builtin_fmaxf(mx, accS[n][m][2]), accS[n][m][3]); } \
                    mx = row_max(mx); \
                    const float mn = __any(mx > mrun[m] + 8.0f) ? fmaxf(mrun[m], mx) : mrun[m];     \
                    const float alpha = __builtin_amdgcn_exp2f(mrun[m] - mn); mrun[m] = mn; \
                    f32x4 ps4 = (f32x4){0.f, 0.f, 0.f, 0.f}; \
                    _Pragma("unroll") for (int n = 0; n < 4; ++n) { const f32x4 d = accS[n][m] - mn; f32x4 pv; \
                        pv[0] = __builtin_amdgcn_exp2f(d[0]); pv[1] = __builtin_amdgcn_exp2f(d[1]); pv[2] = __builtin_amdgcn_exp2f(d[2]); pv[3] = __builtin_amdgcn_exp2f(d[3]); \
                        accS[n][m] = pv; ps4 += pv; } \
                    lpart[m] = lpart[m] * alpha + ((ps4[0] + ps4[1]) + (ps4[2] + ps4[3])); \
                    if (!__all(alpha == 1.0f)) { _Pragma("unroll") for (int n = 0; n < 8; ++n) accO[n][m] *= alpha; } \
                } \
                _Pragma("unroll") for (int s = 0; s < 2; ++s) { u32x4 t; t.x = pk_bf16(accS[2 * s][m][0], accS[2 * s][m][1]); t.y = pk_bf16(accS[2 * s][m][2], accS[2 * s][m][3]); \
                    t.z = pk_bf16(accS[2 * s + 1][m][0], accS[2 * s + 1][m][1]); t.w = pk_bf16(accS[2 * s + 1][m][2], accS[2 * s + 1][m][3]); pf[m][s] = __builtin_bit_cast(bf16x8, t); } }
#define AT_PVX(M0, M1) \
            __builtin_amdgcn_sched_barrier(0); \
            __builtin_amdgcn_s_setprio(1); \
            if (ABL != 2) { _Pragma("unroll") for (int i = 0; i < 16; ++i) { \
                if (i + 3 < 16) AT_VF(i + 3, vq[(i + 3) % 6]);     \
                __builtin_amdgcn_sched_barrier(0); \
                _Pragma("unroll") for (int m = M0; m < M1; ++m) accO[i & 7][m] = __builtin_amdgcn_mfma_f32_16x16x32_bf16(vq[i % 6], pf[m][i >> 3], accO[i & 7][m], 0, 0, 0); \
                __builtin_amdgcn_sched_barrier(0); } } \
            __builtin_amdgcn_s_setprio(0);
            bf16x8 vq[6];
            if (ORD == 0) { AT_QK(0, 2); AT_VPRE(); AT_SMX(0, 2); AT_PVX(0, 2); }
            else {
                { LAS unsigned char* VT = VTp; AT_VPRE(); AT_PVX(0, 2); }
                AT_QK(0, 2); AT_SMX(0, 2);
                VTp = VT; }
            if (nidx >= 9) goto at_done;
            const int sn = (st == 2) ? 0 : st + 1;
            AT_WRITE(sn, par ^ 1);
            int n3 = (n2 < 9) ? n2 + 1 : 9, n3row = 0, n3mt = 0;
            while (n3 < 9 && !attn_tile(n3, b, qb, n3row, n3mt)) ++n3;
            if (n3 < 9) AT_LOAD(n3row, par ^ 1);
            __syncthreads();
            st = sn; mt = nmt; nidx = n2; nmt = n2mt; n2 = n3; n2mt = n3mt;
          }
        }
        at_done:
        if (ORD) { bf16x8 vq[6]; LAS unsigned char* VT = VTp; AT_VPRE(); AT_PVX(0, 2); }
#undef AT_QK
#undef AT_VPRE
#undef AT_SMX
#undef AT_PVX
#undef AT_VF
#undef AT_KF
#undef AT_LOAD
#undef AT_WRITE
#pragma unroll
        for (int m = 0; m < 2; ++m) {
            const float l = row_sum(lpart[m]), inv = 1.0f / l;
            bf16* op = O + (size_t)(r0 + 16 * m + fr) * DM + head * 128 + 4 * g; float ss = 0.f;
#pragma unroll
            for (int n = 0; n < 8; ++n) { const f32x4 o = accO[n][m] * inv; ss += (o[0] * o[0] + o[1] * o[1]) + (o[2] * o[2] + o[3] * o[3]);
                u32x2 t; t.x = pk_bf16(o[0], o[1]); t.y = pk_bf16(o[2], o[3]); *(u32x2*)(op + 16 * n) = t; }
            ss = row_sum(ss);
            if (g == 0 && doatom) __hip_atomic_fetch_add(SSA + r0 + 16 * m + fr, ss, __ATOMIC_RELAXED, __HIP_MEMORY_SCOPE_AGENT);
        }
    }
}
template <int ABL = 0>
__device__ __forceinline__ void p6_attn(Fr& F, bool doatom = true) {
    for (int u = F.bid; u < 1024; u += F.G) { if (AT_DEPHASE && F.wave < 4) attn_unit<ABL, 1>(F, u, doatom); else attn_unit<ABL, 0>(F, u, doatom); }
    __syncthreads();
}
__device__ __forceinline__ void chunk_scan(const float* dtp  , float a, bool rev, int lane, int& t0, int& t1, float& d0, float& d1, float& c0, float& c1, float& total) {
    t0 = rev ? 127 - 2 * lane : 2 * lane; t1 = rev ? 126 - 2 * lane : 2 * lane + 1;
    d0 = dtp[(size_t)t0 * 32]; d1 = dtp[(size_t)t1 * 32];
    const float v0 = d0 * a, v1 = d1 * a; float s = v0 + v1;
#pragma unroll
    for (int o = 1; o < 64; o <<= 1) { const float t = __shfl_up(s, o); if (lane >= o) s += t; }
    const float ex = s - (v0 + v1); c0 = ex + v0; c1 = s; total = __shfl(s, 63);
}
constexpr int SS = 272;
__device__ __forceinline__ int sc_row0(int sc) { return sc < 128 ? sc * 128 : NLAT + (sc - 128) * 128; }

__device__ __forceinline__ void p7_states(Fr& F) {
    const bf16* XC = WSP(bf16, WS_XC); bf16* SL = WSP(bf16, WS_SLOC); float* DEC = WSP(float, WS_DEC);
    const int fr = F.lane & 15, g4 = F.lane >> 4, w = F.wave;
    LAS unsigned char* BT = F.lds; LAS unsigned char* XTf = F.lds + 34816; LAS unsigned char* XTb = F.lds + 52224; LAS float* WF = (LAS float*)(F.lds + 69632); LAS float* WB = WF + 8 * 128;
    const int sj = F.tid >> 2, sps = (F.tid & 3) * 16;
    for (int u = F.bid; u < 512 + 64; u += F.G) {
        const int uq = u - 512;
        const int grp = (u < 512) ? (u & 3) : ((uq >> 2) & 3), sc = (u < 512) ? (u >> 2) : (128 + (uq >> 4)), m0 = sc_row0(sc);
        const int h_lo = (u < 512) ? 0 : (uq & 3) * 2, h_hi = (u < 512) ? 8 : h_lo + 2;
        __syncthreads();
        { const int ns = (F.tid & 3) * 32; const bf16* bp = XC + (size_t)(m0 + sj) * XBCW + 2048 + grp * 128 + ns;
#pragma unroll
          for (int q = 0; q < 4; ++q) { const u32x4 v = *(const u32x4*)(bp + 8 * q); const unsigned vw[4] = {v.x, v.y, v.z, v.w};
#pragma unroll
              for (int e = 0; e < 4; ++e) { *(LAS unsigned short*)(BT + (ns + 8 * q + 2 * e) * SS + sj * 2) = (unsigned short)(vw[e] & 0xffffu); *(LAS unsigned short*)(BT + (ns + 8 * q + 2 * e + 1) * SS + sj * 2) = (unsigned short)(vw[e] >> 16); } } }
        if (w >= h_lo && w < h_hi) { const int h = grp * 8 + w;
#pragma unroll
          for (int dir = 0; dir < 2; ++dir) { const float a = -__expf(F.in[16][dir * 32 + h]); int t0, t1; float d0, d1, c0, c1, tot;
              chunk_scan(WSP(float, dir ? WS_DTB : WS_DTF) + (size_t)m0 * 32 + h, a, dir == 1, F.lane, t0, t1, d0, d1, c0, c1, tot);
              LAS float* wa = (dir ? WB : WF) + w * 128; wa[t0] = __expf(tot - c0) * d0; wa[t1] = __expf(tot - c1) * d1;
              if (F.lane == 0) DEC[(sc * 2 + dir) * 32 + h] = __expf(tot); } }
        u32x4 xr[2];
        { const bf16* xp = XC + (size_t)(m0 + sj) * XBCW + (grp * 8 + h_lo) * 64 + sps; xr[0] = *(const u32x4*)xp; xr[1] = *(const u32x4*)(xp + 8); }
        __syncthreads();
        for (int hh = h_lo; hh < h_hi; ++hh) {
            const int h = grp * 8 + hh;
            { const float wf = WF[hh * 128 + sj], wb = WB[hh * 128 + sj];
#pragma unroll
              for (int q = 0; q < 2; ++q) { float f[8]; unpack8(xr[q], f);
#pragma unroll
                  for (int e = 0; e < 8; ++e) { *(LAS unsigned short*)(XTf + (sps + 8 * q + e) * SS + sj * 2) = f2bf(f[e] * wf); *(LAS unsigned short*)(XTb + (sps + 8 * q + e) * SS + sj * 2) = f2bf(f[e] * wb); } } }
            __syncthreads();
            if (hh < h_hi - 1) { const bf16* xp = XC + (size_t)(m0 + sj) * XBCW + (h + 1) * 64 + sps; xr[0] = *(const u32x4*)xp; xr[1] = *(const u32x4*)(xp + 8); }
            const int pt = w & 3, ntb = (w >> 2) * 4;
            f32x4 aF[4], aB[4];
#pragma unroll
            for (int n = 0; n < 4; ++n) { aF[n] = (f32x4){0.f, 0.f, 0.f, 0.f}; aB[n] = (f32x4){0.f, 0.f, 0.f, 0.f}; }
#pragma unroll
            for (int ks = 0; ks < 4; ++ks) {
                const bf16x8 xf = *(const LAS bf16x8*)(XTf + (16 * pt + fr) * SS + (32 * ks + 8 * g4) * 2), xb = *(const LAS bf16x8*)(XTb + (16 * pt + fr) * SS + (32 * ks + 8 * g4) * 2);
#pragma unroll
                for (int n = 0; n < 4; ++n) { const bf16x8 bt = *(const LAS bf16x8*)(BT + (16 * (ntb + n) + fr) * SS + (32 * ks + 8 * g4) * 2);
                    aF[n] = __builtin_amdgcn_mfma_f32_16x16x32_bf16(bt, xf, aF[n], 0, 0, 0); aB[n] = __builtin_amdgcn_mfma_f32_16x16x32_bf16(bt, xb, aB[n], 0, 0, 0); }
            }
            bf16* sf = SL + ((size_t)(sc * 2 + 0) * 32 + h) * 8192 + (16 * pt + fr) * 128 + 4 * g4; bf16* sb = SL + ((size_t)(sc * 2 + 1) * 32 + h) * 8192 + (16 * pt + fr) * 128 + 4 * g4;
#pragma unroll
            for (int n = 0; n < 4; ++n) { u32x2 o; o.x = pk_bf16(aF[n][0], aF[n][1]); o.y = pk_bf16(aF[n][2], aF[n][3]); *(u32x2*)(sf + 16 * (ntb + n)) = o;
                o.x = pk_bf16(aB[n][0], aB[n][1]); o.y = pk_bf16(aB[n][2], aB[n][3]); *(u32x2*)(sb + 16 * (ntb + n)) = o; }
            __syncthreads();
        }
    }
}

__device__ __forceinline__ void p8_scan(Fr& F) {
    const bf16* SL = WSP(bf16, WS_SLOC); const float* DEC = WSP(float, WS_DEC); bf16* HIN = WSP(bf16, WS_HIN);
    for (int e = F.bid * NTHR + F.tid; e < 2 * 2 * 32 * 1024; e += F.G * NTHR) {
        const int el = (e & 1023) * 8, h = (e >> 10) & 31, dir = (e >> 15) & 1, b = e >> 16;
        const int sA = 128 + 2 * b + (dir ? 1 : 0), sB = 128 + 2 * b + (dir ? 0 : 1);
        float fa[8], fb[8], hc[8];
        unpack8(*(const u32x4*)(SL + ((size_t)(sA * 2 + dir) * 32 + h) * 8192 + el), fa); unpack8(*(const u32x4*)(SL + ((size_t)(sB * 2 + dir) * 32 + h) * 8192 + el), fb);
        const float db = DEC[(sB * 2 + dir) * 32 + h];
#pragma unroll
        for (int q = 0; q < 8; ++q) hc[q] = fb[q] + db * fa[q];
        u32x4 qs[8]; float qd[8];
#define P8_LD(cc_, slot_) do { const int c_ = dir ? 63 - (cc_) : (cc_), sc_ = b * 64 + c_; qs[slot_] = *(const u32x4*)(SL + ((size_t)(sc_ * 2 + dir) * 32 + h) * 8192 + el); qd[slot_] = DEC[(sc_ * 2 + dir) * 32 + h]; } while (0)
#pragma unroll
        for (int i = 0; i < 8; ++i) P8_LD(i, i);
        for (int cb = 0; cb < 64; cb += 8)
#pragma unroll
        for (int j = 0; j < 8; ++j) { const int cc = cb + j;
            const int c = dir ? 63 - cc : cc, sc = b * 64 + c; const size_t off = ((size_t)(sc * 2 + dir) * 32 + h) * 8192 + el;
            float s[8]; unpack8(qs[j], s); const float d = qd[j];
            if (cc + 8 < 64) P8_LD(cc + 8, j);
            u32x4 o; o.x = pk_bf16(hc[0], hc[1]); o.y = pk_bf16(hc[2], hc[3]); o.z = pk_bf16(hc[4], hc[5]); o.w = pk_bf16(hc[6], hc[7]);
            *(u32x4*)(HIN + off) = o;
#pragma unroll
            for (int q = 0; q < 8; ++q) hc[q] = d * hc[q] + s[q];
        }
#undef P8_LD
    }
}

__device__ __forceinline__ void p9_ssd_out(Fr& F, bool doatom = true) {
    const bf16* XC = WSP(bf16, WS_XC); const bf16* P = WSP(bf16, WS_P); const bf16* HIN = WSP(bf16, WS_HIN); bf16* YS = WSP(bf16, WS_H) + 2048; float* SSS = WSP(float, WS_ROWSS) + NLAT;
    const int fr = F.lane & 15, g4 = F.lane >> 4, w = F.wave;
    LAS unsigned char* Cs = F.lds; LAS unsigned char* Bm = F.lds + 34816;
    LAS unsigned char* XT = F.lds + 34816; LAS unsigned char* Hf = F.lds + 52224; LAS unsigned char* Hb = F.lds + 69632;
    LAS float* ACF = (LAS float*)(F.lds + 87040); LAS float* ACB = ACF + 1024; LAS float* DFA = ACF + 2048; LAS float* DBA = ACF + 3072;
    const int sj = F.tid >> 2, sps = (F.tid & 3) * 16, hp = F.tid >> 3, hn0 = (F.tid & 7) * 16;
    if (F.bid & 1) __builtin_amdgcn_s_sleep(75);
    for (int u = F.bid; u < 512; u += F.G) {
        const int grp = u & 3, sc = u >> 2, m0 = sc * 128;
        __syncthreads();
        { const int ns = (F.tid & 3) * 32; const bf16* bp = XC + (size_t)(m0 + sj) * XBCW + 2048 + grp * 128 + ns; const bf16* cp = bp + 512;
#pragma unroll
          for (int q = 0; q < 4; ++q) { *(LAS u32x4*)(Bm + sj * SS + (ns + 8 * q) * 2) = *(const u32x4*)(bp + 8 * q); *(LAS u32x4*)(Cs + sj * SS + (ns + 8 * q) * 2) = *(const u32x4*)(cp + 8 * q); } }
        { const int h = grp * 8 + w;
#pragma unroll
          for (int dir = 0; dir < 2; ++dir) { const float a = -__expf(F.in[16][dir * 32 + h]); int t0, t1; float d0, d1, c0, c1, tot;
              chunk_scan(WSP(float, dir ? WS_DTB : WS_DTF) + (size_t)m0 * 32 + h, a, dir == 1, F.lane, t0, t1, d0, d1, c0, c1, tot);
              LAS float* ca = (dir ? ACB : ACF) + w * 128; LAS float* da = (dir ? DBA : DFA) + w * 128; ca[t0] = c0; ca[t1] = c1; da[t0] = d0; da[t1] = d1; } }
        __syncthreads();
        bf16x8 cfr[4]; f32x4 G[8];
#pragma unroll
        for (int ks = 0; ks < 4; ++ks) cfr[ks] = *(const LAS bf16x8*)(Cs + (16 * w + fr) * SS + (32 * ks + 8 * g4) * 2);
#pragma unroll
        for (int n = 0; n < 8; ++n) { G[n] = (f32x4){0.f, 0.f, 0.f, 0.f};
#pragma unroll
            for (int ks = 0; ks < 4; ++ks) { const bf16x8 bf = *(const LAS bf16x8*)(Bm + (16 * n + fr) * SS + (32 * ks + 8 * g4) * 2); G[n] = __builtin_amdgcn_mfma_f32_16x16x32_bf16(bf, cfr[ks], G[n], 0, 0, 0); } }
        const int i = 16 * w + fr;
        float rowss = 0.f;
        u32x4 xr[2], hfr[2], hbr[2];
        { const int h = grp * 8; const bf16* xp = XC + (size_t)(m0 + sj) * XBCW + h * 64 + sps; xr[0] = *(const u32x4*)xp; xr[1] = *(const u32x4*)(xp + 8);
          const bf16* hf = HIN + ((size_t)(sc * 2 + 0) * 32 + h) * 8192 + hp * 128 + hn0; const bf16* hb = HIN + ((size_t)(sc * 2 + 1) * 32 + h) * 8192 + hp * 128 + hn0;
          hfr[0] = *(const u32x4*)hf; hfr[1] = *(const u32x4*)(hf + 8); hbr[0] = *(const u32x4*)hb; hbr[1] = *(const u32x4*)(hb + 8); }
        u32x2 zn[4];
#define P9_ZLD(hd) do { _Pragma("unroll") for (int pt = 0; pt < 4; ++pt) zn[pt] = *(const u32x2*)(P + (size_t)(m0 + i) * NINP + PZ + (grp * 8 + (hd)) * 64 + 16 * pt + 4 * g4); } while (0)
        P9_ZLD(0);
        __syncthreads();
        for (int hh = 0; hh < 8; ++hh) {
            const int h = grp * 8 + hh;
            {
#pragma unroll
              for (int q = 0; q < 2; ++q) { const unsigned vw[4] = {xr[q].x, xr[q].y, xr[q].z, xr[q].w};
#pragma unroll
                  for (int e = 0; e < 4; ++e) { *(LAS unsigned short*)(XT + (sps + 8 * q + 2 * e) * SS + sj * 2) = (unsigned short)(vw[e] & 0xffffu); *(LAS unsigned short*)(XT + (sps + 8 * q + 2 * e + 1) * SS + sj * 2) = (unsigned short)(vw[e] >> 16); } }
              *(LAS u32x4*)(Hf + hp * SS + hn0 * 2) = hfr[0]; *(LAS u32x4*)(Hf + hp * SS + hn0 * 2 + 16) = hfr[1];
              *(LAS u32x4*)(Hb + hp * SS + hn0 * 2) = hbr[0]; *(LAS u32x4*)(Hb + hp * SS + hn0 * 2 + 16) = hbr[1]; }
            __syncthreads();
            if (hh < 7) { const bf16* xp = XC + (size_t)(m0 + sj) * XBCW + (h + 1) * 64 + sps; xr[0] = *(const u32x4*)xp; xr[1] = *(const u32x4*)(xp + 8);
                const bf16* hf = HIN + ((size_t)(sc * 2 + 0) * 32 + h + 1) * 8192 + hp * 128 + hn0; const bf16* hb = HIN + ((size_t)(sc * 2 + 1) * 32 + h + 1) * 8192 + hp * 128 + hn0;
                hfr[0] = *(const u32x4*)hf; hfr[1] = *(const u32x4*)(hf + 8); hbr[0] = *(const u32x4*)hb; hbr[1] = *(const u32x4*)(hb + 8); }
            bf16x8 xq[2], hfq[2], hbq[2];
#define P9_LD(st_) do { const int pt_ = (st_) >> 2, s_ = (st_) & 3; \
                const u32x2 v0_ = *(const LAS u32x2*)(XT + (16 * pt_ + fr) * SS + (32 * s_ + 4 * g4) * 2), v1_ = *(const LAS u32x2*)(XT + (16 * pt_ + fr) * SS + (32 * s_ + 16 + 4 * g4) * 2); \
                xq[(st_) & 1] = __builtin_bit_cast(bf16x8, (u32x4){v0_.x, v0_.y, v1_.x, v1_.y}); \
                hfq[(st_) & 1] = *(const LAS bf16x8*)(Hf + (16 * pt_ + fr) * SS + (32 * s_ + 8 * g4) * 2); hbq[(st_) & 1] = *(const LAS bf16x8*)(Hb + (16 * pt_ + fr) * SS + (32 * s_ + 8 * g4) * 2); } while (0)
            u32x2 zv[4];
#pragma unroll
            for (int pt = 0; pt < 4; ++pt) zv[pt] = zn[pt];
            if (hh < 7) P9_ZLD(hh + 1);
            const LAS float* acf = ACF + hh * 128; const LAS float* acb = ACB + hh * 128; const LAS float* dfa = DFA + hh * 128; const LAS float* dba = DBA + hh * 128;
            const float aif = acf[i], aib = acb[i];
            bf16x8 pf[4];
#pragma unroll
            for (int s = 0; s < 4; ++s) { unsigned pw[4];
#pragma unroll
                for (int t = 0; t < 2; ++t) { const int n = 2 * s + t, j0 = 16 * n + 4 * g4;
                    float gw[4];
                    if (n < w) {
                        const f32x4 cf = *(const LAS f32x4*)(acf + j0), df = *(const LAS f32x4*)(dfa + j0);
#pragma unroll
                        for (int r = 0; r < 4; ++r) gw[r] = G[n][r] * (__expf(aif - cf[r]) * df[r]);
                    } else if (n > w) {
                        const f32x4 cb = *(const LAS f32x4*)(acb + j0), db = *(const LAS f32x4*)(dba + j0);
#pragma unroll
                        for (int r = 0; r < 4; ++r) gw[r] = G[n][r] * (__expf(aib - cb[r]) * db[r]);
                    } else {
                        const f32x4 cf = *(const LAS f32x4*)(acf + j0), cb = *(const LAS f32x4*)(acb + j0), df = *(const LAS f32x4*)(dfa + j0), db = *(const LAS f32x4*)(dba + j0);
#pragma unroll
                        for (int r = 0; r < 4; ++r) { const int j = j0 + r;
                            const float wf = (j <= i) ? __expf(aif - cf[r]) * df[r] : 0.f, wb = (j >= i) ? __expf(aib - cb[r]) * db[r] : 0.f;
                            gw[r] = G[n][r] * (wf + wb); }
                    }
                    pw[2 * t] = pk_bf16(gw[0], gw[1]); pw[2 * t + 1] = pk_bf16(gw[2], gw[3]); }
                pf[s] = __builtin_bit_cast(bf16x8, (u32x4){pw[0], pw[1], pw[2], pw[3]}); }
            const float ef = __expf(aif), eb = __expf(aib), dsk = F.in[18][h];
#pragma unroll
            for (int hf2 = 0; hf2 < 2; ++hf2) {
                f32x4 aY[2], aF[2], aB[2];
#pragma unroll
                for (int q = 0; q < 2; ++q) { aY[q] = (f32x4){0.f, 0.f, 0.f, 0.f}; aF[q] = aY[q]; aB[q] = aY[q]; }
                P9_LD(8 * hf2);
                __builtin_amdgcn_s_setprio(1);
#pragma unroll
                for (int st = 8 * hf2; st < 8 * hf2 + 8; ++st) {
                    if (st + 1 < 8 * hf2 + 8) P9_LD(st + 1);
                    __builtin_amdgcn_sched_barrier(0);
                    aY[(st >> 2) & 1] = __builtin_amdgcn_mfma_f32_16x16x32_bf16(xq[st & 1], pf[st & 3], aY[(st >> 2) & 1], 0, 0, 0);
                    aF[(st >> 2) & 1] = __builtin_amdgcn_mfma_f32_16x16x32_bf16(hfq[st & 1], cfr[st & 3], aF[(st >> 2) & 1], 0, 0, 0); aB[(st >> 2) & 1] = __builtin_amdgcn_mfma_f32_16x16x32_bf16(hbq[st & 1], cfr[st & 3], aB[(st >> 2) & 1], 0, 0, 0);
                    __builtin_amdgcn_sched_barrier(0);
                }
                __builtin_amdgcn_s_setprio(0);
#pragma unroll
                for (int q = 0; q < 2; ++q) { const int pt = 2 * hf2 + q, col = h * 64 + 16 * pt + 4 * g4;
                    const LAS unsigned char* xtp = XT + (16 * pt + 4 * g4) * SS + i * 2;
                    const float x4[4] = {__uint_as_float((unsigned)*(const LAS unsigned short*)xtp << 16), __uint_as_float((unsigned)*(const LAS unsigned short*)(xtp + SS) << 16),
                                         __uint_as_float((unsigned)*(const LAS unsigned short*)(xtp + 2 * SS) << 16), __uint_as_float((unsigned)*(const LAS unsigned short*)(xtp + 3 * SS) << 16)};
                    const float z4[4] = {bf_lo(zv[pt].x), bf_hi(zv[pt].x), bf_lo(zv[pt].y), bf_hi(zv[pt].y)};
                    float y4[4];
#pragma unroll
                    for (int r = 0; r < 4; ++r) { y4[r] = (aY[q][r] + ef * aF[q][r] + eb * aB[q][r] + dsk * x4[r]) * silu_f(z4[r]); rowss += y4[r] * y4[r]; }
                    u32x2 o; o.x = pk_bf16(y4[0], y4[1]); o.y = pk_bf16(y4[2], y4[3]); *(u32x2*)(YS + (size_t)(m0 + i) * DM + col) = o; }
            }
#undef P9_LD
#undef P9_ZLD
            __syncthreads();
        }
        rowss = row_sum(rowss);
        if (g4 == 0 && doatom) __hip_atomic_fetch_add(SSS + m0 + i, rowss, __ATOMIC_RELAXED, __HIP_MEMORY_SCOPE_AGENT);
    }
}
#ifndef MK_PER_PHASE
#define MK_PER_PHASE 0
#endif
constexpr int N_PHASES = 16;
#ifndef WGM_DOWN
#define WGM_DOWN 2
#endif
#ifndef PROBE_MASK
#define PROBE_MASK 0
#endif
#define REP(k) _Pragma("unroll") for (int _rep = 0; _rep < (((PROBE_MASK >> (k)) & 1) ? 2 : 1); ++_rep)
struct Args { const float* in[21]; float* out; unsigned char* ws; int ph_lo, ph_hi, li, pad; };
__global__ void __launch_bounds__(NTHR, 2) fwd(Args args) {
    extern __shared__ __attribute__((aligned(16))) unsigned char lds_raw[];
    Fr F;
    F.lds = (LAS unsigned char*)lds_raw;
    F.tid = threadIdx.x; F.lane = F.tid & 63; F.wave = __builtin_amdgcn_readfirstlane(F.tid >> 6);
    F.G = gridDim.x; F.bid = blockIdx.x;
#pragma unroll
    for (int i = 0; i < 21; ++i) F.in[i] = args.in[i];
    F.out = args.out; F.ws = args.ws;
    volatile LAS unsigned* MISC = (volatile LAS unsigned*)(F.lds + MISC_OFF);
    if (F.tid < 32) MISC[F.tid] = 0u;
    __syncthreads();
    unsigned* ctl = (unsigned*)(F.ws + WS_CTL);
    XcdBarrier bar = xcd_barrier_post(ctl + CW_BAR + args.li * XCD_BAR_WORDS, MISC + 8);
    const int lo = args.ph_lo, hi = args.ph_hi;
#define IN(k) (lo <= (k) && (k) < hi)
#define SEAM(k) do { if (IN(k) && IN((k) + 1)) xcd_barrier(bar); } while (0)
    LAS unsigned char* ring = F.lds;

    if (IN(0)) REP(0) { p0_prologue(F, _rep); } SEAM(0);
    if (IN(1)) REP(1) { p1_norm(F); } SEAM(1);
    if (IN(2)) REP(2) {
        pg8::Gemm g{WSP(bf16, WS_H), WSP(bf16, WS_WGU0), MROWS, NGU, DM}; pg8::HalfNOrder S; S.init(MROWS, F.G, F.bid);
        pg8::EpiSwiGLU E{WSP(bf16, WS_ACT), FF};
        pg8::gemm_phase<pg8::EpiSwiGLU, pg8::HalfNOrder, true, true>(ring, g, S, E);
        if (_rep == 0) conv_queue(F, CW_Q2, CV_Q2_LO, CV_Q2_HI);
    } SEAM(2);
    if (IN(3)) REP(3) {
        pg8::Gemm g{WSP(bf16, WS_ACT), WSP(bf16, WS_WD0), MROWS, DM, FF};
        { pg8::StaticOrder S; S.init(NLAT, DM, FF, F.G, F.bid, WGM_DOWN); pg8::EpiPlain E{WSP(bf16, WS_Y), DM};
          pg8::gemm_phase<pg8::EpiPlain, pg8::StaticOrder, true, true>(ring, g, S, E); }
        { pg8::CtxSplitOrder S; S.init(F.G, F.bid); pg8::EpiSplitF32 E{WSP(float, WS_YCP), DM};
          pg8::gemm_phase<pg8::EpiSplitF32, pg8::CtxSplitOrder, true, true>(ring, g, S, E); }
    } SEAM(3);
    if (IN(4)) REP(4) { p4_resnorm(F); } SEAM(4);
    if (IN(5)) REP(5) {
        pg8::Gemm g{WSP(bf16, WS_H), WSP(bf16, WS_WIN), MROWS, NINP, DM}; pg8::InProjOrder S; S.init(F.G, F.bid);
        pg8::EpiInProj E{WSP(bf16, WS_P), NINP, WSP(float, WS_DTF), WSP(float, WS_DTB), WSP(float, WS_ROPE), WSP(float, WS_ROPE) + 4096, F.in[17], QSCALE};
        pg8::gemm_phase<pg8::EpiInProj, pg8::InProjOrder, true, true>(ring, g, S, E);
        if (_rep == 0) conv_queue(F, CW_Q5, CV_Q5_LO, CV_Q5_HI);
    } SEAM(5);
    #ifndef PROBE_ATT
#define PROBE_ATT -1
#endif
    if (IN(6)) { p6_attn<0>(F, true); if (PROBE_ATT >= 0) { p6_attn<(PROBE_ATT < 0 ? 0 : PROBE_ATT)>(F, false); } p6_conv(F); } SEAM(6);
    if (IN(7)) REP(7) { p7_states(F); } SEAM(7);
    if (IN(8)) REP(8) { p8_scan(F); } SEAM(8);
    if (IN(9)) REP(9) { p9_ssd_out(F, _rep == 0); } SEAM(9);
    if (IN(11)) REP(11) {
        pg8::Gemm g{WSP(bf16, WS_H), WSP(bf16, WS_WOUT), NLAT, DM, DM}; pg8::OutProjOrder S; S.init(F.G, F.bid);
        LAS float* qt = (LAS float*)(F.lds + RING_BYTES + 1024);
        { const float* ssa = WSP(float, WS_ROWSS); const float* sss = ssa + NLAT;
          for (int e = F.tid; e < 1024; e += NTHR) { pg8::Unit u; if (S.t.next(e >> 8, u)) { const int r = u.pm * 256 + (e & 255);
              qt[e] = sqrtf((sss[r] * (1.0f / 2048.f) + EPS) / (ssa[r] * (1.0f / 2048.f) + EPS)); } }
          __syncthreads(); }
        pg8::EpiOutProj E{WSP(bf16, WS_Y), DM, qt};
        pg8::gemm_phase<pg8::EpiOutProj, pg8::OutProjOrder, true, true, false, true>(ring, g, S, E);
#ifdef PROBE_ZEROB
        xcd_barrier(bar);
        { bf16* zb = WSP(bf16, WS_HIN);
          if (PROBE_ZEROB) { for (size_t e = (size_t)F.bid * NTHR + F.tid; e < (size_t)DM * DM / 8; e += (size_t)F.G * NTHR) ((u32x4*)zb)[e] = (u32x4){0u, 0u, 0u, 0u}; }
          xcd_barrier(bar);
          pg8::Gemm g2{WSP(bf16, WS_H), PROBE_ZEROB ? zb : WSP(bf16, WS_WOUT), NLAT, DM, DM}; pg8::StaticOrder S2; S2.init(NLAT, DM, DM, F.G, F.bid);
          pg8::EpiPlain E2{WSP(bf16, WS_SLOC), DM};
          pg8::gemm_phase<pg8::EpiPlain, pg8::StaticOrder, true, true>(ring, g2, S2, E2); }
#endif
    } SEAM(11);
    if (IN(12)) REP(12) { p12_resnorm(F); } SEAM(12);
    if (IN(13)) REP(13) {
        pg8::Gemm g{WSP(bf16, WS_H), WSP(bf16, WS_WGU1), NLAT, NGU, DM}; pg8::HalfNOrder S; S.init(NLAT, F.G, F.bid);
        pg8::EpiSwiGLU8 E{WSP(unsigned char, WS_ACT), FF};
        pg8::gemm_phase<pg8::EpiSwiGLU8, pg8::HalfNOrder, true, true>(ring, g, S, E);
        if (_rep == 0) conv_queue(F, CW_Q13, CV_Q13_LO, CV_Q13_HI);
    } SEAM(13);
    if (IN(14)) REP(14) {
        pg8::Gemm g{WSP(bf16, WS_ACT), WSP(bf16, WS_WD1), NLAT, DM, FF / 2}; pg8::StaticOrder S; S.init(NLAT, DM, FF / 2, F.G, F.bid, WGM_DOWN);
        pg8::EpiPlainS E{WSP(bf16, WS_Y), DM, 1.0f / (8.0f * 2048.0f)};
        pg8::gemm_phase<pg8::EpiPlainS, pg8::StaticOrder, true, true, true>(ring, g, S, E);
    } SEAM(14);
    if (IN(15)) REP(15) { p15_final(F); }
#undef IN
#undef SEAM
}

extern "C" void kernel_launch(void* const* d_in, const int* in_sizes, int n_in, void* d_out, int out_size, void* d_ws, size_t ws_size, hipStream_t stream) {
    static int grid = 0;
    if (grid == 0) {
        if (n_in != 21 || in_sizes[0] != NLAT * DM || out_size != NLAT * DM || ws_size < WS_END) {
            fprintf(stderr, "kernel_launch: unexpected problem (n_in %d, in0 %d, out %d, ws %zu, need %zu)\n", n_in, n_in > 0 ? in_sizes[0] : -1, out_size, ws_size, (size_t)WS_END); grid = -1; return; }
        int dev = 0, cus = 0, per_cu = 0;
        if (hipGetDevice(&dev) != hipSuccess || hipDeviceGetAttribute(&cus, hipDeviceAttributeMultiprocessorCount, dev) != hipSuccess) { grid = -1; return; }
        if (hipFuncSetAttribute((const void*)fwd, hipFuncAttributeMaxDynamicSharedMemorySize, LDS_BYTES) != hipSuccess) { fprintf(stderr, "kernel_launch: hipFuncSetAttribute failed\n"); grid = -1; return; }
        if (hipOccupancyMaxActiveBlocksPerMultiprocessor(&per_cu, (const void*)fwd, NTHR, LDS_BYTES) != hipSuccess || per_cu < 1)
            fprintf(stderr, "kernel_launch: note: occupancy query reports %d workgroups per CU\n", per_cu);
        (void)hipGetLastError();
        grid = cus;
    }
    if (grid < 0) return;
    if (hipMemsetAsync((char*)d_ws + WS_CTL, 0, ZERO_BYTES, stream) != hipSuccess) { fprintf(stderr, "kernel_launch: memset failed\n"); return; }
    Args a{};
    for (int i = 0; i < 21; ++i) a.in[i] = (const float*)d_in[i];
    a.out = (float*)d_out; a.ws = (unsigned char*)d_ws; a.pad = 0;
#if MK_PER_PHASE
    for (int ph = 0; ph < N_PHASES; ++ph) { a.ph_lo = ph; a.ph_hi = ph + 1; a.li = ph;
        hipLaunchKernelGGL(fwd, dim3(grid), dim3(NTHR), LDS_BYTES, stream, a); }
#else
    a.ph_lo = 0; a.ph_hi = N_PHASES; a.li = 0;
    hipLaunchKernelGGL(fwd, dim3(grid), dim3(NTHR), LDS_BYTES, stream, a);
#endif
    const hipError_t le = hipPeekAtLastError();
    if (le != hipSuccess) fprintf(stderr, "kernel_launch: launch failed: %s\n", hipGetErrorName(le));
}
```

```cpp
#define MK_PER_PHASE 0
#define PROBE_MASK 0
#define PROBE_P0T 1
#include <hip/hip_runtime.h>
#include <cstdio>
#include <cstdint>
namespace pg8 {
#define PG8_LAS __attribute__((address_space(3)))
typedef unsigned short bf16_t;
typedef short bf16x8 __attribute__((ext_vector_type(8)));
typedef float f32x4 __attribute__((ext_vector_type(4)));
typedef unsigned u32x4 __attribute__((ext_vector_type(4)));
constexpr int BM = 256, BK = 64, HALF = 128, HTB = HALF * BK * 2  , STAGE_BYTES = 8 * HTB, NXCD = 8, WGM = 4;

__host__ __device__ __forceinline__ int lds_byte(int r, int c) { const int st = (r >> 4) * 2 + (c >> 5), rr = r & 15, cc = c & 31, ob = rr * 64 + cc * 2; return st * 1024 + (ob ^ (((ob >> 9) & 1) << 5)); }
__host__ __device__ __forceinline__ void stage_rc(int b, int& R, int& C) { const int st = b / 1024, sb = b % 1024, swz = sb ^ (((sb >> 9) & 1) << 5); R = (st >> 1) * 16 + swz / 64; C = (st & 1) * 32 + (swz % 64) / 2; }
__host__ __device__ __forceinline__ int perm32(int rho) { const int n = rho >> 4, i = rho & 15; return 8 * (i >> 2) + 4 * n + (i & 3); }

struct Unit { int pm, pn, koff, nt, aux; };
struct Gemm { const bf16_t* A; const bf16_t* Bt; int M, N, K; };

struct StaticOrder {
    int nM, nN, nwg, G, c, nt, wgm;
    __host__ __device__ void init(int M, int N, int K, int G_, int c_, int wgm_ = WGM) { nM = M / BM; nN = N / BM; nwg = nM * nN; G = G_; c = c_; nt = K / BK; wgm = wgm_; }
    __host__ __device__ __forceinline__ bool next(int i, Unit& u) const {
        const long L = (long)i * G + c; if (L >= nwg) return false;
        int wgid = (int)L; { const int q = nwg / NXCD, r = nwg % NXCD, xcd = wgid % NXCD, off = wgid / NXCD; wgid = (xcd < r ? xcd * (q + 1) : r * (q + 1) + (xcd - r) * q) + off; }
        const int nig = wgm * nN, gid = wgid / nig, fm = gid * wgm, gsz = (nM - fm) < wgm ? (nM - fm) : wgm;
        u.pm = fm + ((wgid % nig) % gsz); u.pn = (wgid % nig) / gsz; u.koff = 0; u.nt = nt; u.aux = 0; return true;
    }
    __device__ __forceinline__ void a_ready(const Unit&) const {}
    __device__ __forceinline__ void done(const Unit&) const {}
};

__device__ __forceinline__ unsigned cvt_pk_bf16(float lo, float hi) { unsigned r; asm volatile("v_cvt_pk_bf16_f32 %0, %1, %2" : "=v"(r) : "v"(lo), "v"(hi)); return r; }
typedef float f32x2_t __attribute__((ext_vector_type(2))); typedef __bf16 bf16x2_t __attribute__((ext_vector_type(2)));
__device__ __forceinline__ unsigned pk_bf16(float lo, float hi) { const f32x2_t v = {lo, hi}; const bf16x2_t b = __builtin_convertvector(v, bf16x2_t); return __builtin_bit_cast(unsigned, b); }
#ifndef AQ_DROP
#define AQ_DROP 2
#endif
__device__ __forceinline__ float aquant(float v) {
    if (AQ_DROP == 0) return v;
    unsigned u = __builtin_bit_cast(unsigned, v); constexpr unsigned sh = 16 + AQ_DROP, half = (1u << (sh - 1)) - 1u;
    u = (u + half + ((u >> sh) & 1u)) & ~((1u << sh) - 1u); return __builtin_bit_cast(float, u);
}
__device__ __forceinline__ unsigned pk_bf16q(float lo, float hi) {
    if (AQ_DROP == 0) return pk_bf16(lo, hi);
    {
#pragma clang fp contract(off)
        const f32x2_t v = {lo, hi}; constexpr float K = (float)((1u << (16 + AQ_DROP)) + 1u);
        const f32x2_t c = v * K; const f32x2_t d = c - v; const f32x2_t h = c - d;
        return __builtin_bit_cast(unsigned, __builtin_convertvector(h, bf16x2_t));
    }
}
typedef _Float16 f16x2_t __attribute__((ext_vector_type(2)));
__device__ __forceinline__ unsigned pk_f16(float lo, float hi) { const f32x2_t v = {lo, hi}; return __builtin_bit_cast(unsigned, __builtin_convertvector(v, f16x2_t)); }
__device__ __forceinline__ float silu_f(float g) { return g * __builtin_amdgcn_rcpf(1.0f + __builtin_amdgcn_exp2f(-1.4426950408889634f * g)); }
template <bool S8>
__device__ __forceinline__ f32x2_t swiglu2(f32x2_t g, f32x2_t u) {
    const f32x2_t t = g * -1.4426950408889634f;
    const f32x2_t e = {__builtin_amdgcn_exp2f(t.x), __builtin_amdgcn_exp2f(t.y)};
    const f32x2_t d = S8 ? e * 0.125f + 0.125f : e + 1.0f;
    const f32x2_t r = {__builtin_amdgcn_rcpf(d.x), __builtin_amdgcn_rcpf(d.y)};
    return (g * u) * r;
}
__device__ __forceinline__ float softplus_f(float x) { return x > 20.f ? x : log1pf(__expf(x)); }

struct EpiPlain {
    static constexpr bool PERM = true, AFTER_DRAIN = false;
    bf16_t* O; int ldc;
    __device__ __forceinline__ void operator()(const f32x4 (&acc)[2][2][4][2], const Unit& u, int wr, int wc, int fr, int fq) const {
        const int row0 = u.pm * BM + wr * 64 + fr, col0 = u.pn * BM + wc * 32 + 8 * fq;
#pragma unroll
        for (int ai = 0; ai < 2; ++ai)
#pragma unroll
            for (int m = 0; m < 4; ++m) { bf16_t* rowp = O + (size_t)(row0 + ai * HALF + m * 16) * ldc + col0;
#pragma unroll
                for (int bj = 0; bj < 2; ++bj) { const f32x4 v0 = acc[ai][bj][m][0], v1 = acc[ai][bj][m][1];
                    u32x4 w; w.x = pk_f16(v0[0], v0[1]); w.y = pk_f16(v0[2], v0[3]); w.z = pk_f16(v1[0], v1[1]); w.w = pk_f16(v1[2], v1[3]);
                    *(u32x4*)(rowp + bj * HALF) = w; } }
    }
};
struct EpiSwiGLU {
    static constexpr bool PERM = true, AFTER_DRAIN = false;
    bf16_t* O; int ldc;
    __device__ __forceinline__ void operator()(const f32x4 (&acc)[2][2][4][2], const Unit& u, int wr, int wc, int fr, int fq) const {
        const int row0 = u.pm * BM + wr * 64 + fr, col0 = u.pn * HALF + wc * 32 + 8 * fq;
#pragma unroll
        for (int ai = 0; ai < 2; ++ai)
#pragma unroll
            for (int m = 0; m < 4; ++m) { bf16_t* rowp = O + (size_t)(row0 + ai * HALF + m * 16) * ldc + col0;
                const f32x4 g0 = acc[ai][0][m][0], g1 = acc[ai][0][m][1], u0 = acc[ai][1][m][0], u1 = acc[ai][1][m][1];
                u32x4 w;
                { const f32x2_t a = swiglu2<false>((f32x2_t){g0[0], g0[1]}, (f32x2_t){u0[0], u0[1]}), b = swiglu2<false>((f32x2_t){g0[2], g0[3]}, (f32x2_t){u0[2], u0[3]}),
                                c = swiglu2<false>((f32x2_t){g1[0], g1[1]}, (f32x2_t){u1[0], u1[1]}), d = swiglu2<false>((f32x2_t){g1[2], g1[3]}, (f32x2_t){u1[2], u1[3]});
                  w.x = pk_bf16q(a.x, a.y); w.y = pk_bf16q(b.x, b.y); w.z = pk_bf16q(c.x, c.y); w.w = pk_bf16q(d.x, d.y); }
                __builtin_nontemporal_store(w, (u32x4*)rowp); }
    }
};
struct EpiInProj {
    static constexpr bool PERM = true, AFTER_DRAIN = false;
    bf16_t* P; int ldc; float* dtf; float* dtb; const float* rcos; const float* rsin; const float* dt_bias; float qscale;
    __device__ __forceinline__ void operator()(const f32x4 (&acc)[2][2][4][2], const Unit& u, int wr, int wc, int fr, int fq) const {
        const int row0 = u.pm * BM + wr * 64 + fr;
        if (u.pn == 32) {
            if (wc < 2) {
                float* dst = (wc == 0) ? dtf : dtb; const float* bp = dt_bias + wc * 32 + 8 * fq;
                const f32x4 b0 = *(const f32x4*)bp, b1 = *(const f32x4*)(bp + 4);
#pragma unroll
                for (int ai = 0; ai < 2; ++ai)
#pragma unroll
                    for (int m = 0; m < 4; ++m) { float* rowp = dst + (size_t)(row0 + ai * HALF + m * 16) * 32 + 8 * fq;
                        f32x4 v0 = acc[ai][0][m][0] + b0, v1 = acc[ai][0][m][1] + b1;
#pragma unroll
                        for (int j = 0; j < 4; ++j) { v0[j] = softplus_f(v0[j]); v1[j] = softplus_f(v1[j]); }
                        *(f32x4*)rowp = v0; *(f32x4*)(rowp + 4) = v1; }
            }
            return;
        }
        const int col0 = u.pn * BM + wc * 32 + 8 * fq;
        const bool rope = (u.pn < 8) || (u.pn == 16) || (u.pn == 17);
        if (!rope) {
#pragma unroll
            for (int ai = 0; ai < 2; ++ai)
#pragma unroll
                for (int m = 0; m < 4; ++m) { bf16_t* rowp = P + (size_t)(row0 + ai * HALF + m * 16) * ldc + col0;
#pragma unroll
                    for (int bj = 0; bj < 2; ++bj) { const f32x4 v0 = acc[ai][bj][m][0], v1 = acc[ai][bj][m][1];
                        u32x4 w; w.x = pk_bf16(v0[0], v0[1]); w.y = pk_bf16(v0[2], v0[3]); w.z = pk_bf16(v1[0], v1[1]); w.w = pk_bf16(v1[2], v1[3]);
                        *(u32x4*)(rowp + bj * HALF) = w; } }
        } else {
            const float sc = (u.pn < 8) ? qscale : 1.0f;
            const bool lat = u.pm < 64;
            const int axis = wc >> 1, ioff = 16 * (wc & 1) + 4 * fq;
#pragma unroll
            for (int ai = 0; ai < 2; ++ai)
#pragma unroll
                for (int m = 0; m < 4; ++m) { const int row = row0 + ai * HALF + m * 16; bf16_t* rowp = P + (size_t)row * ldc + col0;
                    f32x4 cs = (f32x4){1.f, 1.f, 1.f, 1.f}, sn = (f32x4){0.f, 0.f, 0.f, 0.f};
                    if (lat) { const int t = row & 8191, pos = axis ? (t & 63) : (t >> 6); cs = *(const f32x4*)(rcos + pos * 32 + ioff); sn = *(const f32x4*)(rsin + pos * 32 + ioff); }
#pragma unroll
                    for (int bj = 0; bj < 2; ++bj) { const f32x4 x1 = acc[ai][bj][m][0], x2 = acc[ai][bj][m][1];
                        const f32x4 o1 = (x1 * cs - x2 * sn) * sc, o2 = (x2 * cs + x1 * sn) * sc;
                        u32x4 w; w.x = pk_bf16(o1[0], o1[1]); w.y = pk_bf16(o1[2], o1[3]); w.z = pk_bf16(o2[0], o2[1]); w.w = pk_bf16(o2[2], o2[3]);
                        *(u32x4*)(rowp + bj * HALF) = w; } }
        }
    }
};
struct InProjOrder {
    StaticOrder lat; int G, c;
    __host__ __device__ void init(int G_, int c_) { lat.init(16384, 8448, 4096, G_, c_); G = G_; c = c_; }
    __host__ __device__ __forceinline__ bool next(int i, Unit& u) const {
        const long L = (long)i * G + c;
        if (L < lat.nwg) return lat.next(i, u);
        const int k = (int)(L - lat.nwg); if (k >= 34) return false;
        u.pm = 64 + (k & 1); u.pn = 16 + (k >> 1); u.koff = 0; u.nt = lat.nt; u.aux = 0; return true;
    }
    __device__ __forceinline__ void a_ready(const Unit&) const {}
    __device__ __forceinline__ void done(const Unit&) const {}
};


struct CtxSplitOrder {
    int G, c;
    __host__ __device__ void init(int G_, int c_) { G = G_; c = c_; }
    __host__ __device__ __forceinline__ bool next(int i, Unit& u) const {
        const long L = (long)i * G + c; if (L >= 256) return false;
        const int k = (int)L, s = k >> 5;
        u.pm = 64 + (k & 1); u.pn = (k >> 1) & 15; u.aux = s; u.nt = (s < 6) ? 22 : 20; u.koff = 64 * ((s < 6) ? 22 * s : 132 + 20 * (s - 6)); return true;
    }
    __device__ __forceinline__ void a_ready(const Unit&) const {}
    __device__ __forceinline__ void done(const Unit&) const {}
};
struct EpiSplitF32 {
    static constexpr bool PERM = true, AFTER_DRAIN = false;
    float* YP; int ldc;
    __device__ __forceinline__ void operator()(const f32x4 (&acc)[2][2][4][2], const Unit& u, int wr, int wc, int fr, int fq) const {
        float* base = YP + (size_t)u.aux * 512 * ldc + (size_t)((u.pm - 64) * BM + wr * 64 + fr) * ldc + u.pn * BM + wc * 32 + 8 * fq;
#pragma unroll
        for (int ai = 0; ai < 2; ++ai)
#pragma unroll
            for (int m = 0; m < 4; ++m) { float* rowp = base + (size_t)(ai * HALF + m * 16) * ldc;
#pragma unroll
                for (int bj = 0; bj < 2; ++bj) { *(f32x4*)(rowp + bj * HALF) = acc[ai][bj][m][0]; *(f32x4*)(rowp + bj * HALF + 4) = acc[ai][bj][m][1]; } }
    }
};

__device__ __forceinline__ float clamp448(float v) { return __builtin_amdgcn_fmed3f(v, -448.f, 448.f); }
__device__ __forceinline__ unsigned pk4_fp8(float a, float b, float c, float d) { int p = __builtin_amdgcn_cvt_pk_fp8_f32(clamp448(a), clamp448(b), 0, false); p = __builtin_amdgcn_cvt_pk_fp8_f32(clamp448(c), clamp448(d), p, true); return (unsigned)p; }
struct EpiSwiGLU8 {
    static constexpr bool PERM = true, AFTER_DRAIN = false;
    unsigned char* O; int ldc;
    __device__ __forceinline__ void operator()(const f32x4 (&acc)[2][2][4][2], const Unit& u, int wr, int wc, int fr, int fq) const {
        const int row0 = u.pm * BM + wr * 64 + fr, col0 = u.pn * HALF + wc * 32 + 8 * fq;
#pragma unroll
        for (int ai = 0; ai < 2; ++ai)
#pragma unroll
            for (int m = 0; m < 4; ++m) { unsigned char* rowp = O + (size_t)(row0 + ai * HALF + m * 16) * ldc + col0;
                const f32x4 g0 = acc[ai][0][m][0], g1 = acc[ai][0][m][1], u0 = acc[ai][1][m][0], u1 = acc[ai][1][m][1];
                const f32x2_t a = swiglu2<true>((f32x2_t){g0[0], g0[1]}, (f32x2_t){u0[0], u0[1]}), b = swiglu2<true>((f32x2_t){g0[2], g0[3]}, (f32x2_t){u0[2], u0[3]}),
                              c = swiglu2<true>((f32x2_t){g1[0], g1[1]}, (f32x2_t){u1[0], u1[1]}), d = swiglu2<true>((f32x2_t){g1[2], g1[3]}, (f32x2_t){u1[2], u1[3]});
                typedef unsigned u32x2_t __attribute__((ext_vector_type(2)));
                u32x2_t w; w.x = pk4_fp8(a.x, a.y, b.x, b.y); w.y = pk4_fp8(c.x, c.y, d.x, d.y);
                *(u32x2_t*)rowp = w; }
    }
};
struct EpiPlainS {
    static constexpr bool PERM = true, AFTER_DRAIN = false;
    bf16_t* O; int ldc; float scale;
    __device__ __forceinline__ void operator()(const f32x4 (&acc)[2][2][4][2], const Unit& u, int wr, int wc, int fr, int fq) const {
        const int row0 = u.pm * BM + wr * 64 + fr, col0 = u.pn * BM + wc * 32 + 8 * fq;
#pragma unroll
        for (int ai = 0; ai < 2; ++ai)
#pragma unroll
            for (int m = 0; m < 4; ++m) { bf16_t* rowp = O + (size_t)(row0 + ai * HALF + m * 16) * ldc + col0;
#pragma unroll
                for (int bj = 0; bj < 2; ++bj) { const f32x4 v0 = acc[ai][bj][m][0] * scale, v1 = acc[ai][bj][m][1] * scale;
                    u32x4 w; w.x = pk_f16(v0[0], v0[1]); w.y = pk_f16(v0[2], v0[3]); w.z = pk_f16(v1[0], v1[1]); w.w = pk_f16(v1[2], v1[3]);
                    *(u32x4*)(rowp + bj * HALF) = w; } }
    }
};

struct EpiOutProj {
    static constexpr bool PERM = true, AFTER_DRAIN = false;
    bf16_t* O; int ldc; const PG8_LAS float* qt;
    __device__ __forceinline__ float keep_factor(const Unit& u, int ai, int m, int wr, int fr) const {
        const float s = qt[(u.aux & 3) * 256 + ai * HALF + wr * 64 + m * 16 + fr]; return (u.aux & 0x100) ? s : 0.0f;
    }
    __device__ __forceinline__ void operator()(const f32x4 (&acc_)[2][2][4][2], const Unit& u, int wr, int wc, int fr, int fq) const {
        if (u.aux & 0x100) return;
        const int row0 = u.pm * BM + wr * 64 + fr, col0 = u.pn * BM + wc * 32 + 8 * fq;
#pragma unroll
        for (int ai = 0; ai < 2; ++ai)
#pragma unroll
            for (int m = 0; m < 4; ++m) { bf16_t* rowp = O + (size_t)(row0 + ai * HALF + m * 16) * ldc + col0;
#pragma unroll
                for (int bj = 0; bj < 2; ++bj) { const f32x4 v0 = acc_[ai][bj][m][0], v1 = acc_[ai][bj][m][1];
                    u32x4 w; w.x = pk_f16(v0[0], v0[1]); w.y = pk_f16(v0[2], v0[3]); w.z = pk_f16(v1[0], v1[1]); w.w = pk_f16(v1[2], v1[3]);
                    *(u32x4*)(rowp + bj * HALF) = w; } }
    }
};
struct OutProjOrder {
    StaticOrder t;
    __host__ __device__ void init(int G_, int c_) { t.init(16384, 4096, 4096, G_, c_); }
    __host__ __device__ __forceinline__ bool next(int i, Unit& u) const {
        if (!t.next(i >> 1, u)) return false;
        u.nt = 32; u.koff = (i & 1) * 2048; u.aux = (i & 1) ? 0 : (0x100 | ((i >> 1) & 3)); return true;
    }
    __device__ __forceinline__ void a_ready(const Unit&) const {}
    __device__ __forceinline__ void done(const Unit&) const {}
};

struct HalfNOrder {
    StaticOrder h; int G, c, nh;
    __host__ __device__ void init(int M, int G_, int c_) { h.init(M, 43 * 256, 4096, G_, c_); G = G_; c = c_; nh = h.nwg; }
    __host__ __device__ __forceinline__ bool next(int i, Unit& u) const {
        const long L = (long)i * G + c; if (L >= 2L * nh) return false;
        const int half = L >= nh, l = (int)(L - (half ? nh : 0));
        StaticOrder t = h; t.c = l % G; if (!t.next(l / G, u)) return false;
        u.pn += 43 * half; return true;
    }
    __device__ __forceinline__ void a_ready(const Unit&) const {}
    __device__ __forceinline__ void done(const Unit&) const {}
};
typedef int v8i_t __attribute__((ext_vector_type(8))); typedef int v4i_t __attribute__((ext_vector_type(4)));
__device__ __forceinline__ v8i_t cat8(bf16x8 a, bf16x8 b) { return __builtin_shufflevector(__builtin_bit_cast(v4i_t, a), __builtin_bit_cast(v4i_t, b), 0, 1, 2, 3, 4, 5, 6, 7); }
template <class Epi, class Sched, bool ALIGN_EPI = false, bool SP2 = false, bool FP8 = false, bool KEEP = false>
__device__ __forceinline__ void gemm_phase(PG8_LAS unsigned char* lds, const Gemm g, const Sched& S, const Epi& E) {
    const int tid = threadIdx.x, wid = __builtin_amdgcn_readfirstlane(tid >> 6), lane = tid & 63, wr = wid >> 2, wc = wid & 3, fr = lane & 15, fq = lane >> 4;
    const int K = g.K;
    unsigned voffA[2], voffB[2];
#pragma unroll
    for (int i = 0; i < 2; ++i) { int R, C; stage_rc(tid * 16 + i * 8192, R, C); const int Rb = Epi::PERM ? ((R & ~31) + perm32(R & 31)) : R;
        voffA[i] = (unsigned)(R * K + C) * 2u; voffB[i] = (unsigned)(Rb * K + C) * 2u; }
    const size_t kstep = (size_t)(BK * 2);
    const size_t hstep = (size_t)HALF * K * 2;
    const size_t tstep = 2 * hstep;
    const unsigned ldsw = (unsigned)wid * 1024u;
    const int aoff = lds_byte(wr * 64 + fr, fq * 8), boff = lds_byte(wc * 32 + fr, fq * 8);
#define PG8_SA(b, h) (((b) * 2 + (h)) * HTB)
#define PG8_SB(b, h) ((4 + (b) * 2 + (h)) * HTB)
#define PG8_STAGE(bufoff, gbase, voff) do { _Pragma("unroll") for (int _i = 0; _i < 2; ++_i) \
        __builtin_amdgcn_global_load_lds((const unsigned*)((const char*)(gbase) + (voff)[_i]), (PG8_LAS unsigned*)(lds + (bufoff) + ldsw + _i * 8192), 16, 0, 0); } while (0)
#define PG8_LDA(dst, b, h) do { _Pragma("unroll") for (int m = 0; m < 4; ++m) { if constexpr (FP8) dst##8[m] = cat8(*(const PG8_LAS bf16x8*)(lds + PG8_SA(b, h) + aoff + m * 2048), *(const PG8_LAS bf16x8*)(lds + PG8_SA(b, h) + aoff + m * 2048 + 1024)); \
        else { _Pragma("unroll") for (int k = 0; k < 2; ++k) dst[m][k] = *(const PG8_LAS bf16x8*)(lds + PG8_SA(b, h) + aoff + m * 2048 + k * 1024); } } } while (0)
#define PG8_LDB(dst, b, h) do { _Pragma("unroll") for (int n = 0; n < 2; ++n) { if constexpr (FP8) dst##8[n] = cat8(*(const PG8_LAS bf16x8*)(lds + PG8_SB(b, h) + boff + n * 2048), *(const PG8_LAS bf16x8*)(lds + PG8_SB(b, h) + boff + n * 2048 + 1024)); \
        else { _Pragma("unroll") for (int k = 0; k < 2; ++k) dst[n][k] = *(const PG8_LAS bf16x8*)(lds + PG8_SB(b, h) + boff + n * 2048 + k * 1024); } } } while (0)
#ifndef PG8_BSTAT
#define PG8_BSTAT 0
#endif
#define PG8_MMA(ai, bj, At, Bt) do { __builtin_amdgcn_s_setprio(1); \
        if constexpr (FP8) { _Pragma("unroll") for (int m = 0; m < 4; ++m) _Pragma("unroll") for (int n = 0; n < 2; ++n) asm volatile("v_mfma_f32_16x16x128_f8f6f4 %0, %1, %2, %0" : "+v"(acc[ai][bj][m][n]) : "v"(Bt##8[n]), "v"(At##8[m])); } \
        else if (PG8_BSTAT) { _Pragma("unroll") for (int k = 0; k < 2; ++k) _Pragma("unroll") for (int n = 0; n < 2; ++n) _Pragma("unroll") for (int m = 0; m < 4; ++m) acc[ai][bj][m][n] = __builtin_amdgcn_mfma_f32_16x16x32_bf16(Bt[n][k], At[m][k], acc[ai][bj][m][n], 0, 0, 0); } \
        else { _Pragma("unroll") for (int m = 0; m < 4; ++m) _Pragma("unroll") for (int n = 0; n < 2; ++n) _Pragma("unroll") for (int k = 0; k < 2; ++k) acc[ai][bj][m][n] = __builtin_amdgcn_mfma_f32_16x16x32_bf16(Bt[n][k], At[m][k], acc[ai][bj][m][n], 0, 0, 0); } \
        if constexpr (FP8) asm volatile("s_nop 3");     \
        __builtin_amdgcn_s_setprio(0); } while (0)
#define PG8_WAIT_V(n) asm volatile("s_waitcnt vmcnt(" #n ")" ::: "memory")
#define PG8_WAIT_L(n) asm volatile("s_waitcnt lgkmcnt(" #n ")" ::: "memory")
#define PG8_BAR __builtin_amdgcn_s_barrier()
#define PG8_SCHED __builtin_amdgcn_sched_barrier(0)
    Unit cur, nxt; int ui = 0;
    if (!S.next(0, cur)) return;
    f32x4 acc[2][2][4][2];
#pragma unroll
    for (int a = 0; a < 2; ++a)
#pragma unroll
        for (int b = 0; b < 2; ++b)
#pragma unroll
            for (int m = 0; m < 4; ++m)
#pragma unroll
                for (int n = 0; n < 2; ++n) acc[a][b][m][n] = (f32x4){0.f, 0.f, 0.f, 0.f};
    bf16x8 At[4][2], B0[2][2], B1[2][2]; v8i_t At8[4], B08[2], B18[2];
    const char* cA = (const char*)g.A + (size_t)cur.pm * tstep + (size_t)cur.koff * 2; const char* cB = (const char*)g.Bt + (size_t)cur.pn * tstep + (size_t)cur.koff * 2;
    S.a_ready(cur);
    if constexpr (SP2) {
        PG8_STAGE(PG8_SB(0, 0), cB, voffB); PG8_STAGE(PG8_SB(0, 1), cB + hstep, voffB); PG8_STAGE(PG8_SA(0, 0), cA, voffA); PG8_STAGE(PG8_SA(0, 1), cA + hstep, voffA);
        if (wr == 1) PG8_BAR;
        PG8_WAIT_V(2); PG8_BAR;
        PG8_STAGE(PG8_SB(1, 0), cB + kstep, voffB); PG8_STAGE(PG8_SA(1, 0), cA + kstep, voffA); PG8_STAGE(PG8_SB(1, 1), cB + hstep + kstep, voffB);
        PG8_WAIT_V(6); PG8_BAR;
    } else {
        PG8_STAGE(PG8_SB(0, 0), cB, voffB); PG8_STAGE(PG8_SA(0, 0), cA, voffA); PG8_STAGE(PG8_SB(0, 1), cB + hstep, voffB); PG8_STAGE(PG8_SA(0, 1), cA + hstep, voffA);
        if (wr == 1) PG8_BAR;
        PG8_WAIT_V(4); PG8_BAR;
        PG8_STAGE(PG8_SB(1, 0), cB + kstep, voffB); PG8_STAGE(PG8_SA(1, 0), cA + kstep, voffA); PG8_STAGE(PG8_SB(1, 1), cB + hstep + kstep, voffB);
        PG8_WAIT_V(6); PG8_BAR;
    }
    for (;;) {
        const bool has_next = S.next(ui + 1, nxt);
        const char* nA = has_next ? (const char*)g.A + (size_t)nxt.pm * tstep + (size_t)nxt.koff * 2 : cA; const char* nB = has_next ? (const char*)g.Bt + (size_t)nxt.pn * tstep + (size_t)nxt.koff * 2 : cB;
        const int nt = cur.nt;
        for (int t = 0; t < nt; t += 2) {
            const bool last = (t == nt - 2);
            const char* a1 = cA + (size_t)(t + 1) * kstep;
            const char* a2 = last ? nA : cA + (size_t)(t + 2) * kstep; const char* b2 = last ? nB : cB + (size_t)(t + 2) * kstep;
            const char* a3 = a2 + kstep; const char* b3 = b2 + kstep;
            if (last && has_next) S.a_ready(nxt);
            if constexpr (SP2) {
            PG8_LDB(B0, 0, 0); PG8_LDB(B1, 0, 1); PG8_SCHED; PG8_LDA(At, 0, 0); PG8_STAGE(PG8_SA(1, 1), a1 + hstep, voffA);
            PG8_WAIT_V(8); PG8_WAIT_L(0); PG8_BAR; PG8_MMA(0, 0, At, B0); PG8_MMA(0, 1, At, B1); PG8_BAR; PG8_SCHED;
            PG8_LDA(At, 0, 1); PG8_STAGE(PG8_SB(0, 0), b2, voffB); PG8_STAGE(PG8_SB(0, 1), b2 + hstep, voffB); PG8_STAGE(PG8_SA(0, 0), a2, voffA);
            PG8_WAIT_V(8); PG8_WAIT_L(0); PG8_BAR; PG8_MMA(1, 0, At, B0); PG8_MMA(1, 1, At, B1); PG8_BAR; PG8_SCHED;
            PG8_LDB(B0, 1, 0); PG8_LDB(B1, 1, 1); PG8_SCHED; PG8_LDA(At, 1, 0); PG8_STAGE(PG8_SA(0, 1), a2 + hstep, voffA);
            PG8_WAIT_V(8); PG8_WAIT_L(0); PG8_BAR; PG8_MMA(0, 0, At, B0); PG8_MMA(0, 1, At, B1); PG8_BAR; PG8_SCHED;
            PG8_LDA(At, 1, 1); PG8_STAGE(PG8_SB(1, 0), b3, voffB); PG8_STAGE(PG8_SB(1, 1), b3 + hstep, voffB); PG8_STAGE(PG8_SA(1, 0), a3, voffA);
            PG8_WAIT_V(8); PG8_WAIT_L(0); PG8_BAR; PG8_MMA(1, 0, At, B0); PG8_MMA(1, 1, At, B1); PG8_BAR; PG8_SCHED;
            } else {
            PG8_LDB(B0, 0, 0); PG8_SCHED; PG8_LDA(At, 0, 0); PG8_STAGE(PG8_SA(1, 1), a1 + hstep, voffA);
            PG8_WAIT_L(8); PG8_BAR; PG8_WAIT_L(0); PG8_MMA(0, 0, At, B0); PG8_BAR; PG8_SCHED;
            PG8_LDB(B1, 0, 1); PG8_STAGE(PG8_SB(0, 0), b2, voffB);
            PG8_BAR; PG8_WAIT_L(0); PG8_MMA(0, 1, At, B1); PG8_BAR;
            PG8_LDA(At, 0, 1); PG8_STAGE(PG8_SA(0, 0), a2, voffA);
            PG8_BAR; PG8_WAIT_L(0); PG8_MMA(1, 0, At, B0); PG8_BAR; PG8_SCHED;
            PG8_STAGE(PG8_SB(0, 1), b2 + hstep, voffB);
            PG8_WAIT_V(6); PG8_BAR; PG8_MMA(1, 1, At, B1); PG8_BAR;
            PG8_LDB(B0, 1, 0); PG8_SCHED; PG8_LDA(At, 1, 0); PG8_STAGE(PG8_SA(0, 1), a2 + hstep, voffA);
            PG8_WAIT_L(8); PG8_BAR; PG8_WAIT_L(0); PG8_MMA(0, 0, At, B0); PG8_BAR; PG8_SCHED;
            PG8_LDB(B1, 1, 1); PG8_STAGE(PG8_SB(1, 0), b3, voffB);
            PG8_BAR; PG8_WAIT_L(0); PG8_MMA(0, 1, At, B1); PG8_BAR;
            PG8_LDA(At, 1, 1); PG8_STAGE(PG8_SA(1, 0), a3, voffA);
            PG8_BAR; PG8_WAIT_L(0); PG8_MMA(1, 0, At, B0); PG8_BAR; PG8_SCHED;
            PG8_STAGE(PG8_SB(1, 1), b3 + hstep, voffB);
            PG8_WAIT_V(6); PG8_BAR; PG8_MMA(1, 1, At, B1); PG8_BAR;
            }
        }
        if constexpr (ALIGN_EPI) { if (wr == 0) PG8_BAR; }
        if constexpr (FP8) asm volatile("s_nop 15\n\ts_nop 15" ::: "memory");
        if constexpr (!Epi::AFTER_DRAIN) { E(acc, cur, wr, wc, fr, fq); S.done(cur); }
        if (!has_next) break;
        if constexpr (KEEP) {
#pragma unroll
            for (int a = 0; a < 2; ++a)
#pragma unroll
                for (int m = 0; m < 4; ++m) { const float f = E.keep_factor(cur, a, m, wr, fr);
#pragma unroll
                    for (int b = 0; b < 2; ++b) { acc[a][b][m][0] *= f; acc[a][b][m][1] *= f; } }
        } else
#pragma unroll
        for (int a = 0; a < 2; ++a)
#pragma unroll
            for (int b = 0; b < 2; ++b)
#pragma unroll
                for (int m = 0; m < 4; ++m)
#pragma unroll
                    for (int n = 0; n < 2; ++n) acc[a][b][m][n] = (f32x4){0.f, 0.f, 0.f, 0.f};
        cur = nxt; cA = nA; cB = nB; ++ui;
        if constexpr (ALIGN_EPI) { if (wr == 1) PG8_BAR; }
    }
    PG8_WAIT_V(0);
    if constexpr (!ALIGN_EPI) { if (wr == 0) PG8_BAR; }
    PG8_BAR;
    if constexpr (Epi::AFTER_DRAIN) { E.fused(acc, cur, wr, wc, fr, fq, lds, wid, lane); S.done(cur); }
#undef PG8_SA
#undef PG8_SB
#undef PG8_STAGE
#undef PG8_LDA
#undef PG8_LDB
#undef PG8_MMA
#undef PG8_WAIT_V
#undef PG8_WAIT_L
#undef PG8_BAR
#undef PG8_SCHED
}
}
constexpr int NWAVES = 8, NTHR = NWAVES * 64;
constexpr int DM = 4096, NLAT = 16384, NCTX = 512, MROWS = NLAT + NCTX, SEQ = 8192, CTXL = 256;
constexpr int FF = 11008, NGU = 2 * FF;
constexpr int NINP = 8448;
constexpr int PQ = 0, PZ = 2048, PK = 4096, PV = 4608, PXBC = 5120;
constexpr int XBCW = 3072;
constexpr int NMOD = 9 * DM;
constexpr int NSC = 132;
constexpr float EPS = 1e-6f;
constexpr float QSCALE = 0.12751743082459868f;
constexpr float LOG2E = 1.4426950408889634f;

constexpr size_t MiB = 1u << 20;
constexpr size_t WS_CTL = 0, WS_MOD = 1 * MiB, ZERO_BYTES = 2 * MiB;
constexpr size_t WS_ROWSS = 1 * MiB + 512 * 1024;
constexpr size_t WS_ROPE = 2 * MiB;
constexpr size_t WS_DEC = 2 * MiB + 65536;
constexpr size_t WS_DTF = 4 * MiB, WS_DTB = 7 * MiB;
constexpr size_t WS_WGU0 = 16 * MiB, WS_WD0 = 188 * MiB, WS_WIN = 274 * MiB, WS_WOUT = 340 * MiB, WS_WGU1 = 372 * MiB, WS_WD1 = 544 * MiB;
constexpr size_t WS_H = 630 * MiB;
constexpr size_t WS_ACT = 762 * MiB, WS_P = 762 * MiB;
constexpr size_t WS_Y = 1117 * MiB;
constexpr size_t WS_X1 = 1249 * MiB;
constexpr size_t WS_XC = 1505 * MiB;
constexpr size_t WS_OATT = 1604 * MiB, WS_YS = 1668 * MiB;
constexpr size_t WS_SLOC = 1732 * MiB;
constexpr size_t WS_HIN = 1996 * MiB;
constexpr size_t WS_YCP = 2124 * MiB;
constexpr size_t WS_END = 2188 * MiB;
static_assert(WS_WGU0 + (size_t)NGU * DM * 2 <= WS_WD0 && WS_WD0 + (size_t)DM * FF * 2 <= WS_WIN && WS_WIN + (size_t)NINP * DM * 2 <= WS_WOUT && WS_WOUT + (size_t)DM * DM * 2 <= WS_WGU1, "ws map 1");
static_assert(WS_WGU1 + (size_t)NGU * DM * 2 <= WS_WD1 && WS_WD1 + (size_t)DM * FF * 2 <= WS_H && WS_H + (size_t)MROWS * DM * 2 <= WS_ACT && WS_ACT + (size_t)MROWS * FF * 2 <= WS_Y, "ws map 2");
static_assert(WS_P + (size_t)MROWS * NINP * 2 <= WS_Y && WS_Y + (size_t)MROWS * DM * 2 <= WS_X1 && WS_X1 + (size_t)NLAT * DM * 4 <= WS_XC && WS_XC + (size_t)MROWS * XBCW * 2 <= WS_OATT, "ws map 3");
static_assert(WS_OATT + (size_t)NLAT * 2048 * 2 <= WS_YS && WS_YS + (size_t)NLAT * 2048 * 2 <= WS_SLOC && WS_SLOC + (size_t)NSC * 2 * 32 * 8192 * 4 <= WS_HIN && WS_HIN + (size_t)128 * 2 * 32 * 8192 * 2 <= WS_END, "ws map 4");
static_assert(WS_DTF + (size_t)MROWS * 32 * 4 <= WS_DTB && WS_DTB + (size_t)MROWS * 32 * 4 <= WS_WGU0 && WS_MOD + (size_t)3 * NMOD * 4 <= ZERO_BYTES, "ws map 5");
constexpr int CW_BAR = 4096;

constexpr int RING_BYTES = 131072;
constexpr int MISC_OFF = RING_BYTES + 320;
constexpr int LDS_BYTES = 147456;

#define GAS __attribute__((address_space(1)))
#define LAS __attribute__((address_space(3)))
typedef unsigned short bf16;
typedef unsigned u32x4 __attribute__((ext_vector_type(4)));
typedef unsigned u32x2 __attribute__((ext_vector_type(2)));
typedef float f32x4 __attribute__((ext_vector_type(4)));
typedef short bf16x8 __attribute__((ext_vector_type(8)));
typedef short bf16x4 __attribute__((ext_vector_type(4)));
using pg8::pk_bf16; using pg8::pk_bf16q; using pg8::pk_f16; using pg8::silu_f;
__device__ __forceinline__ float bf_lo(unsigned w) { return __uint_as_float(w << 16); }
__device__ __forceinline__ float bf_hi(unsigned w) { return __uint_as_float(w & 0xffff0000u); }
__device__ __forceinline__ unsigned short f2bf(float f) { return (unsigned short)(pk_bf16(f, 0.f) & 0xffffu); }
__device__ __forceinline__ float row_max(float x) {
    u32x2 r = __builtin_amdgcn_permlane16_swap(__float_as_uint(x), __float_as_uint(x), false, false); x = fmaxf(__uint_as_float(r.x), __uint_as_float(r.y));
    r = __builtin_amdgcn_permlane32_swap(__float_as_uint(x), __float_as_uint(x), false, false); return fmaxf(__uint_as_float(r.x), __uint_as_float(r.y));
}
__device__ __forceinline__ float row_sum(float x) {
    u32x2 r = __builtin_amdgcn_permlane16_swap(__float_as_uint(x), __float_as_uint(x), false, false); x = __uint_as_float(r.x) + __uint_as_float(r.y);
    r = __builtin_amdgcn_permlane32_swap(__float_as_uint(x), __float_as_uint(x), false, false); return __uint_as_float(r.x) + __uint_as_float(r.y);
}
__device__ __forceinline__ float wave_sum(float v) {
    v += __uint_as_float(__builtin_amdgcn_update_dpp(0u, __float_as_uint(v), 0xB1, 0xF, 0xF, false));
    v += __uint_as_float(__builtin_amdgcn_update_dpp(0u, __float_as_uint(v), 0x4E, 0xF, 0xF, false));
    v += __uint_as_float(__builtin_amdgcn_update_dpp(0u, __float_as_uint(v), 0x141, 0xF, 0xF, false));
    v += __uint_as_float(__builtin_amdgcn_update_dpp(0u, __float_as_uint(v), 0x140, 0xF, 0xF, false));
    return row_sum(v);
}
typedef _Float16 f16x8 __attribute__((ext_vector_type(8)));
typedef _Float16 f16x2 __attribute__((ext_vector_type(2)));
typedef float f32x2 __attribute__((ext_vector_type(2)));
__device__ __forceinline__ void unpack8h(const u32x4 w, float (&f)[8]) { const f16x8 h = __builtin_bit_cast(f16x8, w);
#pragma unroll
    for (int e = 0; e < 8; ++e) f[e] = (float)h[e]; }
__device__ __forceinline__ void unpack8(const u32x4 w, float (&f)[8]) {
    f[0] = bf_lo(w.x); f[1] = bf_hi(w.x); f[2] = bf_lo(w.y); f[3] = bf_hi(w.y); f[4] = bf_lo(w.z); f[5] = bf_hi(w.z); f[6] = bf_lo(w.w); f[7] = bf_hi(w.w);
}
#define XB_TMO      128
#define XB_XCNT(j)  (256  + 64 * (j))
#define XB_XSUB(j)  (1280 + 64 * (j))
#define XB_XGEN(j)  (2304 + 64 * (j))
#define XB_TOP      3328
#define XB_TOPGEN   3392
#define XCD_BAR_WORDS 3456
#define XB_SPIN_CAP (1u << 18)

__device__ __forceinline__ unsigned xb_ld(unsigned* p)              { return __hip_atomic_load(p, __ATOMIC_RELAXED, __HIP_MEMORY_SCOPE_AGENT); }
__device__ __forceinline__ unsigned xb_add(unsigned* p, unsigned v) { return __hip_atomic_fetch_add(p, v, __ATOMIC_RELAXED, __HIP_MEMORY_SCOPE_AGENT); }
__device__ __forceinline__ unsigned xb_xcc_id() { return (unsigned)__builtin_amdgcn_s_getreg((3 << 11) | 20) & 0xFu; }
#define XB_SPIN(cond, bar) do { unsigned _sp = 0; while (cond) { __builtin_amdgcn_s_sleep(1); \
    if ((++_sp & 255u) == 0u) { if (xb_ld(&(bar)[XB_TMO])) break; if (_sp > XB_SPIN_CAP) { atomicAdd(&(bar)[XB_TMO], 1u); break; } } } } while (0)

struct XcdBarrier {
    unsigned* bar; unsigned x;
    volatile LAS unsigned* st;
};

__device__ __forceinline__ XcdBarrier xcd_barrier_post(unsigned* bar, volatile LAS unsigned* st) {
    XcdBarrier b; b.bar = bar; b.x = xb_xcc_id(); b.st = st;
    if (threadIdx.x == 0) (void)xb_add(&bar[XB_XCNT(b.x)], 1u);
    return b;
}
__device__ __forceinline__ void xcd_barrier_complete(unsigned* bar, unsigned x, unsigned& nloc, unsigned& nx) {
    const unsigned G = gridDim.x * gridDim.y * gridDim.z;
    unsigned sum, cnt, mine, sp = 0u;
    for (;;) {
        sum = 0u; cnt = 0u; mine = 0u;
#pragma unroll
        for (unsigned j = 0; j < 16; ++j) { const unsigned c = xb_ld(&bar[XB_XCNT(j)]); sum += c; cnt += (c > 0u) ? 1u : 0u; mine = (j == x) ? c : mine; }
        if (sum == G) break;
        __builtin_amdgcn_s_sleep(1);
        if ((++sp & 255u) == 0u) { if (xb_ld(&bar[XB_TMO])) break; if (sp > XB_SPIN_CAP) { atomicAdd(&bar[XB_TMO], 1u); break; } }
    }
    nloc = mine > 0u ? mine : 1u; nx = cnt > 0u ? cnt : 1u;
}

__device__ __forceinline__ void xcd_barrier(const XcdBarrier& b) {
    asm volatile("s_waitcnt vmcnt(0)" ::: "memory");
    __syncthreads();
    if (threadIdx.x == 0) {
        unsigned* bar = b.bar;
        __builtin_amdgcn_s_waitcnt(0);
        unsigned nloc = b.st[0], nx = b.st[1];
        if (nloc == 0u) { xcd_barrier_complete(bar, b.x, nloc, nx); b.st[0] = nloc; b.st[1] = nx; }
        const unsigned old = xb_add(&bar[XB_XSUB(b.x)], 1u);
        const unsigned gen = old / nloc;
        if (old + 1u == (gen + 1u) * nloc) {
            __builtin_amdgcn_fence(__ATOMIC_RELEASE, "agent");
            asm volatile("s_waitcnt vmcnt(0)" ::: "memory");
            const unsigned og = xb_add(&bar[XB_TOP], 1u);
            const unsigned tg = og / nx;
            if (og + 1u == (tg + 1u) * nx) xb_add(&bar[XB_TOPGEN], 1u);
            else XB_SPIN(xb_ld(&bar[XB_TOPGEN]) == tg, bar);
            __builtin_amdgcn_fence(__ATOMIC_ACQUIRE, "agent");
            xb_add(&bar[XB_XGEN(b.x)], 1u);
            asm volatile("s_waitcnt vmcnt(0)" ::: "memory");
        } else {
            XB_SPIN(xb_ld(&bar[XB_XGEN(b.x)]) == gen, bar);
            __builtin_amdgcn_fence(__ATOMIC_ACQUIRE, "agent");
            asm volatile("s_waitcnt vmcnt(0)" ::: "memory");
        }
    }
    __syncthreads();
}
struct Fr {
    LAS unsigned char* lds;
    int tid, lane, wave, G, bid;
    const float* in[21]; float* out; unsigned char* ws;
};
#define WSP(T, off) ((T*)(F.ws + (off)))
#define LDSW() asm volatile("s_waitcnt lgkmcnt(0)" ::: "memory")

__device__ __forceinline__ int qk_perm(int d) { const int a = d >> 6, hf = (d >> 5) & 1, i = d & 31; return 32 * (2 * a + (i >> 4)) + 8 * ((i >> 2) & 3) + 4 * hf + (i & 3); }
__device__ __forceinline__ int dst_row(int mode, int n) {
    if (mode == 1) return ((n >> 7) << 8) + (n & 127);
    if (mode == 2) return ((n >> 7) << 8) + 128 + (n & 127);
    if (mode == 3) { if (n < 2048 || (n >= 4096 && n < 4608)) return (n & ~127) + qk_perm(n & 127); return n; }
    return n;
}
#ifndef WQ_DROP
#define WQ_DROP 2
#endif
__device__ __forceinline__ float wquant(float v) {
    if (WQ_DROP == 0) return v;
    unsigned u = __float_as_uint(v); constexpr unsigned sh = 16 + WQ_DROP, half = (1u << (sh - 1)) - 1u;
    u = (u + half + ((u >> sh) & 1u)) & ~((1u << sh) - 1u); return __uint_as_float(u);
}
__device__ __forceinline__ void transpose_item(const float* W, int K, int N, bf16* WT, int mode, const float* kscale, LAS float* scr, int item, int lane) {
    const int nblk = N / 32, kb = item / nblk, nb = item - kb * nblk, k0 = 64 * kb, n0 = 32 * nb;
    float wv[32];
#pragma unroll
    for (int i = 0; i < 32; ++i) wv[i] = __builtin_nontemporal_load(W + (size_t)(k0 + 2 * i + (lane >> 5)) * N + n0 + (lane & 31));
#pragma unroll
    for (int i = 0; i < 32; ++i) { const int kk = 2 * i + (lane >> 5); float v = wv[i]; if (kscale) v *= kscale[k0 + kk]; scr[kk * 33 + (lane & 31)] = (mode & 8) ? wquant(v) : v; }
    LDSW();
    const int c = lane & 7;
#pragma unroll
    for (int j = 0; j < 4; ++j) { const int n = (lane >> 3) + 8 * j; const LAS float* s = scr + (8 * c) * 33 + n;
        u32x4 o; o.x = pk_bf16(s[0 * 33], s[1 * 33]); o.y = pk_bf16(s[2 * 33], s[3 * 33]); o.z = pk_bf16(s[4 * 33], s[5 * 33]); o.w = pk_bf16(s[6 * 33], s[7 * 33]);
        *(u32x4*)(WT + (size_t)dst_row(mode & 7, n0 + n) * K + k0 + 8 * c) = o; }
    LDSW();
}
__device__ __forceinline__ void transpose_item8(const float* W, int K, int N, unsigned char* WT, LAS float* scr, int item, int lane) {
    const int nblk = N / 32, kb = item / nblk, nb = item - kb * nblk, k0 = 64 * kb, n0 = 32 * nb;
    float wv[32];
#pragma unroll
    for (int i = 0; i < 32; ++i) wv[i] = __builtin_nontemporal_load(W + (size_t)(k0 + 2 * i + (lane >> 5)) * N + n0 + (lane & 31));
#pragma unroll
    for (int i = 0; i < 32; ++i) { const int kk = 2 * i + (lane >> 5); scr[kk * 33 + (lane & 31)] = 2048.f * wv[i]; }
    LDSW();
    const int n = lane >> 1, kh = (lane & 1) * 32; const LAS float* s = scr + kh * 33 + n;
    u32x4 o0, o1;
    o0.x = pg8::pk4_fp8(s[0 * 33], s[1 * 33], s[2 * 33], s[3 * 33]); o0.y = pg8::pk4_fp8(s[4 * 33], s[5 * 33], s[6 * 33], s[7 * 33]);
    o0.z = pg8::pk4_fp8(s[8 * 33], s[9 * 33], s[10 * 33], s[11 * 33]); o0.w = pg8::pk4_fp8(s[12 * 33], s[13 * 33], s[14 * 33], s[15 * 33]);
    o1.x = pg8::pk4_fp8(s[16 * 33], s[17 * 33], s[18 * 33], s[19 * 33]); o1.y = pg8::pk4_fp8(s[20 * 33], s[21 * 33], s[22 * 33], s[23 * 33]);
    o1.z = pg8::pk4_fp8(s[24 * 33], s[25 * 33], s[26 * 33], s[27 * 33]); o1.w = pg8::pk4_fp8(s[28 * 33], s[29 * 33], s[30 * 33], s[31 * 33]);
    unsigned char* dst = WT + (size_t)(n0 + n) * K + k0 + kh;
    *(u32x4*)dst = o0; *(u32x4*)(dst + 16) = o1;
    LDSW();
}
constexpr int CV_F = 22016, CV_IN = 64 * 258, CV_OUT = 64 * 128;
constexpr int CV_WD0 = 2 * CV_F, CV_WIN = 3 * CV_F, CV_WOUT = CV_WIN + CV_IN, CV_G1 = CV_WOUT + CV_OUT, CV_U1 = CV_G1 + CV_F, CV_WD1 = CV_U1 + CV_F, CV_END = CV_WD1 + CV_F;
constexpr int CV_Q2_LO = CV_WD0, CV_Q2_HI = CV_WOUT;
constexpr int CV_Q5_LO = CV_WOUT, CV_Q5_HI = CV_G1 + 28000;
constexpr int CV_Q13_LO = CV_WD1, CV_Q13_HI = CV_END;
constexpr int CW_Q2 = 1024, CW_Q5 = 1088, CW_Q13 = 1152;
__device__ __forceinline__ void conv_item(Fr& F, int id, LAS float* scr) {
    const size_t FW = (size_t)DM * FF;
    if (id < CV_F) { transpose_item(F.in[8], DM, FF, WSP(bf16, WS_WGU0), 1 | 8, nullptr, scr, id, F.lane); return; }
    if (id < CV_WD0) { transpose_item(F.in[9], DM, FF, WSP(bf16, WS_WGU0), 2 | 8, nullptr, scr, id - CV_F, F.lane); return; }
    if (id < CV_WIN) { transpose_item(F.in[10], FF, DM, WSP(bf16, WS_WD0), 0 | 8, nullptr, scr, id - CV_WD0, F.lane); return; }
    if (id < CV_WOUT) { transpose_item(F.in[11], DM, 8256, WSP(bf16, WS_WIN), 3, nullptr, scr, id - CV_WIN, F.lane); return; }
    if (id < CV_G1) { const int r = id - CV_WOUT, kb = r / 128; const float* ks = (kb < 32) ? F.in[13] : (F.in[19] - 2048);
        transpose_item(F.in[20], DM, DM, WSP(bf16, WS_WOUT), 0, ks, scr, r, F.lane); return; }
    if (id < CV_U1) { transpose_item(F.in[8] + FW, DM, FF, WSP(bf16, WS_WGU1), 1 | 8, nullptr, scr, id - CV_G1, F.lane); return; }
    if (id < CV_WD1) { transpose_item(F.in[9] + FW, DM, FF, WSP(bf16, WS_WGU1), 2 | 8, nullptr, scr, id - CV_U1, F.lane); return; }
    transpose_item8(F.in[10] + FW, FF, DM, WSP(unsigned char, WS_WD1), scr, id - CV_WD1, F.lane);
}
__device__ __forceinline__ void p0_prologue(Fr& F, int rep = 0) {
    const int gw = F.bid * NWAVES + F.wave, NGW = F.G * NWAVES, gt = F.bid * NTHR + F.tid, NGT = F.G * NTHR;
    LAS float* scr = (LAS float*)(F.lds + F.wave * 8448);
    LAS float* sv = (LAS float*)(F.lds + 69632);
    for (int i = F.tid; i < 3 * DM; i += NTHR) { const int r = i >> 12, k = i & 4095; const float v = (r < 2) ? F.in[1][r * DM + k] : F.in[3][k]; sv[i] = v / (1.0f + __expf(-v)); }
    for (int e = gt; e < 4096; e += NGT) {
        const int pos = e >> 5, i = e & 31; double inv = 1.0; for (int q = 0; q < i; ++q) inv *= 0.74989420933245582730;
        double a = (double)pos * inv; const double k = __builtin_rint(a * 0.15915494309189533577); a = (a - k * 6.283185307179586232) - k * 2.449293598294706414e-16;
        const double a2 = a * a; double sn = 1.0, cs = 1.0;
        for (int q = 14; q >= 1; --q) { sn = 1.0 - sn * a2 / (double)((2 * q) * (2 * q + 1)); cs = 1.0 - cs * a2 / (double)((2 * q - 1) * (2 * q)); }
        sn *= a;
        WSP(float, WS_ROPE)[e] = (float)cs; WSP(float, WS_ROPE)[4096 + e] = (float)sn;
    }
    for (int e = gt; e < 192 * DM / 8; e += NGT) WSP(u32x4, WS_WIN + (size_t)8256 * DM * 2)[e] = (u32x4){0u, 0u, 0u, 0u};
    __syncthreads();
    {
        const float* wm = F.in[4]; const float* bm = F.in[5]; float* MOD = rep ? WSP(float, WS_YCP) : WSP(float, WS_MOD);
        for (int it = gw; it < 144 * 64; it += NGW) {
            const int chunk = it % 144, ks = it / 144, n = chunk * 256 + 4 * F.lane;
            f32x4 a0 = (f32x4){0.f, 0.f, 0.f, 0.f}, a1 = a0, a2 = a0;
            if (ks == 0) { a0 = *(const f32x4*)(bm + n); a1 = a0; a2 = a0; }
            const float* wp = wm + (size_t)(ks * 64) * NMOD + n; const LAS float* s = sv + ks * 64;
#pragma unroll 8
            for (int k = 0; k < 64; ++k) { const f32x4 w = __builtin_nontemporal_load((const f32x4*)(wp + (size_t)k * NMOD)); a0 += s[k] * w; a1 += s[DM + k] * w; a2 += s[2 * DM + k] * w; }
#pragma unroll
            for (int j = 0; j < 4; ++j) {
                __hip_atomic_fetch_add(MOD + n + j, a0[j], __ATOMIC_RELAXED, __HIP_MEMORY_SCOPE_AGENT);
                __hip_atomic_fetch_add(MOD + NMOD + n + j, a1[j], __ATOMIC_RELAXED, __HIP_MEMORY_SCOPE_AGENT);
                __hip_atomic_fetch_add(MOD + 2 * NMOD + n + j, a2[j], __ATOMIC_RELAXED, __HIP_MEMORY_SCOPE_AGENT); }
        }
    }
#ifndef PROBE_P0T
#define PROBE_P0T 1
#endif
    for (int rep = 0; rep < PROBE_P0T; ++rep) {
        for (int it = gw; it < CV_Q2_LO; it += NGW) conv_item(F, it, scr);
        for (int it = CV_Q5_HI + gw; it < CV_Q13_LO; it += NGW) conv_item(F, it, scr);
    }
}
__device__ __forceinline__ void conv_queue(Fr& F, int qword, int lo, int hi) {
    LAS float* scr = (LAS float*)(F.lds + F.wave * 8448);
    unsigned* ctr = (unsigned*)(F.ws + WS_CTL) + qword;
    unsigned b = 0; if (F.lane == 0) b = __hip_atomic_fetch_add(ctr, 4u, __ATOMIC_RELAXED, __HIP_MEMORY_SCOPE_AGENT);
    for (;;) {
        const int base = lo + (int)__builtin_amdgcn_readfirstlane(b);
        if (base >= hi) break;
        unsigned bn = 0; if (F.lane == 0) bn = __hip_atomic_fetch_add(ctr, 4u, __ATOMIC_RELAXED, __HIP_MEMORY_SCOPE_AGENT);
        for (int q = 0; q < 4 && base + q < hi; ++q) conv_item(F, base + q, scr);
        b = bn;
    }
}

__device__ __forceinline__ void norm_mod_row(const float* xrow, const float* g, const float* scale, const float* shift, bf16* hrow, int lane) {
    f32x4 v[16]; float ss = 0.f;
#pragma unroll
    for (int j = 0; j < 8; ++j) { const float* p = xrow + 512 * j + 8 * lane; v[2 * j] = __builtin_nontemporal_load((const f32x4*)p); v[2 * j + 1] = __builtin_nontemporal_load((const f32x4*)(p + 4)); }
#pragma unroll
    for (int j = 0; j < 16; ++j) ss += (v[j][0] * v[j][0] + v[j][1] * v[j][1]) + (v[j][2] * v[j][2] + v[j][3] * v[j][3]);
    const float rstd = 1.0f / sqrtf(wave_sum(ss) * (1.0f / DM) + EPS);
#pragma unroll
    for (int j = 0; j < 8; ++j) { const int o = 512 * j + 8 * lane;
        const f32x4 g0 = *(const f32x4*)(g + o), g1 = *(const f32x4*)(g + o + 4), s0 = *(const f32x4*)(scale + o), s1 = *(const f32x4*)(scale + o + 4), t0 = *(const f32x4*)(shift + o), t1 = *(const f32x4*)(shift + o + 4);
        const f32x4 a = v[2 * j] * rstd * g0 * (1.0f + s0) + t0, b = v[2 * j + 1] * rstd * g1 * (1.0f + s1) + t1;
        u32x4 w; w.x = pk_bf16q(a[0], a[1]); w.y = pk_bf16q(a[2], a[3]); w.z = pk_bf16q(b[0], b[1]); w.w = pk_bf16q(b[2], b[3]);
        *(u32x4*)(hrow + o) = w; }
}
template <bool STORE_X, bool DO_H, bool YSPLIT = false, bool XIN_BF = false, bool XOUT_BF = false, bool HQ = false>
__device__ __forceinline__ void res_norm_row(const void* xin_, const bf16* yrow, void* xout_, bf16* hrow, float coef, const float* gate, const float* gpost,
                                             const float* gpre, const float* scale, const float* shift, int lane, const float* ysplit = nullptr, float ymul = 1.0f) {
    u32x4 yv[8]; float ssy = 0.f;
    if (YSPLIT) {
#pragma unroll
        for (int j = 0; j < 8; ++j) { f32x4 a = (f32x4){0.f, 0.f, 0.f, 0.f}, b = a;
#pragma unroll
            for (int s = 0; s < 8; ++s) { const float* p = ysplit + (size_t)s * 512 * DM + 512 * j + 8 * lane; a += *(const f32x4*)p; b += *(const f32x4*)(p + 4); }
            yv[j].x = pk_f16(a[0], a[1]); yv[j].y = pk_f16(a[2], a[3]); yv[j].z = pk_f16(b[0], b[1]); yv[j].w = pk_f16(b[2], b[3]); }
    } else {
#pragma unroll
    for (int j = 0; j < 8; ++j) yv[j] = __builtin_nontemporal_load((const u32x4*)(yrow + 512 * j + 8 * lane));
    }
    f32x4 v[16];
#pragma unroll
    for (int j = 0; j < 8; ++j) {
        if (XIN_BF) { float f[8]; unpack8h(__builtin_nontemporal_load((const u32x4*)((const bf16*)xin_ + 512 * j + 8 * lane)), f); v[2 * j] = (f32x4){f[0], f[1], f[2], f[3]}; v[2 * j + 1] = (f32x4){f[4], f[5], f[6], f[7]}; }
        else { const float* p = (const float*)xin_ + 512 * j + 8 * lane; v[2 * j] = __builtin_nontemporal_load((const f32x4*)p); v[2 * j + 1] = __builtin_nontemporal_load((const f32x4*)(p + 4)); } }
#pragma unroll
    for (int j = 0; j < 8; ++j) { float f[8]; unpack8h(yv[j], f);
#pragma unroll
        for (int e = 0; e < 8; ++e) ssy += f[e] * f[e]; }
    const float ry = coef * ymul / sqrtf(wave_sum(ssy) * (ymul * ymul) * (1.0f / DM) + EPS);
    float ss = 0.f;
#pragma unroll
    for (int j = 0; j < 8; ++j) { const int o = 512 * j + 8 * lane; float f[8]; unpack8h(yv[j], f);
        const f32x4 ga0 = *(const f32x4*)(gate + o), ga1 = *(const f32x4*)(gate + o + 4), gp0 = *(const f32x4*)(gpost + o), gp1 = *(const f32x4*)(gpost + o + 4);
        const f32x4 y0 = (f32x4){f[0], f[1], f[2], f[3]}, y1 = (f32x4){f[4], f[5], f[6], f[7]};
        v[2 * j] += ga0 * gp0 * (y0 * ry); v[2 * j + 1] += ga1 * gp1 * (y1 * ry);
        if (STORE_X) {
            if (XOUT_BF) { u32x4 w; w.x = pk_f16(v[2 * j][0], v[2 * j][1]); w.y = pk_f16(v[2 * j][2], v[2 * j][3]); w.z = pk_f16(v[2 * j + 1][0], v[2 * j + 1][1]); w.w = pk_f16(v[2 * j + 1][2], v[2 * j + 1][3]);
                __builtin_nontemporal_store(w, (u32x4*)((bf16*)xout_ + o)); }
            else { __builtin_nontemporal_store(v[2 * j], (f32x4*)((float*)xout_ + o)); __builtin_nontemporal_store(v[2 * j + 1], (f32x4*)((float*)xout_ + o + 4)); } }
        if (DO_H) ss += (v[2 * j][0] * v[2 * j][0] + v[2 * j][1] * v[2 * j][1]) + (v[2 * j][2] * v[2 * j][2] + v[2 * j][3] * v[2 * j][3])
                      + (v[2 * j + 1][0] * v[2 * j + 1][0] + v[2 * j + 1][1] * v[2 * j + 1][1]) + (v[2 * j + 1][2] * v[2 * j + 1][2] + v[2 * j + 1][3] * v[2 * j + 1][3]); }
    if (DO_H) {
        const float rstd = 1.0f / sqrtf(wave_sum(ss) * (1.0f / DM) + EPS);
#pragma unroll
        for (int j = 0; j < 8; ++j) { const int o = 512 * j + 8 * lane;
            const f32x4 g0 = *(const f32x4*)(gpre + o), g1 = *(const f32x4*)(gpre + o + 4), s0 = *(const f32x4*)(scale + o), s1 = *(const f32x4*)(scale + o + 4), t0 = *(const f32x4*)(shift + o), t1 = *(const f32x4*)(shift + o + 4);
            const f32x4 a = v[2 * j] * rstd * g0 * (1.0f + s0) + t0, b = v[2 * j + 1] * rstd * g1 * (1.0f + s1) + t1;
            u32x4 w;
            if (HQ) { w.x = pk_bf16q(a[0], a[1]); w.y = pk_bf16q(a[2], a[3]); w.z = pk_bf16q(b[0], b[1]); w.w = pk_bf16q(b[2], b[3]); }
            else { w.x = pk_bf16(a[0], a[1]); w.y = pk_bf16(a[2], a[3]); w.z = pk_bf16(b[0], b[1]); w.w = pk_bf16(b[2], b[3]); }
            *(u32x4*)(hrow + o) = w; }
    }
}
__device__ __forceinline__ int mod_row_of(int m) { return m < NLAT ? (m >> 13) : 2; }
__device__ __forceinline__ const float* xin_row(Fr& F, int m) { return m < NLAT ? F.in[0] + (size_t)m * DM : F.in[2] + (size_t)(m - NLAT) * DM; }

__device__ __forceinline__ void p1_norm(Fr& F) {
    const int gw = F.bid * NWAVES + F.wave, NGW = F.G * NWAVES; const float* MOD = WSP(float, WS_MOD);
    for (int m = gw; m < MROWS; m += NGW) { const float* md = MOD + (size_t)mod_row_of(m) * NMOD;
        norm_mod_row(xin_row(F, m), F.in[6], md + 1 * DM, md + 0 * DM, WSP(bf16, WS_H) + (size_t)m * DM, F.lane); }
}
__device__ __forceinline__ void p4_resnorm(Fr& F) {
    const int gw = F.bid * NWAVES + F.wave, NGW = F.G * NWAVES; const float* MOD = WSP(float, WS_MOD);
    for (int m = gw; m < MROWS; m += NGW) { const float* md = MOD + (size_t)mod_row_of(m) * NMOD; const bf16* y = WSP(bf16, WS_Y) + (size_t)m * DM; bf16* h = WSP(bf16, WS_H) + (size_t)m * DM;
        if (m < NLAT) res_norm_row<true, true, false, false, true>(xin_row(F, m), y, WSP(bf16, WS_X1) + (size_t)m * DM, h, 0.5f, md + 2 * DM, F.in[7], F.in[6] + DM, md + 4 * DM, md + 3 * DM, F.lane);
        else res_norm_row<false, true, true>(xin_row(F, m), y, nullptr, h, 0.5f, md + 2 * DM, F.in[7], F.in[6] + DM, md + 4 * DM, md + 3 * DM, F.lane, WSP(float, WS_YCP) + (size_t)(m - NLAT) * DM); }
}
__device__ __forceinline__ void p12_resnorm(Fr& F) {
    const int gw = F.bid * NWAVES + F.wave, NGW = F.G * NWAVES; const float* MOD = WSP(float, WS_MOD);
    for (int m = gw; m < NLAT; m += NGW) { const float* md = MOD + (size_t)(m >> 13) * NMOD;
        const float rs = 1.0f / sqrtf(WSP(float, WS_ROWSS)[NLAT + m] * (1.0f / 2048.f) + EPS);
        res_norm_row<true, true, false, true, true, true>(WSP(bf16, WS_X1) + (size_t)m * DM, WSP(bf16, WS_Y) + (size_t)m * DM, WSP(bf16, WS_X1) + (size_t)m * DM, WSP(bf16, WS_H) + (size_t)m * DM, 1.0f, md + 5 * DM, F.in[7] + DM, F.in[6] + 2 * DM, md + 7 * DM, md + 6 * DM, F.lane, nullptr, rs); }
}
__device__ __forceinline__ void p15_final(Fr& F) {
    const int gw = F.bid * NWAVES + F.wave, NGW = F.G * NWAVES; const float* MOD = WSP(float, WS_MOD);
    for (int m = gw; m < NLAT; m += NGW) { const float* md = MOD + (size_t)(m >> 13) * NMOD;
        res_norm_row<true, false, false, true, false>(WSP(bf16, WS_X1) + (size_t)m * DM, WSP(bf16, WS_Y) + (size_t)m * DM, F.out + (size_t)m * DM, nullptr, 0.5f, md + 8 * DM, F.in[7] + 2 * DM, nullptr, nullptr, nullptr, F.lane); }
}
__device__ __forceinline__ void p10_merge(Fr& F) {
    const int gw = F.bid * NWAVES + F.wave, NGW = F.G * NWAVES;
    for (int m = gw; m < NLAT; m += NGW) {
        const bf16* a = WSP(bf16, WS_OATT) + (size_t)m * 2048; const bf16* s = WSP(bf16, WS_YS) + (size_t)m * 2048; bf16* h = WSP(bf16, WS_H) + (size_t)m * DM;
        u32x4 av[4], sv[4]; float sa = 0.f, ssm = 0.f;
#pragma unroll
        for (int j = 0; j < 4; ++j) { av[j] = *(const u32x4*)(a + 512 * j + 8 * F.lane); sv[j] = *(const u32x4*)(s + 512 * j + 8 * F.lane); }
#pragma unroll
        for (int j = 0; j < 4; ++j) { float f[8], q[8]; unpack8(av[j], f); unpack8(sv[j], q);
#pragma unroll
            for (int e = 0; e < 8; ++e) { sa += f[e] * f[e]; ssm += q[e] * q[e]; } }
        const float ra = 1.0f / sqrtf(wave_sum(sa) * (1.0f / 2048.f) + EPS), rs = 1.0f / sqrtf(wave_sum(ssm) * (1.0f / 2048.f) + EPS);
#pragma unroll
        for (int j = 0; j < 4; ++j) { float f[8], q[8]; unpack8(av[j], f); unpack8(sv[j], q);
            u32x4 w; w.x = pk_bf16(f[0] * ra, f[1] * ra); w.y = pk_bf16(f[2] * ra, f[3] * ra); w.z = pk_bf16(f[4] * ra, f[5] * ra); w.w = pk_bf16(f[6] * ra, f[7] * ra);
            *(u32x4*)(h + 512 * j + 8 * F.lane) = w;
            w.x = pk_bf16(q[0] * rs, q[1] * rs); w.y = pk_bf16(q[2] * rs, q[3] * rs); w.z = pk_bf16(q[4] * rs, q[5] * rs); w.w = pk_bf16(q[6] * rs, q[7] * rs);
            *(u32x4*)(h + 2048 + 512 * j + 8 * F.lane) = w; }
    }
}

__device__ __forceinline__ void p6_conv(Fr& F) {
    const int gw = F.bid * NWAVES + F.wave, NGW = F.G * NWAVES;
    const bf16* P = WSP(bf16, WS_P); bf16* XC = WSP(bf16, WS_XC); const float* cw = F.in[14]; const float* cb = F.in[15];
    u32x4 nxt[20];
#define CV_ROWS(itx) do { const int rb_ = (itx) / 6, cgi_ = (itx) - rb_ * 6, m0_ = rb_ * 16, c0_ = (cgi_ * 64 + F.lane) * 8; \
        int s0_, s1_; if (m0_ < NLAT) { s0_ = m0_ & ~(SEQ - 1); s1_ = s0_ + SEQ; } else { s0_ = NLAT + ((m0_ - NLAT) & ~(CTXL - 1)); s1_ = s0_ + CTXL; } \
        _Pragma("unroll") for (int r = 0; r < 20; ++r) { const int row = m0_ - 2 + r; const bool ok = row >= s0_ && row < s1_; const int rc = row < s0_ ? s0_ : (row >= s1_ ? s1_ - 1 : row); \
            const u32x4 v = *(const u32x4*)(P + (size_t)rc * NINP + PXBC + c0_); nxt[r] = ok ? v : (u32x4){0u, 0u, 0u, 0u}; } } while (0)
    if (gw < (MROWS / 16) * 6) CV_ROWS(gw);
    for (int it = gw; it < (MROWS / 16) * 6; it += NGW) {
        const int rb = it / 6, cgi = it - rb * 6, m0 = rb * 16, c0 = (cgi * 64 + F.lane) * 8;
        u32x4 raw[20];
#pragma unroll
        for (int r = 0; r < 20; ++r) raw[r] = nxt[r];
        if (it + NGW < (MROWS / 16) * 6) CV_ROWS(it + NGW);
        float w[5][8], bias[8];
#pragma unroll
        for (int k = 0; k < 5; ++k) { const f32x4 a = *(const f32x4*)(cw + k * XBCW + c0), b = *(const f32x4*)(cw + k * XBCW + c0 + 4);
            w[k][0] = a[0]; w[k][1] = a[1]; w[k][2] = a[2]; w[k][3] = a[3]; w[k][4] = b[0]; w[k][5] = b[1]; w[k][6] = b[2]; w[k][7] = b[3]; }
        { const f32x4 a = *(const f32x4*)(cb + c0), b = *(const f32x4*)(cb + c0 + 4); bias[0] = a[0]; bias[1] = a[1]; bias[2] = a[2]; bias[3] = a[3]; bias[4] = b[0]; bias[5] = b[1]; bias[6] = b[2]; bias[7] = b[3]; }
#pragma unroll
        for (int t = 0; t < 16; ++t) {
            float acc[8];
#pragma unroll
            for (int e = 0; e < 8; ++e) acc[e] = bias[e];
#pragma unroll
            for (int k = 0; k < 5; ++k) { float f[8]; unpack8(raw[t + k], f);
#pragma unroll
                for (int e = 0; e < 8; ++e) acc[e] += w[k][e] * f[e]; }
            u32x4 o; o.x = pk_bf16(silu_f(acc[0]), silu_f(acc[1])); o.y = pk_bf16(silu_f(acc[2]), silu_f(acc[3])); o.z = pk_bf16(silu_f(acc[4]), silu_f(acc[5])); o.w = pk_bf16(silu_f(acc[6]), silu_f(acc[7]));
            *(u32x4*)(XC + (size_t)(m0 + t) * XBCW + c0) = o;
        }
    }
#undef CV_ROWS
}

constexpr int AT_KS = 288, AT_VS = 144, AT_K_OFF = 0, AT_V_OFF = 64 * AT_KS, AT_STG = 64 * AT_KS + 128 * AT_VS;
__device__ __forceinline__ bool attn_tile(int idx, int b, int qb, int& rowbase, int& mt) {
    if (idx < 5) { const int kt = qb + idx - 2; mt = (idx == 0) ? -1 : ((idx == 4) ? 1 : 0); rowbase = b * SEQ + kt * 64; return kt >= 0 && kt < 128; }
    mt = 0; rowbase = NLAT + b * CTXL + (idx - 5) * 64; return true;
}
#ifndef AT_DEPHASE
#define AT_DEPHASE 0
#endif
template <int ABL, int ORD>
__device__ __forceinline__ void attn_unit(Fr& F, const int u, const bool doatom) {
    const bf16* P = WSP(bf16, WS_P); bf16* O = ABL ? WSP(bf16, WS_SLOC) : WSP(bf16, WS_H); float* SSA = WSP(float, WS_ROWSS);
    const int fr = F.lane & 15, g = F.lane >> 4, w = F.wave, hg = w >> 1, half = w & 1;
    const int srow = F.tid >> 3, sd0 = (F.tid & 7) * 16;
    const int vkp = F.tid >> 4, vdq = F.tid & 15;
    const int kfo = fr * AT_KS + 16 * g, vlo0 = fr * AT_VS + (4 * g) * 2, vlo1 = fr * AT_VS + ((4 * g) ^ 8) * 2;
    int vhi0 = vlo0, vhi1 = vlo1; asm volatile("" : "+v"(vhi0), "+v"(vhi1));
    {
        const int qb = u & 127, kvh = (u >> 7) & 3, b = u >> 9, head = kvh * 4 + hg;
        const int r0 = b * SEQ + qb * 64 + half * 32;
        bf16x8 qf[2][4];
#pragma unroll
        for (int m = 0; m < 2; ++m)
#pragma unroll
            for (int ks = 0; ks < 4; ++ks) qf[m][ks] = *(const bf16x8*)(P + (size_t)(r0 + 16 * m + fr) * NINP + PQ + head * 128 + 32 * ks + 8 * g);
        f32x4 accO[8][2];
#pragma unroll
        for (int n = 0; n < 8; ++n) { accO[n][0] = (f32x4){0.f, 0.f, 0.f, 0.f}; accO[n][1] = (f32x4){0.f, 0.f, 0.f, 0.f}; }
        const float sink = F.in[12][head] * LOG2E;
        float mrun[2] = {sink, sink}, lpart[2] = {g == 0 ? 1.0f : 0.0f, g == 0 ? 1.0f : 0.0f};
        int idx = 0, rowbase = 0, mt = 0;
        while (!attn_tile(idx, b, qb, rowbase, mt)) ++idx;
        int nidx = idx + 1, nrow = 0, nmt = 0;
        while (nidx < 9 && !attn_tile(nidx, b, qb, nrow, nmt)) ++nidx;
        u32x4 kr[2][2], vr[2][2];
#define AT_LOAD(rb, S_) do { const bf16* kp = P + (size_t)((rb) + srow) * NINP + PK + kvh * 128 + sd0; kr[S_][0] = *(const u32x4*)kp; kr[S_][1] = *(const u32x4*)(kp + 8); \
                         const bf16* vp = P + (size_t)((rb) + 2 * vkp) * NINP + PV + kvh * 128 + 8 * vdq; vr[S_][0] = *(const u32x4*)vp; vr[S_][1] = *(const u32x4*)(vp + NINP); } while (0)
#define AT_WRITE(st, S_) do { LAS unsigned char* kt_ = F.lds + (st) * AT_STG; LAS unsigned char* vt_ = kt_ + AT_V_OFF; \
            *(LAS u32x4*)(kt_ + srow * AT_KS + sd0 * 2) = kr[S_][0]; *(LAS u32x4*)(kt_ + srow * AT_KS + sd0 * 2 + 16) = kr[S_][1]; \
            const unsigned va_[4] = {vr[S_][0].x, vr[S_][0].y, vr[S_][0].z, vr[S_][0].w}, vb2_[4] = {vr[S_][1].x, vr[S_][1].y, vr[S_][1].z, vr[S_][1].w}; const int vsw_ = ((2 * vkp) ^ (8 * (vdq >> 1))) * 2;     \
            _Pragma("unroll") for (int j = 0; j < 4; ++j) { *(LAS unsigned*)(vt_ + (8 * vdq + 2 * j) * AT_VS + vsw_) = __builtin_amdgcn_perm(vb2_[j], va_[j], 0x05040100u); *(LAS unsigned*)(vt_ + (8 * vdq + 2 * j + 1) * AT_VS + vsw_) = __builtin_amdgcn_perm(vb2_[j], va_[j], 0x07060302u); } } while (0)
        int n2 = (nidx < 9) ? nidx + 1 : 9, n2row = 0, n2mt = 0;
        while (n2 < 9 && !attn_tile(n2, b, qb, n2row, n2mt)) ++n2;
        AT_LOAD(rowbase, 0);
        if (nidx < 9) AT_LOAD(nrow, 1);
        __syncthreads();
        AT_WRITE(0, 0);
        if (n2 < 9) AT_LOAD(n2row, 0);
        __syncthreads();
        int st = 0;
        bf16x8 pf[2][2];
        LAS unsigned char* VTp = F.lds + AT_V_OFF;
        if (ORD) {
#pragma unroll
            for (int m = 0; m < 2; ++m)
#pragma unroll
                for (int s = 0; s < 2; ++s) pf[m][s] = (bf16x8){0, 0, 0, 0, 0, 0, 0, 0}; }
        for (;;) {
#pragma unroll
          for (int par = 0; par < 2; ++par) {
            LAS unsigned char* Kt = F.lds + st * AT_STG; LAS unsigned char* VT = Kt + AT_V_OFF;
#define AT_KF(n, ks) (*(const LAS bf16x8*)(Kt + kfo + (16 * (n)) * AT_KS + (32 * (ks)) * 2))
#define AT_VF(i, dst) do { const LAS unsigned char* vb_ = VT + ((((i) & 7) & 1) ? vlo1 : vlo0) + (16 * ((i) & 7)) * AT_VS; const LAS unsigned char* vc_ = VT + ((((i) & 7) & 1) ? vhi1 : vhi0) + (16 * ((i) & 7)) * AT_VS; \
                const u32x2 v0_ = *(const LAS u32x2*)(vb_ + ((32 * ((i) >> 3)) ^ ((8 * ((i) & 7)) & 48)) * 2), v1_ = *(const LAS u32x2*)(vc_ + ((32 * ((i) >> 3) + 16) ^ ((8 * ((i) & 7)) & 48)) * 2); \
                dst = __builtin_bit_cast(bf16x8, (u32x4){v0_.x, v0_.y, v1_.x, v1_.y}); } while (0)
#define AT_QK(M0, M1) \
            f32x4 accS[4][2]; \
            _Pragma("unroll") for (int n = 0; n < 4; ++n) _Pragma("unroll") for (int m = M0; m < M1; ++m) accS[n][m] = (f32x4){0.f, 0.f, 0.f, 0.f}; \
            bf16x8 kf[2][4]; \
            _Pragma("unroll") for (int n = 0; n < 4; ++n) kf[0][n] = AT_KF(n, 0); \
            __builtin_amdgcn_s_setprio(1); \
            _Pragma("unroll") for (int ks = 0; ks < 4; ++ks) { \
                if (ks < 3) { _Pragma("unroll") for (int n = 0; n < 4; ++n) kf[(ks + 1) & 1][n] = AT_KF(n, ks + 1); } \
                __builtin_amdgcn_sched_barrier(0); \
                _Pragma("unroll") for (int n = 0; n < 4; ++n) _Pragma("unroll") for (int m = M0; m < M1; ++m) accS[n][m] = __builtin_amdgcn_mfma_f32_16x16x32_bf16(kf[ks & 1][n], qf[m][ks], accS[n][m], 0, 0, 0); \
                __builtin_amdgcn_sched_barrier(0); } \
            __builtin_amdgcn_s_setprio(0);
#define AT_VPRE() \
            if (ABL != 2) { _Pragma("unroll") for (int i = 0; i < 3; ++i) AT_VF(i, vq[i]); }     \
            __builtin_amdgcn_sched_barrier(0);
#define AT_SMX(M0, M1) \
            if (mt != 0) {   \
                _Pragma("unroll") for (int m = M0; m < M1; ++m) { const int ii = half * 32 + 16 * m + fr; \
                    _Pragma("unroll") for (int n = 0; n < 4; ++n) _Pragma("unroll") for (int r = 0; r < 4; ++r) { const int jj = 16 * n + 4 * g + r; const bool ok = (mt < 0) ? (jj >= ii) : (jj <= ii); if (!ok) accS[n][m][r] = -1e30f; } } } \
            _Pragma("unroll") for (int m = M0; m < M1; ++m) { \
                if (ABL == 0) { \
                    float mx = __builtin_fmaxf(__builtin_fmaxf(accS[0][m][0], accS[0][m][1]), __builtin_fmaxf(accS[0][m][2], accS[0][m][3])); \
                    _Pragma("unroll") for (int n = 1; n < 4; ++n) { mx = __builtin_fmaxf(__builtin_fmaxf(mx, accS[n][m][0]), accS[n][m][1]); mx = __builtin_fmaxf(__builtin_fmaxf(mx, accS[n][m][2]), accS[n][m][3]); } \
                    mx = row_max(mx); \
                    const float mn = __any(mx > mrun[m] + 8.0f) ? fmaxf(mrun[m], mx) : mrun[m];     \
                    const float alpha = __builtin_amdgcn_exp2f(mrun[m] - mn); mrun[m] = mn; \
                    f32x4 ps4 = (f32x4){0.f, 0.f, 0.f, 0.f}; \
                    _Pragma("unroll") for (int n = 0; n < 4; ++n) { const f32x4 d = accS[n][m] - mn; f32x4 pv; \
                        pv[0] = __builtin_amdgcn_exp2f(d[0]); pv[1] = __builtin_amdgcn_exp2f(d[1]); pv[2] = __builtin_amdgcn_exp2f(d[2]); pv[3] = __builtin_amdgcn_exp2f(d[3]); \
                        accS[n][m] = pv; ps4 += pv; } \
                    lpart[m] = lpart[m] * alpha + ((ps4[0] + ps4[1]) + (ps4[2] + ps4[3])); \
                    if (!__all(alpha == 1.0f)) { _Pragma("unroll") for (int n = 0; n < 8; ++n) accO[n][m] *= alpha; } \
                } \
                _Pragma("unroll") for (int s = 0; s < 2; ++s) { u32x4 t; t.x = pk_bf16(accS[2 * s][m][0], accS[2 * s][m][1]); t.y = pk_bf16(accS[2 * s][m][2], accS[2 * s][m][3]); \
                    t.z = pk_bf16(accS[2 * s + 1][m][0], accS[2 * s + 1][m][1]); t.w = pk_bf16(accS[2 * s + 1][m][2], accS[2 * s + 1][m][3]); pf[m][s] = __builtin_bit_cast(bf16x8, t); } }
#define AT_PVX(M0, M1) \
            __builtin_amdgcn_sched_barrier(0); \
            __builtin_amdgcn_s_setprio(1); \
            if (ABL != 2) { _Pragma("unroll") for (int i = 0; i < 16; ++i) { \
                if (i + 3 < 16) AT_VF(i + 3, vq[(i + 3) % 6]);     \
                __builtin_amdgcn_sched_barrier(0); \
                _Pragma("unroll") for (int m = M0; m < M1; ++m) accO[i & 7][m] = __builtin_amdgcn_mfma_f32_16x16x32_bf16(vq[i % 6], pf[m][i >> 3], accO[i & 7][m], 0, 0, 0); \
                __builtin_amdgcn_sched_barrier(0); } } \
            __builtin_amdgcn_s_setprio(0);
            bf16x8 vq[6];
            if (ORD == 0) { AT_QK(0, 2); AT_VPRE(); AT_SMX(0, 2); AT_PVX(0, 2); }
            else {
                { LAS unsigned char* VT = VTp; AT_VPRE(); AT_PVX(0, 2); }
                AT_QK(0, 2); AT_SMX(0, 2);
                VTp = VT; }
            if (nidx >= 9) goto at_done;
            const int sn = (st == 2) ? 0 : st + 1;
            AT_WRITE(sn, par ^ 1);
            int n3 = (n2 < 9) ? n2 + 1 : 9, n3row = 0, n3mt = 0;
            while (n3 < 9 && !attn_tile(n3, b, qb, n3row, n3mt)) ++n3;
            if (n3 < 9) AT_LOAD(n3row, par ^ 1);
            __syncthreads();
            st = sn; mt = nmt; nidx = n2; nmt = n2mt; n2 = n3; n2mt = n3mt;
          }
        }
        at_done:
        if (ORD) { bf16x8 vq[6]; LAS unsigned char* VT = VTp; AT_VPRE(); AT_PVX(0, 2); }
#undef AT_QK
#undef AT_VPRE
#undef AT_SMX
#undef AT_PVX
#undef AT_VF
#undef AT_KF
#undef AT_LOAD
#undef AT_WRITE
#pragma unroll
        for (int m = 0; m < 2; ++m) {
            const float l = row_sum(lpart[m]), inv = 1.0f / l;
            bf16* op = O + (size_t)(r0 + 16 * m + fr) * DM + head * 128 + 4 * g; float ss = 0.f;
#pragma unroll
            for (int n = 0; n < 8; ++n) { const f32x4 o = accO[n][m] * inv; ss += (o[0] * o[0] + o[1] * o[1]) + (o[2] * o[2] + o[3] * o[3]);
                u32x2 t; t.x = pk_bf16(o[0], o[1]); t.y = pk_bf16(o[2], o[3]); *(u32x2*)(op + 16 * n) = t; }
            ss = row_sum(ss);
            if (g == 0 && doatom) __hip_atomic_fetch_add(SSA + r0 + 16 * m + fr, ss, __ATOMIC_RELAXED, __HIP_MEMORY_SCOPE_AGENT);
        }
    }
}
template <int ABL = 0>
__device__ __forceinline__ void p6_attn(Fr& F, bool doatom = true) {
    for (int u = F.bid; u < 1024; u += F.G) { if (AT_DEPHASE && F.wave < 4) attn_unit<ABL, 1>(F, u, doatom); else attn_unit<ABL, 0>(F, u, doatom); }
    __syncthreads();
}
__device__ __forceinline__ void chunk_scan(const float* dtp  , float a, bool rev, int lane, int& t0, int& t1, float& d0, float& d1, float& c0, float& c1, float& total) {
    t0 = rev ? 127 - 2 * lane : 2 * lane; t1 = rev ? 126 - 2 * lane : 2 * lane + 1;
    d0 = dtp[(size_t)t0 * 32]; d1 = dtp[(size_t)t1 * 32];
    const float v0 = d0 * a, v1 = d1 * a; float s = v0 + v1;
#pragma unroll
    for (int o = 1; o < 64; o <<= 1) { const float t = __shfl_up(s, o); if (lane >= o) s += t; }
    const float ex = s - (v0 + v1); c0 = ex + v0; c1 = s; total = __shfl(s, 63);
}
constexpr int SS = 272;
__device__ __forceinline__ int sc_row0(int sc) { return sc < 128 ? sc * 128 : NLAT + (sc - 128) * 128; }

__device__ __forceinline__ void p7_states(Fr& F) {
    const bf16* XC = WSP(bf16, WS_XC); bf16* SL = WSP(bf16, WS_SLOC); float* DEC = WSP(float, WS_DEC);
    const int fr = F.lane & 15, g4 = F.lane >> 4, w = F.wave;
    LAS unsigned char* BT = F.lds; LAS unsigned char* XTf = F.lds + 34816; LAS unsigned char* XTb = F.lds + 52224; LAS float* WF = (LAS float*)(F.lds + 69632); LAS float* WB = WF + 8 * 128;
    const int sj = F.tid >> 2, sps = (F.tid & 3) * 16;
    for (int u = F.bid; u < 512 + 64; u += F.G) {
        const int uq = u - 512;
        const int grp = (u < 512) ? (u & 3) : ((uq >> 2) & 3), sc = (u < 512) ? (u >> 2) : (128 + (uq >> 4)), m0 = sc_row0(sc);
        const int h_lo = (u < 512) ? 0 : (uq & 3) * 2, h_hi = (u < 512) ? 8 : h_lo + 2;
        __syncthreads();
        { const int ns = (F.tid & 3) * 32; const bf16* bp = XC + (size_t)(m0 + sj) * XBCW + 2048 + grp * 128 + ns;
#pragma unroll
          for (int q = 0; q < 4; ++q) { const u32x4 v = *(const u32x4*)(bp + 8 * q); const unsigned vw[4] = {v.x, v.y, v.z, v.w};
#pragma unroll
              for (int e = 0; e < 4; ++e) { *(LAS unsigned short*)(BT + (ns + 8 * q + 2 * e) * SS + sj * 2) = (unsigned short)(vw[e] & 0xffffu); *(LAS unsigned short*)(BT + (ns + 8 * q + 2 * e + 1) * SS + sj * 2) = (unsigned short)(vw[e] >> 16); } } }
        if (w >= h_lo && w < h_hi) { const int h = grp * 8 + w;
#pragma unroll
          for (int dir = 0; dir < 2; ++dir) { const float a = -__expf(F.in[16][dir * 32 + h]); int t0, t1; float d0, d1, c0, c1, tot;
              chunk_scan(WSP(float, dir ? WS_DTB : WS_DTF) + (size_t)m0 * 32 + h, a, dir == 1, F.lane, t0, t1, d0, d1, c0, c1, tot);
              LAS float* wa = (dir ? WB : WF) + w * 128; wa[t0] = __expf(tot - c0) * d0; wa[t1] = __expf(tot - c1) * d1;
              if (F.lane == 0) DEC[(sc * 2 + dir) * 32 + h] = __expf(tot); } }
        u32x4 xr[2];
        { const bf16* xp = XC + (size_t)(m0 + sj) * XBCW + (grp * 8 + h_lo) * 64 + sps; xr[0] = *(const u32x4*)xp; xr[1] = *(const u32x4*)(xp + 8); }
        __syncthreads();
        for (int hh = h_lo; hh < h_hi; ++hh) {
            const int h = grp * 8 + hh;
            { const float wf = WF[hh * 128 + sj], wb = WB[hh * 128 + sj];
#pragma unroll
              for (int q = 0; q < 2; ++q) { float f[8]; unpack8(xr[q], f);
#pragma unroll
                  for (int e = 0; e < 8; ++e) { *(LAS unsigned short*)(XTf + (sps + 8 * q + e) * SS + sj * 2) = f2bf(f[e] * wf); *(LAS unsigned short*)(XTb + (sps + 8 * q + e) * SS + sj * 2) = f2bf(f[e] * wb); } } }
            __syncthreads();
            if (hh < h_hi - 1) { const bf16* xp = XC + (size_t)(m0 + sj) * XBCW + (h + 1) * 64 + sps; xr[0] = *(const u32x4*)xp; xr[1] = *(const u32x4*)(xp + 8); }
            const int pt = w & 3, ntb = (w >> 2) * 4;
            f32x4 aF[4], aB[4];
#pragma unroll
            for (int n = 0; n < 4; ++n) { aF[n] = (f32x4){0.f, 0.f, 0.f, 0.f}; aB[n] = (f32x4){0.f, 0.f, 0.f, 0.f}; }
#pragma unroll
            for (int ks = 0; ks < 4; ++ks) {
                const bf16x8 xf = *(const LAS bf16x8*)(XTf + (16 * pt + fr) * SS + (32 * ks + 8 * g4) * 2), xb = *(const LAS bf16x8*)(XTb + (16 * pt + fr) * SS + (32 * ks + 8 * g4) * 2);
#pragma unroll
                for (int n = 0; n < 4; ++n) { const bf16x8 bt = *(const LAS bf16x8*)(BT + (16 * (ntb + n) + fr) * SS + (32 * ks + 8 * g4) * 2);
                    aF[n] = __builtin_amdgcn_mfma_f32_16x16x32_bf16(bt, xf, aF[n], 0, 0, 0); aB[n] = __builtin_amdgcn_mfma_f32_16x16x32_bf16(bt, xb, aB[n], 0, 0, 0); }
            }
            bf16* sf = SL + ((size_t)(sc * 2 + 0) * 32 + h) * 8192 + (16 * pt + fr) * 128 + 4 * g4; bf16* sb = SL + ((size_t)(sc * 2 + 1) * 32 + h) * 8192 + (16 * pt + fr) * 128 + 4 * g4;
#pragma unroll
            for (int n = 0; n < 4; ++n) { u32x2 o; o.x = pk_bf16(aF[n][0], aF[n][1]); o.y = pk_bf16(aF[n][2], aF[n][3]); *(u32x2*)(sf + 16 * (ntb + n)) = o;
                o.x = pk_bf16(aB[n][0], aB[n][1]); o.y = pk_bf16(aB[n][2], aB[n][3]); *(u32x2*)(sb + 16 * (ntb + n)) = o; }
            __syncthreads();
        }
    }
}

__device__ __forceinline__ void p8_scan(Fr& F) {
    const bf16* SL = WSP(bf16, WS_SLOC); const float* DEC = WSP(float, WS_DEC); bf16* HIN = WSP(bf16, WS_HIN);
    for (int e = F.bid * NTHR + F.tid; e < 2 * 2 * 32 * 1024; e += F.G * NTHR) {
        const int el = (e & 1023) * 8, h = (e >> 10) & 31, dir = (e >> 15) & 1, b = e >> 16;
        const int sA = 128 + 2 * b + (dir ? 1 : 0), sB = 128 + 2 * b + (dir ? 0 : 1);
        float fa[8], fb[8], hc[8];
        unpack8(*(const u32x4*)(SL + ((size_t)(sA * 2 + dir) * 32 + h) * 8192 + el), fa); unpack8(*(const u32x4*)(SL + ((size_t)(sB * 2 + dir) * 32 + h) * 8192 + el), fb);
        const float db = DEC[(sB * 2 + dir) * 32 + h];
#pragma unroll
        for (int q = 0; q < 8; ++q) hc[q] = fb[q] + db * fa[q];
        u32x4 qs[8]; float qd[8];
#define P8_LD(cc_, slot_) do { const int c_ = dir ? 63 - (cc_) : (cc_), sc_ = b * 64 + c_; qs[slot_] = *(const u32x4*)(SL + ((size_t)(sc_ * 2 + dir) * 32 + h) * 8192 + el); qd[slot_] = DEC[(sc_ * 2 + dir) * 32 + h]; } while (0)
#pragma unroll
        for (int i = 0; i < 8; ++i) P8_LD(i, i);
        for (int cb = 0; cb < 64; cb += 8)
#pragma unroll
        for (int j = 0; j < 8; ++j) { const int cc = cb + j;
            const int c = dir ? 63 - cc : cc, sc = b * 64 + c; const size_t off = ((size_t)(sc * 2 + dir) * 32 + h) * 8192 + el;
            float s[8]; unpack8(qs[j], s); const float d = qd[j];
            if (cc + 8 < 64) P8_LD(cc + 8, j);
            u32x4 o; o.x = pk_bf16(hc[0], hc[1]); o.y = pk_bf16(hc[2], hc[3]); o.z = pk_bf16(hc[4], hc[5]); o.w = pk_bf16(hc[6], hc[7]);
            *(u32x4*)(HIN + off) = o;
#pragma unroll
            for (int q = 0; q < 8; ++q) hc[q] = d * hc[q] + s[q];
        }
#undef P8_LD
    }
}

__device__ __forceinline__ void p9_ssd_out(Fr& F, bool doatom = true) {
    const bf16* XC = WSP(bf16, WS_XC); const bf16* P = WSP(bf16, WS_P); const bf16* HIN = WSP(bf16, WS_HIN); bf16* YS = WSP(bf16, WS_H) + 2048; float* SSS = WSP(float, WS_ROWSS) + NLAT;
    const int fr = F.lane & 15, g4 = F.lane >> 4, w = F.wave;
    LAS unsigned char* Cs = F.lds; LAS unsigned char* Bm = F.lds + 34816;
    LAS unsigned char* XT = F.lds + 34816; LAS unsigned char* Hf = F.lds + 52224; LAS unsigned char* Hb = F.lds + 69632;
    LAS float* ACF = (LAS float*)(F.lds + 87040); LAS float* ACB = ACF + 1024; LAS float* DFA = ACF + 2048; LAS float* DBA = ACF + 3072;
    const int sj = F.tid >> 2, sps = (F.tid & 3) * 16, hp = F.tid >> 3, hn0 = (F.tid & 7) * 16;
    for (int u = F.bid; u < 512; u += F.G) {
        const int grp = u & 3, sc = u >> 2, m0 = sc * 128;
        __syncthreads();
        { const int ns = (F.tid & 3) * 32; const bf16* bp = XC + (size_t)(m0 + sj) * XBCW + 2048 + grp * 128 + ns; const bf16* cp = bp + 512;
#pragma unroll
          for (int q = 0; q < 4; ++q) { *(LAS u32x4*)(Bm + sj * SS + (ns + 8 * q) * 2) = *(const u32x4*)(bp + 8 * q); *(LAS u32x4*)(Cs + sj * SS + (ns + 8 * q) * 2) = *(const u32x4*)(cp + 8 * q); } }
        { const int h = grp * 8 + w;
#pragma unroll
          for (int dir = 0; dir < 2; ++dir) { const float a = -__expf(F.in[16][dir * 32 + h]); int t0, t1; float d0, d1, c0, c1, tot;
              chunk_scan(WSP(float, dir ? WS_DTB : WS_DTF) + (size_t)m0 * 32 + h, a, dir == 1, F.lane, t0, t1, d0, d1, c0, c1, tot);
              LAS float* ca = (dir ? ACB : ACF) + w * 128; LAS float* da = (dir ? DBA : DFA) + w * 128; ca[t0] = c0; ca[t1] = c1; da[t0] = d0; da[t1] = d1; } }
        __syncthreads();
        bf16x8 cfr[4]; f32x4 G[8];
#pragma unroll
        for (int ks = 0; ks < 4; ++ks) cfr[ks] = *(const LAS bf16x8*)(Cs + (16 * w + fr) * SS + (32 * ks + 8 * g4) * 2);
#pragma unroll
        for (int n = 0; n < 8; ++n) { G[n] = (f32x4){0.f, 0.f, 0.f, 0.f};
#pragma unroll
            for (int ks = 0; ks < 4; ++ks) { const bf16x8 bf = *(const LAS bf16x8*)(Bm + (16 * n + fr) * SS + (32 * ks + 8 * g4) * 2); G[n] = __builtin_amdgcn_mfma_f32_16x16x32_bf16(bf, cfr[ks], G[n], 0, 0, 0); } }
        const int i = 16 * w + fr;
        float rowss = 0.f;
        u32x4 xr[2], hfr[2], hbr[2];
        { const int h = grp * 8; const bf16* xp = XC + (size_t)(m0 + sj) * XBCW + h * 64 + sps; xr[0] = *(const u32x4*)xp; xr[1] = *(const u32x4*)(xp + 8);
          const bf16* hf = HIN + ((size_t)(sc * 2 + 0) * 32 + h) * 8192 + hp * 128 + hn0; const bf16* hb = HIN + ((size_t)(sc * 2 + 1) * 32 + h) * 8192 + hp * 128 + hn0;
          hfr[0] = *(const u32x4*)hf; hfr[1] = *(const u32x4*)(hf + 8); hbr[0] = *(const u32x4*)hb; hbr[1] = *(const u32x4*)(hb + 8); }
        u32x2 zn[4];
#define P9_ZLD(hd) do { _Pragma("unroll") for (int pt = 0; pt < 4; ++pt) zn[pt] = *(const u32x2*)(P + (size_t)(m0 + i) * NINP + PZ + (grp * 8 + (hd)) * 64 + 16 * pt + 4 * g4); } while (0)
        P9_ZLD(0);
        __syncthreads();
        for (int hh = 0; hh < 8; ++hh) {
            const int h = grp * 8 + hh;
            {
#pragma unroll
              for (int q = 0; q < 2; ++q) { const unsigned vw[4] = {xr[q].x, xr[q].y, xr[q].z, xr[q].w};
#pragma unroll
                  for (int e = 0; e < 4; ++e) { *(LAS unsigned short*)(XT + (sps + 8 * q + 2 * e) * SS + sj * 2) = (unsigned short)(vw[e] & 0xffffu); *(LAS unsigned short*)(XT + (sps + 8 * q + 2 * e + 1) * SS + sj * 2) = (unsigned short)(vw[e] >> 16); } }
              *(LAS u32x4*)(Hf + hp * SS + hn0 * 2) = hfr[0]; *(LAS u32x4*)(Hf + hp * SS + hn0 * 2 + 16) = hfr[1];
              *(LAS u32x4*)(Hb + hp * SS + hn0 * 2) = hbr[0]; *(LAS u32x4*)(Hb + hp * SS + hn0 * 2 + 16) = hbr[1]; }
            __syncthreads();
            if (hh < 7) { const bf16* xp = XC + (size_t)(m0 + sj) * XBCW + (h + 1) * 64 + sps; xr[0] = *(const u32x4*)xp; xr[1] = *(const u32x4*)(xp + 8);
                const bf16* hf = HIN + ((size_t)(sc * 2 + 0) * 32 + h + 1) * 8192 + hp * 128 + hn0; const bf16* hb = HIN + ((size_t)(sc * 2 + 1) * 32 + h + 1) * 8192 + hp * 128 + hn0;
                hfr[0] = *(const u32x4*)hf; hfr[1] = *(const u32x4*)(hf + 8); hbr[0] = *(const u32x4*)hb; hbr[1] = *(const u32x4*)(hb + 8); }
            bf16x8 xq[2], hfq[2], hbq[2];
#define P9_LD(st_) do { const int pt_ = (st_) >> 2, s_ = (st_) & 3; \
                const u32x2 v0_ = *(const LAS u32x2*)(XT + (16 * pt_ + fr) * SS + (32 * s_ + 4 * g4) * 2), v1_ = *(const LAS u32x2*)(XT + (16 * pt_ + fr) * SS + (32 * s_ + 16 + 4 * g4) * 2); \
                xq[(st_) & 1] = __builtin_bit_cast(bf16x8, (u32x4){v0_.x, v0_.y, v1_.x, v1_.y}); \
                hfq[(st_) & 1] = *(const LAS bf16x8*)(Hf + (16 * pt_ + fr) * SS + (32 * s_ + 8 * g4) * 2); hbq[(st_) & 1] = *(const LAS bf16x8*)(Hb + (16 * pt_ + fr) * SS + (32 * s_ + 8 * g4) * 2); } while (0)
            u32x2 zv[4];
#pragma unroll
            for (int pt = 0; pt < 4; ++pt) zv[pt] = zn[pt];
            if (hh < 7) P9_ZLD(hh + 1);
            const LAS float* acf = ACF + hh * 128; const LAS float* acb = ACB + hh * 128; const LAS float* dfa = DFA + hh * 128; const LAS float* dba = DBA + hh * 128;
            const float aif = acf[i], aib = acb[i];
            bf16x8 pf[4];
#pragma unroll
            for (int s = 0; s < 4; ++s) { unsigned pw[4];
#pragma unroll
                for (int t = 0; t < 2; ++t) { const int n = 2 * s + t, j0 = 16 * n + 4 * g4;
                    float gw[4];
                    if (n < w) {
                        const f32x4 cf = *(const LAS f32x4*)(acf + j0), df = *(const LAS f32x4*)(dfa + j0);
#pragma unroll
                        for (int r = 0; r < 4; ++r) gw[r] = G[n][r] * (__expf(aif - cf[r]) * df[r]);
                    } else if (n > w) {
                        const f32x4 cb = *(const LAS f32x4*)(acb + j0), db = *(const LAS f32x4*)(dba + j0);
#pragma unroll
                        for (int r = 0; r < 4; ++r) gw[r] = G[n][r] * (__expf(aib - cb[r]) * db[r]);
                    } else {
                        const f32x4 cf = *(const LAS f32x4*)(acf + j0), cb = *(const LAS f32x4*)(acb + j0), df = *(const LAS f32x4*)(dfa + j0), db = *(const LAS f32x4*)(dba + j0);
#pragma unroll
                        for (int r = 0; r < 4; ++r) { const int j = j0 + r;
                            const float wf = (j <= i) ? __expf(aif - cf[r]) * df[r] : 0.f, wb = (j >= i) ? __expf(aib - cb[r]) * db[r] : 0.f;
                            gw[r] = G[n][r] * (wf + wb); }
                    }
                    pw[2 * t] = pk_bf16(gw[0], gw[1]); pw[2 * t + 1] = pk_bf16(gw[2], gw[3]); }
                pf[s] = __builtin_bit_cast(bf16x8, (u32x4){pw[0], pw[1], pw[2], pw[3]}); }
            const float ef = __expf(aif), eb = __expf(aib), dsk = F.in[18][h];
#pragma unroll
            for (int hf2 = 0; hf2 < 2; ++hf2) {
                f32x4 aY[2], aF[2], aB[2];
#pragma unroll
                for (int q = 0; q < 2; ++q) { aY[q] = (f32x4){0.f, 0.f, 0.f, 0.f}; aF[q] = aY[q]; aB[q] = aY[q]; }
                P9_LD(8 * hf2);
                __builtin_amdgcn_s_setprio(1);
#pragma unroll
                for (int st = 8 * hf2; st < 8 * hf2 + 8; ++st) {
                    if (st + 1 < 8 * hf2 + 8) P9_LD(st + 1);
                    __builtin_amdgcn_sched_barrier(0);
                    aY[(st >> 2) & 1] = __builtin_amdgcn_mfma_f32_16x16x32_bf16(xq[st & 1], pf[st & 3], aY[(st >> 2) & 1], 0, 0, 0);
                    aF[(st >> 2) & 1] = __builtin_amdgcn_mfma_f32_16x16x32_bf16(hfq[st & 1], cfr[st & 3], aF[(st >> 2) & 1], 0, 0, 0); aB[(st >> 2) & 1] = __builtin_amdgcn_mfma_f32_16x16x32_bf16(hbq[st & 1], cfr[st & 3], aB[(st >> 2) & 1], 0, 0, 0);
                    __builtin_amdgcn_sched_barrier(0);
                }
                __builtin_amdgcn_s_setprio(0);
#pragma unroll
                for (int q = 0; q < 2; ++q) { const int pt = 2 * hf2 + q, col = h * 64 + 16 * pt + 4 * g4;
                    const LAS unsigned char* xtp = XT + (16 * pt + 4 * g4) * SS + i * 2;
                    const float x4[4] = {__uint_as_float((unsigned)*(const LAS unsigned short*)xtp << 16), __uint_as_float((unsigned)*(const LAS unsigned short*)(xtp + SS) << 16),
                                         __uint_as_float((unsigned)*(const LAS unsigned short*)(xtp + 2 * SS) << 16), __uint_as_float((unsigned)*(const LAS unsigned short*)(xtp + 3 * SS) << 16)};
                    const float z4[4] = {bf_lo(zv[pt].x), bf_hi(zv[pt].x), bf_lo(zv[pt].y), bf_hi(zv[pt].y)};
                    float y4[4];
#pragma unroll
                    for (int r = 0; r < 4; ++r) { y4[r] = (aY[q][r] + ef * aF[q][r] + eb * aB[q][r] + dsk * x4[r]) * silu_f(z4[r]); rowss += y4[r] * y4[r]; }
                    u32x2 o; o.x = pk_bf16(y4[0], y4[1]); o.y = pk_bf16(y4[2], y4[3]); *(u32x2*)(YS + (size_t)(m0 + i) * DM + col) = o; }
            }
#undef P9_LD
#undef P9_ZLD
            __syncthreads();
        }
        rowss = row_sum(rowss);
        if (g4 == 0 && doatom) __hip_atomic_fetch_add(SSS + m0 + i, rowss, __ATOMIC_RELAXED, __HIP_MEMORY_SCOPE_AGENT);
    }
}
#ifndef MK_PER_PHASE
#define MK_PER_PHASE 0
#endif
constexpr int N_PHASES = 16;
#ifndef WGM_DOWN
#define WGM_DOWN 2
#endif
#ifndef PROBE_MASK
#define PROBE_MASK 0
#endif
#define REP(k) _Pragma("unroll") for (int _rep = 0; _rep < (((PROBE_MASK >> (k)) & 1) ? 2 : 1); ++_rep)
struct Args { const float* in[21]; float* out; unsigned char* ws; int ph_lo, ph_hi, li, pad; };
__global__ void __launch_bounds__(NTHR, 2) fwd(Args args) {
    extern __shared__ __attribute__((aligned(16))) unsigned char lds_raw[];
    Fr F;
    F.lds = (LAS unsigned char*)lds_raw;
    F.tid = threadIdx.x; F.lane = F.tid & 63; F.wave = __builtin_amdgcn_readfirstlane(F.tid >> 6);
    F.G = gridDim.x; F.bid = blockIdx.x;
#pragma unroll
    for (int i = 0; i < 21; ++i) F.in[i] = args.in[i];
    F.out = args.out; F.ws = args.ws;
    volatile LAS unsigned* MISC = (volatile LAS unsigned*)(F.lds + MISC_OFF);
    if (F.tid < 32) MISC[F.tid] = 0u;
    __syncthreads();
    unsigned* ctl = (unsigned*)(F.ws + WS_CTL);
    XcdBarrier bar = xcd_barrier_post(ctl + CW_BAR + args.li * XCD_BAR_WORDS, MISC + 8);
    const int lo = args.ph_lo, hi = args.ph_hi;
#define IN(k) (lo <= (k) && (k) < hi)
#define SEAM(k) do { if (IN(k) && IN((k) + 1)) xcd_barrier(bar); } while (0)
    LAS unsigned char* ring = F.lds;

    if (IN(0)) REP(0) { p0_prologue(F, _rep); } SEAM(0);
    if (IN(1)) REP(1) { p1_norm(F); } SEAM(1);
    if (IN(2)) REP(2) {
        pg8::Gemm g{WSP(bf16, WS_H), WSP(bf16, WS_WGU0), MROWS, NGU, DM}; pg8::HalfNOrder S; S.init(MROWS, F.G, F.bid);
        pg8::EpiSwiGLU E{WSP(bf16, WS_ACT), FF};
        pg8::gemm_phase<pg8::EpiSwiGLU, pg8::HalfNOrder, true, true>(ring, g, S, E);
        if (_rep == 0) conv_queue(F, CW_Q2, CV_Q2_LO, CV_Q2_HI);
    } SEAM(2);
    if (IN(3)) REP(3) {
        pg8::Gemm g{WSP(bf16, WS_ACT), WSP(bf16, WS_WD0), MROWS, DM, FF};
        { pg8::StaticOrder S; S.init(NLAT, DM, FF, F.G, F.bid, WGM_DOWN); pg8::EpiPlain E{WSP(bf16, WS_Y), DM};
          pg8::gemm_phase<pg8::EpiPlain, pg8::StaticOrder, true, true>(ring, g, S, E); }
        { pg8::CtxSplitOrder S; S.init(F.G, F.bid); pg8::EpiSplitF32 E{WSP(float, WS_YCP), DM};
          pg8::gemm_phase<pg8::EpiSplitF32, pg8::CtxSplitOrder, true, true>(ring, g, S, E); }
    } SEAM(3);
    if (IN(4)) REP(4) { p4_resnorm(F); } SEAM(4);
    if (IN(5)) REP(5) {
        pg8::Gemm g{WSP(bf16, WS_H), WSP(bf16, WS_WIN), MROWS, NINP, DM}; pg8::InProjOrder S; S.init(F.G, F.bid);
        pg8::EpiInProj E{WSP(bf16, WS_P), NINP, WSP(float, WS_DTF), WSP(float, WS_DTB), WSP(float, WS_ROPE), WSP(float, WS_ROPE) + 4096, F.in[17], QSCALE};
        pg8::gemm_phase<pg8::EpiInProj, pg8::InProjOrder, true, true>(ring, g, S, E);
        if (_rep == 0) conv_queue(F, CW_Q5, CV_Q5_LO, CV_Q5_HI);
    } SEAM(5);
    #ifndef PROBE_ATT
#define PROBE_ATT -1
#endif
    if (IN(6)) { p6_attn<0>(F, true); if (PROBE_ATT >= 0) { p6_attn<(PROBE_ATT < 0 ? 0 : PROBE_ATT)>(F, false); } p6_conv(F); } SEAM(6);
    if (IN(7)) REP(7) { p7_states(F); } SEAM(7);
    if (IN(8)) REP(8) { p8_scan(F); } SEAM(8);
    if (IN(9)) REP(9) { p9_ssd_out(F, _rep == 0); } SEAM(9);
    if (IN(11)) REP(11) {
        pg8::Gemm g{WSP(bf16, WS_H), WSP(bf16, WS_WOUT), NLAT, DM, DM}; pg8::OutProjOrder S; S.init(F.G, F.bid);
        LAS float* qt = (LAS float*)(F.lds + RING_BYTES + 1024);
        { const float* ssa = WSP(float, WS_ROWSS); const float* sss = ssa + NLAT;
          for (int e = F.tid; e < 1024; e += NTHR) { pg8::Unit u; if (S.t.next(e >> 8, u)) { const int r = u.pm * 256 + (e & 255);
              qt[e] = sqrtf((sss[r] * (1.0f / 2048.f) + EPS) / (ssa[r] * (1.0f / 2048.f) + EPS)); } }
          __syncthreads(); }
        pg8::EpiOutProj E{WSP(bf16, WS_Y), DM, qt};
        pg8::gemm_phase<pg8::EpiOutProj, pg8::OutProjOrder, true, true, false, true>(ring, g, S, E);
#ifdef PROBE_ZEROB
        xcd_barrier(bar);
        { bf16* zb = WSP(bf16, WS_HIN);
          if (PROBE_ZEROB) { for (size_t e = (size_t)F.bid * NTHR + F.tid; e < (size_t)DM * DM / 8; e += (size_t)F.G * NTHR) ((u32x4*)zb)[e] = (u32x4){0u, 0u, 0u, 0u}; }
          xcd_barrier(bar);
          pg8::Gemm g2{WSP(bf16, WS_H), PROBE_ZEROB ? zb : WSP(bf16, WS_WOUT), NLAT, DM, DM}; pg8::StaticOrder S2; S2.init(NLAT, DM, DM, F.G, F.bid);
          pg8::EpiPlain E2{WSP(bf16, WS_SLOC), DM};
          pg8::gemm_phase<pg8::EpiPlain, pg8::StaticOrder, true, true>(ring, g2, S2, E2); }
#endif
    } SEAM(11);
    if (IN(12)) REP(12) { p12_resnorm(F); } SEAM(12);
    if (IN(13)) REP(13) {
        pg8::Gemm g{WSP(bf16, WS_H), WSP(bf16, WS_WGU1), NLAT, NGU, DM}; pg8::HalfNOrder S; S.init(NLAT, F.G, F.bid);
        pg8::EpiSwiGLU8 E{WSP(unsigned char, WS_ACT), FF};
        pg8::gemm_phase<pg8::EpiSwiGLU8, pg8::HalfNOrder, true, true>(ring, g, S, E);
        if (_rep == 0) conv_queue(F, CW_Q13, CV_Q13_LO, CV_Q13_HI);
    } SEAM(13);
    if (IN(14)) REP(14) {
        pg8::Gemm g{WSP(bf16, WS_ACT), WSP(bf16, WS_WD1), NLAT, DM, FF / 2}; pg8::StaticOrder S; S.init(NLAT, DM, FF / 2, F.G, F.bid, WGM_DOWN);
        pg8::EpiPlainS E{WSP(bf16, WS_Y), DM, 1.0f / (8.0f * 2048.0f)};
        pg8::gemm_phase<pg8::EpiPlainS, pg8::StaticOrder, true, true, true>(ring, g, S, E);
    } SEAM(14);
    if (IN(15)) REP(15) { p15_final(F); }
#undef IN
#undef SEAM
}

extern "C" void kernel_launch(void* const* d_in, const int* in_sizes, int n_in, void* d_out, int out_size, void* d_ws, size_t ws_size, hipStream_t stream) {
    static int grid = 0;
    if (grid == 0) {
        if (n_in != 21 || in_sizes[0] != NLAT * DM || out_size != NLAT * DM || ws_size < WS_END) {
            fprintf(stderr, "kernel_launch: unexpected problem (n_in %d, in0 %d, out %d, ws %zu, need %zu)\n", n_in, n_in > 0 ? in_sizes[0] : -1, out_size, ws_size, (size_t)WS_END); grid = -1; return; }
        int dev = 0, cus = 0, per_cu = 0;
        if (hipGetDevice(&dev) != hipSuccess || hipDeviceGetAttribute(&cus, hipDeviceAttributeMultiprocessorCount, dev) != hipSuccess) { grid = -1; return; }
        if (hipFuncSetAttribute((const void*)fwd, hipFuncAttributeMaxDynamicSharedMemorySize, LDS_BYTES) != hipSuccess) { fprintf(stderr, "kernel_launch: hipFuncSetAttribute failed\n"); grid = -1; return; }
        if (hipOccupancyMaxActiveBlocksPerMultiprocessor(&per_cu, (const void*)fwd, NTHR, LDS_BYTES) != hipSuccess || per_cu < 1)
            fprintf(stderr, "kernel_launch: note: occupancy query reports %d workgroups per CU\n", per_cu);
        (void)hipGetLastError();
        grid = cus;
    }
    if (grid < 0) return;
    if (hipMemsetAsync((char*)d_ws + WS_CTL, 0, ZERO_BYTES, stream) != hipSuccess) { fprintf(stderr, "kernel_launch: memset failed\n"); return; }
    Args a{};
    for (int i = 0; i < 21; ++i) a.in[i] = (const float*)d_in[i];
    a.out = (float*)d_out; a.ws = (unsigned char*)d_ws; a.pad = 0;
#if MK_PER_PHASE
    for (int ph = 0; ph < N_PHASES; ++ph) { a.ph_lo = ph; a.ph_hi = ph + 1; a.li = ph;
        hipLaunchKernelGGL(fwd, dim3(grid), dim3(NTHR), LDS_BYTES, stream, a); }
#else
    a.ph_lo = 0; a.ph_hi = N_PHASES; a.li = 0;
    hipLaunchKernelGGL(fwd, dim3(grid), dim3(NTHR), LDS_BYTES, stream, a);
#endif
    const hipError_t le = hipPeekAtLastError();
    if (le != hipSuccess) fprintf(stderr, "kernel_launch: launch failed: %s\n", hipGetErrorName(le));
}
```

```cpp
#define MK_PER_PHASE 0
#define PROBE_MASK 0
#define PROBE_P0T 1
#include <hip/hip_runtime.h>
#include <cstdio>
#include <cstdint>
namespace pg8 {
#define PG8_LAS __attribute__((address_space(3)))
typedef unsigned short bf16_t;
typedef short bf16x8 __attribute__((ext_vector_type(8)));
typedef float f32x4 __attribute__((ext_vector_type(4)));
typedef unsigned u32x4 __attribute__((ext_vector_type(4)));
constexpr int BM = 256, BK = 64, HALF = 128, HTB = HALF * BK * 2  , STAGE_BYTES = 8 * HTB, NXCD = 8, WGM = 4;

__host__ __device__ __forceinline__ int lds_byte(int r, int c) { const int st = (r >> 4) * 2 + (c >> 5), rr = r & 15, cc = c & 31, ob = rr * 64 + cc * 2; return st * 1024 + (ob ^ (((ob >> 9) & 1) << 5)); }
__host__ __device__ __forceinline__ void stage_rc(int b, int& R, int& C) { const int st = b / 1024, sb = b % 1024, swz = sb ^ (((sb >> 9) & 1) << 5); R = (st >> 1) * 16 + swz / 64; C = (st & 1) * 32 + (swz % 64) / 2; }
__host__ __device__ __forceinline__ int perm32(int rho) { const int n = rho >> 4, i = rho & 15; return 8 * (i >> 2) + 4 * n + (i & 3); }

struct Unit { int pm, pn, koff, nt, aux; };
struct Gemm { const bf16_t* A; const bf16_t* Bt; int M, N, K; };

struct StaticOrder {
    int nM, nN, nwg, G, c, nt, wgm;
    __host__ __device__ void init(int M, int N, int K, int G_, int c_, int wgm_ = WGM) { nM = M / BM; nN = N / BM; nwg = nM * nN; G = G_; c = c_; nt = K / BK; wgm = wgm_; }
    __host__ __device__ __forceinline__ bool next(int i, Unit& u) const {
        const long L = (long)i * G + c; if (L >= nwg) return false;
        int wgid = (int)L; { const int q = nwg / NXCD, r = nwg % NXCD, xcd = wgid % NXCD, off = wgid / NXCD; wgid = (xcd < r ? xcd * (q + 1) : r * (q + 1) + (xcd - r) * q) + off; }
        const int nig = wgm * nN, gid = wgid / nig, fm = gid * wgm, gsz = (nM - fm) < wgm ? (nM - fm) : wgm;
        u.pm = fm + ((wgid % nig) % gsz); u.pn = (wgid % nig) / gsz; u.koff = 0; u.nt = nt; u.aux = 0; return true;
    }
    __device__ __forceinline__ void a_ready(const Unit&) const {}
    __device__ __forceinline__ void done(const Unit&) const {}
};

__device__ __forceinline__ unsigned cvt_pk_bf16(float lo, float hi) { unsigned r; asm volatile("v_cvt_pk_bf16_f32 %0, %1, %2" : "=v"(r) : "v"(lo), "v"(hi)); return r; }
typedef float f32x2_t __attribute__((ext_vector_type(2))); typedef __bf16 bf16x2_t __attribute__((ext_vector_type(2)));
__device__ __forceinline__ unsigned pk_bf16(float lo, float hi) { const f32x2_t v = {lo, hi}; const bf16x2_t b = __builtin_convertvector(v, bf16x2_t); return __builtin_bit_cast(unsigned, b); }
#ifndef AQ_DROP
#define AQ_DROP 2
#endif
__device__ __forceinline__ float aquant(float v) {
    if (AQ_DROP == 0) return v;
    unsigned u = __builtin_bit_cast(unsigned, v); constexpr unsigned sh = 16 + AQ_DROP, half = (1u << (sh - 1)) - 1u;
    u = (u + half + ((u >> sh) & 1u)) & ~((1u << sh) - 1u); return __builtin_bit_cast(float, u);
}
__device__ __forceinline__ unsigned pk_bf16q(float lo, float hi) {
    if (AQ_DROP == 0) return pk_bf16(lo, hi);
    {
#pragma clang fp contract(off)
        const f32x2_t v = {lo, hi}; constexpr float K = (float)((1u << (16 + AQ_DROP)) + 1u);
        const f32x2_t c = v * K; const f32x2_t d = c - v; const f32x2_t h = c - d;
        return __builtin_bit_cast(unsigned, __builtin_convertvector(h, bf16x2_t));
    }
}
typedef _Float16 f16x2_t __attribute__((ext_vector_type(2)));
__device__ __forceinline__ unsigned pk_f16(float lo, float hi) { const f32x2_t v = {lo, hi}; return __builtin_bit_cast(unsigned, __builtin_convertvector(v, f16x2_t)); }
__device__ __forceinline__ float silu_f(float g) { return g * __builtin_amdgcn_rcpf(1.0f + __builtin_amdgcn_exp2f(-1.4426950408889634f * g)); }
template <bool S8>
__device__ __forceinline__ f32x2_t swiglu2(f32x2_t g, f32x2_t u) {
    const f32x2_t t = g * -1.4426950408889634f;
    const f32x2_t e = {__builtin_amdgcn_exp2f(t.x), __builtin_amdgcn_exp2f(t.y)};
    const f32x2_t d = S8 ? e * 0.125f + 0.125f : e + 1.0f;
    const f32x2_t r = {__builtin_amdgcn_rcpf(d.x), __builtin_amdgcn_rcpf(d.y)};
    return (g * u) * r;
}
__device__ __forceinline__ float softplus_f(float x) { return x > 20.f ? x : log1pf(__expf(x)); }

struct EpiPlain {
    static constexpr bool PERM = true, AFTER_DRAIN = false;
    bf16_t* O; int ldc;
    __device__ __forceinline__ void operator()(const f32x4 (&acc)[2][2][4][2], const Unit& u, int wr, int wc, int fr, int fq) const {
        const int row0 = u.pm * BM + wr * 64 + fr, col0 = u.pn * BM + wc * 32 + 8 * fq;
#pragma unroll
        for (int ai = 0; ai < 2; ++ai)
#pragma unroll
            for (int m = 0; m < 4; ++m) { bf16_t* rowp = O + (size_t)(row0 + ai * HALF + m * 16) * ldc + col0;
#pragma unroll
                for (int bj = 0; bj < 2; ++bj) { const f32x4 v0 = acc[ai][bj][m][0], v1 = acc[ai][bj][m][1];
                    u32x4 w; w.x = pk_f16(v0[0], v0[1]); w.y = pk_f16(v0[2], v0[3]); w.z = pk_f16(v1[0], v1[1]); w.w = pk_f16(v1[2], v1[3]);
                    *(u32x4*)(rowp + bj * HALF) = w; } }
    }
};
struct EpiSwiGLU {
    static constexpr bool PERM = true, AFTER_DRAIN = false;
    bf16_t* O; int ldc;
    __device__ __forceinline__ void operator()(const f32x4 (&acc)[2][2][4][2], const Unit& u, int wr, int wc, int fr, int fq) const {
        const int row0 = u.pm * BM + wr * 64 + fr, col0 = u.pn * HALF + wc * 32 + 8 * fq;
#pragma unroll
        for (int ai = 0; ai < 2; ++ai)
#pragma unroll
            for (int m = 0; m < 4; ++m) { bf16_t* rowp = O + (size_t)(row0 + ai * HALF + m * 16) * ldc + col0;
                const f32x4 g0 = acc[ai][0][m][0], g1 = acc[ai][0][m][1], u0 = acc[ai][1][m][0], u1 = acc[ai][1][m][1];
                u32x4 w;
                { const f32x2_t a = swiglu2<false>((f32x2_t){g0[0], g0[1]}, (f32x2_t){u0[0], u0[1]}), b = swiglu2<false>((f32x2_t){g0[2], g0[3]}, (f32x2_t){u0[2], u0[3]}),
                                c = swiglu2<false>((f32x2_t){g1[0], g1[1]}, (f32x2_t){u1[0], u1[1]}), d = swiglu2<false>((f32x2_t){g1[2], g1[3]}, (f32x2_t){u1[2], u1[3]});
                  w.x = pk_bf16q(a.x, a.y); w.y = pk_bf16q(b.x, b.y); w.z = pk_bf16q(c.x, c.y); w.w = pk_bf16q(d.x, d.y); }
                __builtin_nontemporal_store(w, (u32x4*)rowp); }
    }
};
struct EpiInProj {
    static constexpr bool PERM = true, AFTER_DRAIN = false;
    bf16_t* P; int ldc; float* dtf; float* dtb; const float* rcos; const float* rsin; const float* dt_bias; float qscale;
    __device__ __forceinline__ void operator()(const f32x4 (&acc)[2][2][4][2], const Unit& u, int wr, int wc, int fr, int fq) const {
        const int row0 = u.pm * BM + wr * 64 + fr;
        if (u.pn == 32) {
            if (wc < 2) {
                float* dst = (wc == 0) ? dtf : dtb; const float* bp = dt_bias + wc * 32 + 8 * fq;
                const f32x4 b0 = *(const f32x4*)bp, b1 = *(const f32x4*)(bp + 4);
#pragma unroll
                for (int ai = 0; ai < 2; ++ai)
#pragma unroll
                    for (int m = 0; m < 4; ++m) { float* rowp = dst + (size_t)(row0 + ai * HALF + m * 16) * 32 + 8 * fq;
                        f32x4 v0 = acc[ai][0][m][0] + b0, v1 = acc[ai][0][m][1] + b1;
#pragma unroll
                        for (int j = 0; j < 4; ++j) { v0[j] = softplus_f(v0[j]); v1[j] = softplus_f(v1[j]); }
                        *(f32x4*)rowp = v0; *(f32x4*)(rowp + 4) = v1; }
            }
            return;
        }
        const int col0 = u.pn * BM + wc * 32 + 8 * fq;
        const bool rope = (u.pn < 8) || (u.pn == 16) || (u.pn == 17);
        if (!rope) {
#pragma unroll
            for (int ai = 0; ai < 2; ++ai)
#pragma unroll
                for (int m = 0; m < 4; ++m) { bf16_t* rowp = P + (size_t)(row0 + ai * HALF + m * 16) * ldc + col0;
#pragma unroll
                    for (int bj = 0; bj < 2; ++bj) { const f32x4 v0 = acc[ai][bj][m][0], v1 = acc[ai][bj][m][1];
                        u32x4 w; w.x = pk_bf16(v0[0], v0[1]); w.y = pk_bf16(v0[2], v0[3]); w.z = pk_bf16(v1[0], v1[1]); w.w = pk_bf16(v1[2], v1[3]);
                        *(u32x4*)(rowp + bj * HALF) = w; } }
        } else {
            const float sc = (u.pn < 8) ? qscale : 1.0f;
            const bool lat = u.pm < 64;
            const int axis = wc >> 1, ioff = 16 * (wc & 1) + 4 * fq;
#pragma unroll
            for (int ai = 0; ai < 2; ++ai)
#pragma unroll
                for (int m = 0; m < 4; ++m) { const int row = row0 + ai * HALF + m * 16; bf16_t* rowp = P + (size_t)row * ldc + col0;
                    f32x4 cs = (f32x4){1.f, 1.f, 1.f, 1.f}, sn = (f32x4){0.f, 0.f, 0.f, 0.f};
                    if (lat) { const int t = row & 8191, pos = axis ? (t & 63) : (t >> 6); cs = *(const f32x4*)(rcos + pos * 32 + ioff); sn = *(const f32x4*)(rsin + pos * 32 + ioff); }
#pragma unroll
                    for (int bj = 0; bj < 2; ++bj) { const f32x4 x1 = acc[ai][bj][m][0], x2 = acc[ai][bj][m][1];
                        const f32x4 o1 = (x1 * cs - x2 * sn) * sc, o2 = (x2 * cs + x1 * sn) * sc;
                        u32x4 w; w.x = pk_bf16(o1[0], o1[1]); w.y = pk_bf16(o1[2], o1[3]); w.z = pk_bf16(o2[0], o2[1]); w.w = pk_bf16(o2[2], o2[3]);
                        *(u32x4*)(rowp + bj * HALF) = w; } }
        }
    }
};
struct InProjOrder {
    StaticOrder lat; int G, c;
    __host__ __device__ void init(int G_, int c_) { lat.init(16384, 8448, 4096, G_, c_); G = G_; c = c_; }
    __host__ __device__ __forceinline__ bool next(int i, Unit& u) const {
        const long L = (long)i * G + c;
        if (L < lat.nwg) return lat.next(i, u);
        const int k = (int)(L - lat.nwg); if (k >= 34) return false;
        u.pm = 64 + (k & 1); u.pn = 16 + (k >> 1); u.koff = 0; u.nt = lat.nt; u.aux = 0; return true;
    }
    __device__ __forceinline__ void a_ready(const Unit&) const {}
    __device__ __forceinline__ void done(const Unit&) const {}
};


struct CtxSplitOrder {
    int G, c;
    __host__ __device__ void init(int G_, int c_) { G = G_; c = c_; }
    __host__ __device__ __forceinline__ bool next(int i, Unit& u) const {
        const long L = (long)i * G + c; if (L >= 256) return false;
        const int k = (int)L, s = k >> 5;
        u.pm = 64 + (k & 1); u.pn = (k >> 1) & 15; u.aux = s; u.nt = (s < 6) ? 22 : 20; u.koff = 64 * ((s < 6) ? 22 * s : 132 + 20 * (s - 6)); return true;
    }
    __device__ __forceinline__ void a_ready(const Unit&) const {}
    __device__ __forceinline__ void done(const Unit&) const {}
};
struct EpiSplitF32 {
    static constexpr bool PERM = true, AFTER_DRAIN = false;
    float* YP; int ldc;
    __device__ __forceinline__ void operator()(const f32x4 (&acc)[2][2][4][2], const Unit& u, int wr, int wc, int fr, int fq) const {
        float* base = YP + (size_t)u.aux * 512 * ldc + (size_t)((u.pm - 64) * BM + wr * 64 + fr) * ldc + u.pn * BM + wc * 32 + 8 * fq;
#pragma unroll
        for (int ai = 0; ai < 2; ++ai)
#pragma unroll
            for (int m = 0; m < 4; ++m) { float* rowp = base + (size_t)(ai * HALF + m * 16) * ldc;
#pragma unroll
                for (int bj = 0; bj < 2; ++bj) { *(f32x4*)(rowp + bj * HALF) = acc[ai][bj][m][0]; *(f32x4*)(rowp + bj * HALF + 4) = acc[ai][bj][m][1]; } }
    }
};

__device__ __forceinline__ float clamp448(float v) { return __builtin_amdgcn_fmed3f(v, -448.f, 448.f); }
__device__ __forceinline__ unsigned pk4_fp8(float a, float b, float c, float d) { int p = __builtin_amdgcn_cvt_pk_fp8_f32(clamp448(a), clamp448(b), 0, false); p = __builtin_amdgcn_cvt_pk_fp8_f32(clamp448(c), clamp448(d), p, true); return (unsigned)p; }
struct EpiSwiGLU8 {
    static constexpr bool PERM = true, AFTER_DRAIN = false;
    unsigned char* O; int ldc;
    __device__ __forceinline__ void operator()(const f32x4 (&acc)[2][2][4][2], const Unit& u, int wr, int wc, int fr, int fq) const {
        const int row0 = u.pm * BM + wr * 64 + fr, col0 = u.pn * HALF + wc * 32 + 8 * fq;
#pragma unroll
        for (int ai = 0; ai < 2; ++ai)
#pragma unroll
            for (int m = 0; m < 4; ++m) { unsigned char* rowp = O + (size_t)(row0 + ai * HALF + m * 16) * ldc + col0;
                const f32x4 g0 = acc[ai][0][m][0], g1 = acc[ai][0][m][1], u0 = acc[ai][1][m][0], u1 = acc[ai][1][m][1];
                const f32x2_t a = swiglu2<true>((f32x2_t){g0[0], g0[1]}, (f32x2_t){u0[0], u0[1]}), b = swiglu2<true>((f32x2_t){g0[2], g0[3]}, (f32x2_t){u0[2], u0[3]}),
                              c = swiglu2<true>((f32x2_t){g1[0], g1[1]}, (f32x2_t){u1[0], u1[1]}), d = swiglu2<true>((f32x2_t){g1[2], g1[3]}, (f32x2_t){u1[2], u1[3]});
                typedef unsigned u32x2_t __attribute__((ext_vector_type(2)));
                u32x2_t w; w.x = pk4_fp8(a.x, a.y, b.x, b.y); w.y = pk4_fp8(c.x, c.y, d.x, d.y);
                *(u32x2_t*)rowp = w; }
    }
};
struct EpiPlainS {
    static constexpr bool PERM = true, AFTER_DRAIN = false;
    bf16_t* O; int ldc; float scale;
    __device__ __forceinline__ void operator()(const f32x4 (&acc)[2][2][4][2], const Unit& u, int wr, int wc, int fr, int fq) const {
        const int row0 = u.pm * BM + wr * 64 + fr, col0 = u.pn * BM + wc * 32 + 8 * fq;
#pragma unroll
        for (int ai = 0; ai < 2; ++ai)
#pragma unroll
            for (int m = 0; m < 4; ++m) { bf16_t* rowp = O + (size_t)(row0 + ai * HALF + m * 16) * ldc + col0;
#pragma unroll
                for (int bj = 0; bj < 2; ++bj) { const f32x4 v0 = acc[ai][bj][m][0] * scale, v1 = acc[ai][bj][m][1] * scale;
                    u32x4 w; w.x = pk_f16(v0[0], v0[1]); w.y = pk_f16(v0[2], v0[3]); w.z = pk_f16(v1[0], v1[1]); w.w = pk_f16(v1[2], v1[3]);
                    *(u32x4*)(rowp + bj * HALF) = w; } }
    }
};

struct EpiOutProj {
    static constexpr bool PERM = true, AFTER_DRAIN = false;
    bf16_t* O; int ldc; const PG8_LAS float* qt;
    __device__ __forceinline__ float keep_factor(const Unit& u, int ai, int m, int wr, int fr) const {
        const float s = qt[(u.aux & 3) * 256 + ai * HALF + wr * 64 + m * 16 + fr]; return (u.aux & 0x100) ? s : 0.0f;
    }
    __device__ __forceinline__ void operator()(const f32x4 (&acc_)[2][2][4][2], const Unit& u, int wr, int wc, int fr, int fq) const {
        if (u.aux & 0x100) return;
        const int row0 = u.pm * BM + wr * 64 + fr, col0 = u.pn * BM + wc * 32 + 8 * fq;
#pragma unroll
        for (int ai = 0; ai < 2; ++ai)
#pragma unroll
            for (int m = 0; m < 4; ++m) { bf16_t* rowp = O + (size_t)(row0 + ai * HALF + m * 16) * ldc + col0;
#pragma unroll
                for (int bj = 0; bj < 2; ++bj) { const f32x4 v0 = acc_[ai][bj][m][0], v1 = acc_[ai][bj][m][1];
                    u32x4 w; w.x = pk_f16(v0[0], v0[1]); w.y = pk_f16(v0[2], v0[3]); w.z = pk_f16(v1[0], v1[1]); w.w = pk_f16(v1[2], v1[3]);
                    *(u32x4*)(rowp + bj * HALF) = w; } }
    }
};
struct OutProjOrder {
    StaticOrder t;
    __host__ __device__ void init(int G_, int c_) { t.init(16384, 4096, 4096, G_, c_); }
    __host__ __device__ __forceinline__ bool next(int i, Unit& u) const {
        if (!t.next(i >> 1, u)) return false;
        u.nt = 32; u.koff = (i & 1) * 2048; u.aux = (i & 1) ? 0 : (0x100 | ((i >> 1) & 3)); return true;
    }
    __device__ __forceinline__ void a_ready(const Unit&) const {}
    __device__ __forceinline__ void done(const Unit&) const {}
};

struct HalfNOrder {
    StaticOrder h; int G, c, nh;
    __host__ __device__ void init(int M, int G_, int c_) { h.init(M, 43 * 256, 4096, G_, c_); G = G_; c = c_; nh = h.nwg; }
    __host__ __device__ __forceinline__ bool next(int i, Unit& u) const {
        const long L = (long)i * G + c; if (L >= 2L * nh) return false;
        const int half = L >= nh, l = (int)(L - (half ? nh : 0));
        StaticOrder t = h; t.c = l % G; if (!t.next(l / G, u)) return false;
        u.pn += 43 * half; return true;
    }
    __device__ __forceinline__ void a_ready(const Unit&) const {}
    __device__ __forceinline__ void done(const Unit&) const {}
};
typedef int v8i_t __attribute__((ext_vector_type(8))); typedef int v4i_t __attribute__((ext_vector_type(4)));
__device__ __forceinline__ v8i_t cat8(bf16x8 a, bf16x8 b) { return __builtin_shufflevector(__builtin_bit_cast(v4i_t, a), __builtin_bit_cast(v4i_t, b), 0, 1, 2, 3, 4, 5, 6, 7); }
template <class Epi, class Sched, bool ALIGN_EPI = false, bool SP2 = false, bool FP8 = false, bool KEEP = false>
__device__ __forceinline__ void gemm_phase(PG8_LAS unsigned char* lds, const Gemm g, const Sched& S, const Epi& E) {
    const int tid = threadIdx.x, wid = __builtin_amdgcn_readfirstlane(tid >> 6), lane = tid & 63, wr = wid >> 2, wc = wid & 3, fr = lane & 15, fq = lane >> 4;
    const int K = g.K;
    unsigned voffA[2], voffB[2];
#pragma unroll
    for (int i = 0; i < 2; ++i) { int R, C; stage_rc(tid * 16 + i * 8192, R, C); const int Rb = Epi::PERM ? ((R & ~31) + perm32(R & 31)) : R;
        voffA[i] = (unsigned)(R * K + C) * 2u; voffB[i] = (unsigned)(Rb * K + C) * 2u; }
    const size_t kstep = (size_t)(BK * 2);
    const size_t hstep = (size_t)HALF * K * 2;
    const size_t tstep = 2 * hstep;
    const unsigned ldsw = (unsigned)wid * 1024u;
    const int aoff = lds_byte(wr * 64 + fr, fq * 8), boff = lds_byte(wc * 32 + fr, fq * 8);
#define PG8_SA(b, h) (((b) * 2 + (h)) * HTB)
#define PG8_SB(b, h) ((4 + (b) * 2 + (h)) * HTB)
#define PG8_STAGE(bufoff, gbase, voff) do { _Pragma("unroll") for (int _i = 0; _i < 2; ++_i) \
        __builtin_amdgcn_global_load_lds((const unsigned*)((const char*)(gbase) + (voff)[_i]), (PG8_LAS unsigned*)(lds + (bufoff) + ldsw + _i * 8192), 16, 0, 0); } while (0)
#define PG8_LDA(dst, b, h) do { _Pragma("unroll") for (int m = 0; m < 4; ++m) { if constexpr (FP8) dst##8[m] = cat8(*(const PG8_LAS bf16x8*)(lds + PG8_SA(b, h) + aoff + m * 2048), *(const PG8_LAS bf16x8*)(lds + PG8_SA(b, h) + aoff + m * 2048 + 1024)); \
        else { _Pragma("unroll") for (int k = 0; k < 2; ++k) dst[m][k] = *(const PG8_LAS bf16x8*)(lds + PG8_SA(b, h) + aoff + m * 2048 + k * 1024); } } } while (0)
#define PG8_LDB(dst, b, h) do { _Pragma("unroll") for (int n = 0; n < 2; ++n) { if constexpr (FP8) dst##8[n] = cat8(*(const PG8_LAS bf16x8*)(lds + PG8_SB(b, h) + boff + n * 2048), *(const PG8_LAS bf16x8*)(lds + PG8_SB(b, h) + boff + n * 2048 + 1024)); \
        else { _Pragma("unroll") for (int k = 0; k < 2; ++k) dst[n][k] = *(const PG8_LAS bf16x8*)(lds + PG8_SB(b, h) + boff + n * 2048 + k * 1024); } } } while (0)
#ifndef PG8_BSTAT
#define PG8_BSTAT 0
#endif
#define PG8_MMA(ai, bj, At, Bt) do { __builtin_amdgcn_s_setprio(1); \
        if constexpr (FP8) { _Pragma("unroll") for (int m = 0; m < 4; ++m) _Pragma("unroll") for (int n = 0; n < 2; ++n) asm volatile("v_mfma_f32_16x16x128_f8f6f4 %0, %1, %2, %0" : "+v"(acc[ai][bj][m][n]) : "v"(Bt##8[n]), "v"(At##8[m])); } \
        else if (PG8_BSTAT) { _Pragma("unroll") for (int k = 0; k < 2; ++k) _Pragma("unroll") for (int n = 0; n < 2; ++n) _Pragma("unroll") for (int m = 0; m < 4; ++m) acc[ai][bj][m][n] = __builtin_amdgcn_mfma_f32_16x16x32_bf16(Bt[n][k], At[m][k], acc[ai][bj][m][n], 0, 0, 0); } \
        else { _Pragma("unroll") for (int m = 0; m < 4; ++m) _Pragma("unroll") for (int n = 0; n < 2; ++n) _Pragma("unroll") for (int k = 0; k < 2; ++k) acc[ai][bj][m][n] = __builtin_amdgcn_mfma_f32_16x16x32_bf16(Bt[n][k], At[m][k], acc[ai][bj][m][n], 0, 0, 0); } \
        if constexpr (FP8) asm volatile("s_nop 3");     \
        __builtin_amdgcn_s_setprio(0); } while (0)
#define PG8_WAIT_V(n) asm volatile("s_waitcnt vmcnt(" #n ")" ::: "memory")
#define PG8_WAIT_L(n) asm volatile("s_waitcnt lgkmcnt(" #n ")" ::: "memory")
#define PG8_BAR __builtin_amdgcn_s_barrier()
#define PG8_SCHED __builtin_amdgcn_sched_barrier(0)
    Unit cur, nxt; int ui = 0;
    if (!S.next(0, cur)) return;
    f32x4 acc[2][2][4][2];
#pragma unroll
    for (int a = 0; a < 2; ++a)
#pragma unroll
        for (int b = 0; b < 2; ++b)
#pragma unroll
            for (int m = 0; m < 4; ++m)
#pragma unroll
                for (int n = 0; n < 2; ++n) acc[a][b][m][n] = (f32x4){0.f, 0.f, 0.f, 0.f};
    bf16x8 At[4][2], B0[2][2], B1[2][2]; v8i_t At8[4], B08[2], B18[2];
    const char* cA = (const char*)g.A + (size_t)cur.pm * tstep + (size_t)cur.koff * 2; const char* cB = (const char*)g.Bt + (size_t)cur.pn * tstep + (size_t)cur.koff * 2;
    S.a_ready(cur);
    if constexpr (SP2) {
        PG8_STAGE(PG8_SB(0, 0), cB, voffB); PG8_STAGE(PG8_SB(0, 1), cB + hstep, voffB); PG8_STAGE(PG8_SA(0, 0), cA, voffA); PG8_STAGE(PG8_SA(0, 1), cA + hstep, voffA);
        if (wr == 1) PG8_BAR;
        PG8_WAIT_V(2); PG8_BAR;
        PG8_STAGE(PG8_SB(1, 0), cB + kstep, voffB); PG8_STAGE(PG8_SA(1, 0), cA + kstep, voffA); PG8_STAGE(PG8_SB(1, 1), cB + hstep + kstep, voffB);
        PG8_WAIT_V(6); PG8_BAR;
    } else {
        PG8_STAGE(PG8_SB(0, 0), cB, voffB); PG8_STAGE(PG8_SA(0, 0), cA, voffA); PG8_STAGE(PG8_SB(0, 1), cB + hstep, voffB); PG8_STAGE(PG8_SA(0, 1), cA + hstep, voffA);
        if (wr == 1) PG8_BAR;
        PG8_WAIT_V(4); PG8_BAR;
        PG8_STAGE(PG8_SB(1, 0), cB + kstep, voffB); PG8_STAGE(PG8_SA(1, 0), cA + kstep, voffA); PG8_STAGE(PG8_SB(1, 1), cB + hstep + kstep, voffB);
        PG8_WAIT_V(6); PG8_BAR;
    }
    for (;;) {
        const bool has_next = S.next(ui + 1, nxt);
        const char* nA = has_next ? (const char*)g.A + (size_t)nxt.pm * tstep + (size_t)nxt.koff * 2 : cA; const char* nB = has_next ? (const char*)g.Bt + (size_t)nxt.pn * tstep + (size_t)nxt.koff * 2 : cB;
        const int nt = cur.nt;
        for (int t = 0; t < nt; t += 2) {
            const bool last = (t == nt - 2);
            const char* a1 = cA + (size_t)(t + 1) * kstep;
            const char* a2 = last ? nA : cA + (size_t)(t + 2) * kstep; const char* b2 = last ? nB : cB + (size_t)(t + 2) * kstep;
            const char* a3 = a2 + kstep; const char* b3 = b2 + kstep;
            if (last && has_next) S.a_ready(nxt);
            if constexpr (SP2) {
            PG8_LDB(B0, 0, 0); PG8_LDB(B1, 0, 1); PG8_SCHED; PG8_LDA(At, 0, 0); PG8_STAGE(PG8_SA(1, 1), a1 + hstep, voffA);
            PG8_WAIT_V(8); PG8_WAIT_L(0); PG8_BAR; PG8_MMA(0, 0, At, B0); PG8_MMA(0, 1, At, B1); PG8_BAR; PG8_SCHED;
            PG8_LDA(At, 0, 1); PG8_STAGE(PG8_SB(0, 0), b2, voffB); PG8_STAGE(PG8_SB(0, 1), b2 + hstep, voffB); PG8_STAGE(PG8_SA(0, 0), a2, voffA);
            PG8_WAIT_V(8); PG8_WAIT_L(0); PG8_BAR; PG8_MMA(1, 0, At, B0); PG8_MMA(1, 1, At, B1); PG8_BAR; PG8_SCHED;
            PG8_LDB(B0, 1, 0); PG8_LDB(B1, 1, 1); PG8_SCHED; PG8_LDA(At, 1, 0); PG8_STAGE(PG8_SA(0, 1), a2 + hstep, voffA);
            PG8_WAIT_V(8); PG8_WAIT_L(0); PG8_BAR; PG8_MMA(0, 0, At, B0); PG8_MMA(0, 1, At, B1); PG8_BAR; PG8_SCHED;
            PG8_LDA(At, 1, 1); PG8_STAGE(PG8_SB(1, 0), b3, voffB); PG8_STAGE(PG8_SB(1, 1), b3 + hstep, voffB); PG8_STAGE(PG8_SA(1, 0), a3, voffA);
            PG8_WAIT_V(8); PG8_WAIT_L(0); PG8_BAR; PG8_MMA(1, 0, At, B0); PG8_MMA(1, 1, At, B1); PG8_BAR; PG8_SCHED;
            } else {
            PG8_LDB(B0, 0, 0); PG8_SCHED; PG8_LDA(At, 0, 0); PG8_STAGE(PG8_SA(1, 1), a1 + hstep, voffA);
            PG8_WAIT_L(8); PG8_BAR; PG8_WAIT_L(0); PG8_MMA(0, 0, At, B0); PG8_BAR; PG8_SCHED;
            PG8_LDB(B1, 0, 1); PG8_STAGE(PG8_SB(0, 0), b2, voffB);
            PG8_BAR; PG8_WAIT_L(0); PG8_MMA(0, 1, At, B1); PG8_BAR;
            PG8_LDA(At, 0, 1); PG8_STAGE(PG8_SA(0, 0), a2, voffA);
            PG8_BAR; PG8_WAIT_L(0); PG8_MMA(1, 0, At, B0); PG8_BAR; PG8_SCHED;
            PG8_STAGE(PG8_SB(0, 1), b2 + hstep, voffB);
            PG8_WAIT_V(6); PG8_BAR; PG8_MMA(1, 1, At, B1); PG8_BAR;
            PG8_LDB(B0, 1, 0); PG8_SCHED; PG8_LDA(At, 1, 0); PG8_STAGE(PG8_SA(0, 1), a2 + hstep, voffA);
            PG8_WAIT_L(8); PG8_BAR; PG8_WAIT_L(0); PG8_MMA(0, 0, At, B0); PG8_BAR; PG8_SCHED;
            PG8_LDB(B1, 1, 1); PG8_STAGE(PG8_SB(1, 0), b3, voffB);
            PG8_BAR; PG8_WAIT_L(0); PG8_MMA(0, 1, At, B1); PG8_BAR;
            PG8_LDA(At, 1, 1); PG8_STAGE(PG8_SA(1, 0), a3, voffA);
            PG8_BAR; PG8_WAIT_L(0); PG8_MMA(1, 0, At, B0); PG8_BAR; PG8_SCHED;
            PG8_STAGE(PG8_SB(1, 1), b3 + hstep, voffB);
            PG8_WAIT_V(6); PG8_BAR; PG8_MMA(1, 1, At, B1); PG8_BAR;
            }
        }
        if constexpr (ALIGN_EPI) { if (wr == 0) PG8_BAR; }
        if constexpr (FP8) asm volatile("s_nop 15\n\ts_nop 15" ::: "memory");
        if constexpr (!Epi::AFTER_DRAIN) { E(acc, cur, wr, wc, fr, fq); S.done(cur); }
        if (!has_next) break;
        if constexpr (KEEP) {
#pragma unroll
            for (int a = 0; a < 2; ++a)
#pragma unroll
                for (int m = 0; m < 4; ++m) { const float f = E.keep_factor(cur, a, m, wr, fr);
#pragma unroll
                    for (int b = 0; b < 2; ++b) { acc[a][b][m][0] *= f; acc[a][b][m][1] *= f; } }
        } else
#pragma unroll
        for (int a = 0; a < 2; ++a)
#pragma unroll
            for (int b = 0; b < 2; ++b)
#pragma unroll
                for (int m = 0; m < 4; ++m)
#pragma unroll
                    for (int n = 0; n < 2; ++n) acc[a][b][m][n] = (f32x4){0.f, 0.f, 0.f, 0.f};
        cur = nxt; cA = nA; cB = nB; ++ui;
        if constexpr (ALIGN_EPI) { if (wr == 1) PG8_BAR; }
    }
    PG8_WAIT_V(0);
    if constexpr (!ALIGN_EPI) { if (wr == 0) PG8_BAR; }
    PG8_BAR;
    if constexpr (Epi::AFTER_DRAIN) { E.fused(acc, cur, wr, wc, fr, fq, lds, wid, lane); S.done(cur); }
#undef PG8_SA
#undef PG8_SB
#undef PG8_STAGE
#undef PG8_LDA
#undef PG8_LDB
#undef PG8_MMA
#undef PG8_WAIT_V
#undef PG8_WAIT_L
#undef PG8_BAR
#undef PG8_SCHED
}
}
constexpr int NWAVES = 8, NTHR = NWAVES * 64;
constexpr int DM = 4096, NLAT = 16384, NCTX = 512, MROWS = NLAT + NCTX, SEQ = 8192, CTXL = 256;
constexpr int FF = 11008, NGU = 2 * FF;
constexpr int NINP = 8448;
constexpr int PQ = 0, PZ = 2048, PK = 4096, PV = 4608, PXBC = 5120;
constexpr int XBCW = 3072;
constexpr int NMOD = 9 * DM;
constexpr int NSC = 132;
constexpr float EPS = 1e-6f;
constexpr float QSCALE = 0.12751743082459868f;
constexpr float LOG2E = 1.4426950408889634f;

constexpr size_t MiB = 1u << 20;
constexpr size_t WS_CTL = 0, WS_MOD = 1 * MiB, ZERO_BYTES = 2 * MiB;
constexpr size_t WS_ROWSS = 1 * MiB + 512 * 1024;
constexpr size_t WS_ROPE = 2 * MiB;
constexpr size_t WS_DEC = 2 * MiB + 65536;
constexpr size_t WS_DTF = 4 * MiB, WS_DTB = 7 * MiB;
constexpr size_t WS_WGU0 = 16 * MiB, WS_WD0 = 188 * MiB, WS_WIN = 274 * MiB, WS_WOUT = 340 * MiB, WS_WGU1 = 372 * MiB, WS_WD1 = 544 * MiB;
constexpr size_t WS_H = 630 * MiB;
constexpr size_t WS_ACT = 762 * MiB, WS_P = 762 * MiB;
constexpr size_t WS_Y = 1117 * MiB;
constexpr size_t WS_X1 = 1249 * MiB;
constexpr size_t WS_XC = 1505 * MiB;
constexpr size_t WS_OATT = 1604 * MiB, WS_YS = 1668 * MiB;
constexpr size_t WS_SLOC = 1732 * MiB;
constexpr size_t WS_HIN = 1996 * MiB;
constexpr size_t WS_YCP = 2124 * MiB;
constexpr size_t WS_END = 2188 * MiB;
static_assert(WS_WGU0 + (size_t)NGU * DM * 2 <= WS_WD0 && WS_WD0 + (size_t)DM * FF * 2 <= WS_WIN && WS_WIN + (size_t)NINP * DM * 2 <= WS_WOUT && WS_WOUT + (size_t)DM * DM * 2 <= WS_WGU1, "ws map 1");
static_assert(WS_WGU1 + (size_t)NGU * DM * 2 <= WS_WD1 && WS_WD1 + (size_t)DM * FF * 2 <= WS_H && WS_H + (size_t)MROWS * DM * 2 <= WS_ACT && WS_ACT + (size_t)MROWS * FF * 2 <= WS_Y, "ws map 2");
static_assert(WS_P + (size_t)MROWS * NINP * 2 <= WS_Y && WS_Y + (size_t)MROWS * DM * 2 <= WS_X1 && WS_X1 + (size_t)NLAT * DM * 4 <= WS_XC && WS_XC + (size_t)MROWS * XBCW * 2 <= WS_OATT, "ws map 3");
static_assert(WS_OATT + (size_t)NLAT * 2048 * 2 <= WS_YS && WS_YS + (size_t)NLAT * 2048 * 2 <= WS_SLOC && WS_SLOC + (size_t)NSC * 2 * 32 * 8192 * 4 <= WS_HIN && WS_HIN + (size_t)128 * 2 * 32 * 8192 * 2 <= WS_END, "ws map 4");
static_assert(WS_DTF + (size_t)MROWS * 32 * 4 <= WS_DTB && WS_DTB + (size_t)MROWS * 32 * 4 <= WS_WGU0 && WS_MOD + (size_t)3 * NMOD * 4 <= ZERO_BYTES, "ws map 5");
constexpr int CW_BAR = 4096;

constexpr int RING_BYTES = 131072;
constexpr int MISC_OFF = RING_BYTES + 320;
constexpr int LDS_BYTES = 147456;

#define GAS __attribute__((address_space(1)))
#define LAS __attribute__((address_space(3)))
typedef unsigned short bf16;
typedef unsigned u32x4 __attribute__((ext_vector_type(4)));
typedef unsigned u32x2 __attribute__((ext_vector_type(2)));
typedef float f32x4 __attribute__((ext_vector_type(4)));
typedef short bf16x8 __attribute__((ext_vector_type(8)));
typedef short bf16x4 __attribute__((ext_vector_type(4)));
using pg8::pk_bf16; using pg8::pk_bf16q; using pg8::pk_f16; using pg8::silu_f;
__device__ __forceinline__ float bf_lo(unsigned w) { return __uint_as_float(w << 16); }
__device__ __forceinline__ float bf_hi(unsigned w) { return __uint_as_float(w & 0xffff0000u); }
__device__ __forceinline__ unsigned short f2bf(float f) { return (unsigned short)(pk_bf16(f, 0.f) & 0xffffu); }
__device__ __forceinline__ float row_max(float x) {
    u32x2 r = __builtin_amdgcn_permlane16_swap(__float_as_uint(x), __float_as_uint(x), false, false); x = fmaxf(__uint_as_float(r.x), __uint_as_float(r.y));
    r = __builtin_amdgcn_permlane32_swap(__float_as_uint(x), __float_as_uint(x), false, false); return fmaxf(__uint_as_float(r.x), __uint_as_float(r.y));
}
__device__ __forceinline__ float row_sum(float x) {
    u32x2 r = __builtin_amdgcn_permlane16_swap(__float_as_uint(x), __float_as_uint(x), false, false); x = __uint_as_float(r.x) + __uint_as_float(r.y);
    r = __builtin_amdgcn_permlane32_swap(__float_as_uint(x), __float_as_uint(x), false, false); return __uint_as_float(r.x) + __uint_as_float(r.y);
}
__device__ __forceinline__ float wave_sum(float v) {
    v += __uint_as_float(__builtin_amdgcn_update_dpp(0u, __float_as_uint(v), 0xB1, 0xF, 0xF, false));
    v += __uint_as_float(__builtin_amdgcn_update_dpp(0u, __float_as_uint(v), 0x4E, 0xF, 0xF, false));
    v += __uint_as_float(__builtin_amdgcn_update_dpp(0u, __float_as_uint(v), 0x141, 0xF, 0xF, false));
    v += __uint_as_float(__builtin_amdgcn_update_dpp(0u, __float_as_uint(v), 0x140, 0xF, 0xF, false));
    return row_sum(v);
}
typedef _Float16 f16x8 __attribute__((ext_vector_type(8)));
typedef _Float16 f16x2 __attribute__((ext_vector_type(2)));
typedef float f32x2 __attribute__((ext_vector_type(2)));
__device__ __forceinline__ void unpack8h(const u32x4 w, float (&f)[8]) { const f16x8 h = __builtin_bit_cast(f16x8, w);
#pragma unroll
    for (int e = 0; e < 8; ++e) f[e] = (float)h[e]; }
__device__ __forceinline__ void unpack8(const u32x4 w, float (&f)[8]) {
    f[0] = bf_lo(w.x); f[1] = bf_hi(w.x); f[2] = bf_lo(w.y); f[3] = bf_hi(w.y); f[4] = bf_lo(w.z); f[5] = bf_hi(w.z); f[6] = bf_lo(w.w); f[7] = bf_hi(w.w);
}
#define XB_TMO      128
#define XB_XCNT(j)  (256  + 64 * (j))
#define XB_XSUB(j)  (1280 + 64 * (j))
#define XB_XGEN(j)  (2304 + 64 * (j))
#define XB_TOP      3328
#define XB_TOPGEN   3392
#define XCD_BAR_WORDS 3456
#define XB_SPIN_CAP (1u << 18)

__device__ __forceinline__ unsigned xb_ld(unsigned* p)              { return __hip_atomic_load(p, __ATOMIC_RELAXED, __HIP_MEMORY_SCOPE_AGENT); }
__device__ __forceinline__ unsigned xb_add(unsigned* p, unsigned v) { return __hip_atomic_fetch_add(p, v, __ATOMIC_RELAXED, __HIP_MEMORY_SCOPE_AGENT); }
__device__ __forceinline__ unsigned xb_xcc_id() { return (unsigned)__builtin_amdgcn_s_getreg((3 << 11) | 20) & 0xFu; }
#define XB_SPIN(cond, bar) do { unsigned _sp = 0; while (cond) { __builtin_amdgcn_s_sleep(1); \
    if ((++_sp & 255u) == 0u) { if (xb_ld(&(bar)[XB_TMO])) break; if (_sp > XB_SPIN_CAP) { atomicAdd(&(bar)[XB_TMO], 1u); break; } } } } while (0)

struct XcdBarrier {
    unsigned* bar; unsigned x;
    volatile LAS unsigned* st;
};

__device__ __forceinline__ XcdBarrier xcd_barrier_post(unsigned* bar, volatile LAS unsigned* st) {
    XcdBarrier b; b.bar = bar; b.x = xb_xcc_id(); b.st = st;
    if (threadIdx.x == 0) (void)xb_add(&bar[XB_XCNT(b.x)], 1u);
    return b;
}
__device__ __forceinline__ void xcd_barrier_complete(unsigned* bar, unsigned x, unsigned& nloc, unsigned& nx) {
    const unsigned G = gridDim.x * gridDim.y * gridDim.z;
    unsigned sum, cnt, mine, sp = 0u;
    for (;;) {
        sum = 0u; cnt = 0u; mine = 0u;
#pragma unroll
        for (unsigned j = 0; j < 16; ++j) { const unsigned c = xb_ld(&bar[XB_XCNT(j)]); sum += c; cnt += (c > 0u) ? 1u : 0u; mine = (j == x) ? c : mine; }
        if (sum == G) break;
        __builtin_amdgcn_s_sleep(1);
        if ((++sp & 255u) == 0u) { if (xb_ld(&bar[XB_TMO])) break; if (sp > XB_SPIN_CAP) { atomicAdd(&bar[XB_TMO], 1u); break; } }
    }
    nloc = mine > 0u ? mine : 1u; nx = cnt > 0u ? cnt : 1u;
}

__device__ __forceinline__ void xcd_barrier(const XcdBarrier& b) {
    asm volatile("s_waitcnt vmcnt(0)" ::: "memory");
    __syncthreads();
    if (threadIdx.x == 0) {
        unsigned* bar = b.bar;
        __builtin_amdgcn_s_waitcnt(0);
        unsigned nloc = b.st[0], nx = b.st[1];
        if (nloc == 0u) { xcd_barrier_complete(bar, b.x, nloc, nx); b.st[0] = nloc; b.st[1] = nx; }
        const unsigned old = xb_add(&bar[XB_XSUB(b.x)], 1u);
        const unsigned gen = old / nloc;
        if (old + 1u == (gen + 1u) * nloc) {
            __builtin_amdgcn_fence(__ATOMIC_RELEASE, "agent");
            asm volatile("s_waitcnt vmcnt(0)" ::: "memory");
            const unsigned og = xb_add(&bar[XB_TOP], 1u);
            const unsigned tg = og / nx;
            if (og + 1u == (tg + 1u) * nx) xb_add(&bar[XB_TOPGEN], 1u);
            else XB_SPIN(xb_ld(&bar[XB_TOPGEN]) == tg, bar);
            __builtin_amdgcn_fence(__ATOMIC_ACQUIRE, "agent");
            xb_add(&bar[XB_XGEN(b.x)], 1u);
            asm volatile("s_waitcnt vmcnt(0)" ::: "memory");
        } else {
            XB_SPIN(xb_ld(&bar[XB_XGEN(b.x)]) == gen, bar);
            __builtin_amdgcn_fence(__ATOMIC_ACQUIRE, "agent");
            asm volatile("s_waitcnt vmcnt(0)" ::: "memory");
        }
    }
    __syncthreads();
}
struct Fr {
    LAS unsigned char* lds;
    int tid, lane, wave, G, bid;
    const float* in[21]; float* out; unsigned char* ws;
};
#define WSP(T, off) ((T*)(F.ws + (off)))
#define LDSW() asm volatile("s_waitcnt lgkmcnt(0)" ::: "memory")

__device__ __forceinline__ int qk_perm(int d) { const int a = d >> 6, hf = (d >> 5) & 1, i = d & 31; return 32 * (2 * a + (i >> 4)) + 8 * ((i >> 2) & 3) + 4 * hf + (i & 3); }
__device__ __forceinline__ int dst_row(int mode, int n) {
    if (mode == 1) return ((n >> 7) << 8) + (n & 127);
    if (mode == 2) return ((n >> 7) << 8) + 128 + (n & 127);
    if (mode == 3) { if (n < 2048 || (n >= 4096 && n < 4608)) return (n & ~127) + qk_perm(n & 127); return n; }
    return n;
}
#ifndef WQ_DROP
#define WQ_DROP 2
#endif
__device__ __forceinline__ float wquant(float v) {
    if (WQ_DROP == 0) return v;
    unsigned u = __float_as_uint(v); constexpr unsigned sh = 16 + WQ_DROP, half = (1u << (sh - 1)) - 1u;
    u = (u + half + ((u >> sh) & 1u)) & ~((1u << sh) - 1u); return __uint_as_float(u);
}
__device__ __forceinline__ void transpose_item(const float* W, int K, int N, bf16* WT, int mode, const float* kscale, LAS float* scr, int item, int lane) {
    const int nblk = N / 32, kb = item / nblk, nb = item - kb * nblk, k0 = 64 * kb, n0 = 32 * nb;
    float wv[32];
#pragma unroll
    for (int i = 0; i < 32; ++i) wv[i] = __builtin_nontemporal_load(W + (size_t)(k0 + 2 * i + (lane >> 5)) * N + n0 + (lane & 31));
#pragma unroll
    for (int i = 0; i < 32; ++i) { const int kk = 2 * i + (lane >> 5); float v = wv[i]; if (kscale) v *= kscale[k0 + kk]; scr[kk * 33 + (lane & 31)] = (mode & 8) ? wquant(v) : v; }
    LDSW();
    const int c = lane & 7;
#pragma unroll
    for (int j = 0; j < 4; ++j) { const int n = (lane >> 3) + 8 * j; const LAS float* s = scr + (8 * c) * 33 + n;
        u32x4 o; o.x = pk_bf16(s[0 * 33], s[1 * 33]); o.y = pk_bf16(s[2 * 33], s[3 * 33]); o.z = pk_bf16(s[4 * 33], s[5 * 33]); o.w = pk_bf16(s[6 * 33], s[7 * 33]);
        *(u32x4*)(WT + (size_t)dst_row(mode & 7, n0 + n) * K + k0 + 8 * c) = o; }
    LDSW();
}
__device__ __forceinline__ void transpose_item8(const float* W, int K, int N, unsigned char* WT, LAS float* scr, int item, int lane) {
    const int nblk = N / 32, kb = item / nblk, nb = item - kb * nblk, k0 = 64 * kb, n0 = 32 * nb;
    float wv[32];
#pragma unroll
    for (int i = 0; i < 32; ++i) wv[i] = __builtin_nontemporal_load(W + (size_t)(k0 + 2 * i + (lane >> 5)) * N + n0 + (lane & 31));
#pragma unroll
    for (int i = 0; i < 32; ++i) { const int kk = 2 * i + (lane >> 5); scr[kk * 33 + (lane & 31)] = 2048.f * wv[i]; }
    LDSW();
    const int n = lane >> 1, kh = (lane & 1) * 32; const LAS float* s = scr + kh * 33 + n;
    u32x4 o0, o1;
    o0.x = pg8::pk4_fp8(s[0 * 33], s[1 * 33], s[2 * 33], s[3 * 33]); o0.y = pg8::pk4_fp8(s[4 * 33], s[5 * 33], s[6 * 33], s[7 * 33]);
    o0.z = pg8::pk4_fp8(s[8 * 33], s[9 * 33], s[10 * 33], s[11 * 33]); o0.w = pg8::pk4_fp8(s[12 * 33], s[13 * 33], s[14 * 33], s[15 * 33]);
    o1.x = pg8::pk4_fp8(s[16 * 33], s[17 * 33], s[18 * 33], s[19 * 33]); o1.y = pg8::pk4_fp8(s[20 * 33], s[21 * 33], s[22 * 33], s[23 * 33]);
    o1.z = pg8::pk4_fp8(s[24 * 33], s[25 * 33], s[26 * 33], s[27 * 33]); o1.w = pg8::pk4_fp8(s[28 * 33], s[29 * 33], s[30 * 33], s[31 * 33]);
    unsigned char* dst = WT + (size_t)(n0 + n) * K + k0 + kh;
    *(u32x4*)dst = o0; *(u32x4*)(dst + 16) = o1;
    LDSW();
}
constexpr int CV_F = 22016, CV_IN = 64 * 258, CV_OUT = 64 * 128;
constexpr int CV_WD0 = 2 * CV_F, CV_WIN = 3 * CV_F, CV_WOUT = CV_WIN + CV_IN, CV_G1 = CV_WOUT + CV_OUT, CV_U1 = CV_G1 + CV_F, CV_WD1 = CV_U1 + CV_F, CV_END = CV_WD1 + CV_F;
constexpr int CV_Q2_LO = CV_WD0, CV_Q2_HI = CV_WOUT;
constexpr int CV_Q5_LO = CV_WOUT, CV_Q5_HI = CV_G1 + 28000;
constexpr int CV_Q13_LO = CV_WD1, CV_Q13_HI = CV_END;
constexpr int CW_Q2 = 1024, CW_Q5 = 1088, CW_Q13 = 1152;
__device__ __forceinline__ void conv_item(Fr& F, int id, LAS float* scr) {
    const size_t FW = (size_t)DM * FF;
    if (id < CV_F) { transpose_item(F.in[8], DM, FF, WSP(bf16, WS_WGU0), 1 | 8, nullptr, scr, id, F.lane); return; }
    if (id < CV_WD0) { transpose_item(F.in[9], DM, FF, WSP(bf16, WS_WGU0), 2 | 8, nullptr, scr, id - CV_F, F.lane); return; }
    if (id < CV_WIN) { transpose_item(F.in[10], FF, DM, WSP(bf16, WS_WD0), 0 | 8, nullptr, scr, id - CV_WD0, F.lane); return; }
    if (id < CV_WOUT) { transpose_item(F.in[11], DM, 8256, WSP(bf16, WS_WIN), 3, nullptr, scr, id - CV_WIN, F.lane); return; }
    if (id < CV_G1) { const int r = id - CV_WOUT, kb = r / 128; const float* ks = (kb < 32) ? F.in[13] : (F.in[19] - 2048);
        transpose_item(F.in[20], DM, DM, WSP(bf16, WS_WOUT), 0, ks, scr, r, F.lane); return; }
    if (id < CV_U1) { transpose_item(F.in[8] + FW, DM, FF, WSP(bf16, WS_WGU1), 1 | 8, nullptr, scr, id - CV_G1, F.lane); return; }
    if (id < CV_WD1) { transpose_item(F.in[9] + FW, DM, FF, WSP(bf16, WS_WGU1), 2 | 8, nullptr, scr, id - CV_U1, F.lane); return; }
    transpose_item8(F.in[10] + FW, FF, DM, WSP(unsigned char, WS_WD1), scr, id - CV_WD1, F.lane);
}
__device__ __forceinline__ void p0_prologue(Fr& F, int rep = 0) {
    const int gw = F.bid * NWAVES + F.wave, NGW = F.G * NWAVES, gt = F.bid * NTHR + F.tid, NGT = F.G * NTHR;
    LAS float* scr = (LAS float*)(F.lds + F.wave * 8448);
    LAS float* sv = (LAS float*)(F.lds + 69632);
    for (int i = F.tid; i < 3 * DM; i += NTHR) { const int r = i >> 12, k = i & 4095; const float v = (r < 2) ? F.in[1][r * DM + k] : F.in[3][k]; sv[i] = v / (1.0f + __expf(-v)); }
    for (int e = gt; e < 4096; e += NGT) {
        const int pos = e >> 5, i = e & 31; double inv = 1.0; for (int q = 0; q < i; ++q) inv *= 0.74989420933245582730;
        double a = (double)pos * inv; const double k = __builtin_rint(a * 0.15915494309189533577); a = (a - k * 6.283185307179586232) - k * 2.449293598294706414e-16;
        const double a2 = a * a; double sn = 1.0, cs = 1.0;
        for (int q = 14; q >= 1; --q) { sn = 1.0 - sn * a2 / (double)((2 * q) * (2 * q + 1)); cs = 1.0 - cs * a2 / (double)((2 * q - 1) * (2 * q)); }
        sn *= a;
        WSP(float, WS_ROPE)[e] = (float)cs; WSP(float, WS_ROPE)[4096 + e] = (float)sn;
    }
    for (int e = gt; e < 192 * DM / 8; e += NGT) WSP(u32x4, WS_WIN + (size_t)8256 * DM * 2)[e] = (u32x4){0u, 0u, 0u, 0u};
    __syncthreads();
    {
        const float* wm = F.in[4]; const float* bm = F.in[5]; float* MOD = rep ? WSP(float, WS_YCP) : WSP(float, WS_MOD);
        for (int it = gw; it < 144 * 64; it += NGW) {
            const int chunk = it % 144, ks = it / 144, n = chunk * 256 + 4 * F.lane;
            f32x4 a0 = (f32x4){0.f, 0.f, 0.f, 0.f}, a1 = a0, a2 = a0;
            if (ks == 0) { a0 = *(const f32x4*)(bm + n); a1 = a0; a2 = a0; }
            const float* wp = wm + (size_t)(ks * 64) * NMOD + n; const LAS float* s = sv + ks * 64;
#pragma unroll 8
            for (int k = 0; k < 64; ++k) { const f32x4 w = __builtin_nontemporal_load((const f32x4*)(wp + (size_t)k * NMOD)); a0 += s[k] * w; a1 += s[DM + k] * w; a2 += s[2 * DM + k] * w; }
#pragma unroll
            for (int j = 0; j < 4; ++j) {
                __hip_atomic_fetch_add(MOD + n + j, a0[j], __ATOMIC_RELAXED, __HIP_MEMORY_SCOPE_AGENT);
                __hip_atomic_fetch_add(MOD + NMOD + n + j, a1[j], __ATOMIC_RELAXED, __HIP_MEMORY_SCOPE_AGENT);
                __hip_atomic_fetch_add(MOD + 2 * NMOD + n + j, a2[j], __ATOMIC_RELAXED, __HIP_MEMORY_SCOPE_AGENT); }
        }
    }
#ifndef PROBE_P0T
#define PROBE_P0T 1
#endif
    for (int rep = 0; rep < PROBE_P0T; ++rep) {
        for (int it = gw; it < CV_Q2_LO; it += NGW) conv_item(F, it, scr);
        for (int it = CV_Q5_HI + gw; it < CV_Q13_LO; it += NGW) conv_item(F, it, scr);
    }
}
__device__ __forceinline__ void conv_queue(Fr& F, int qword, int lo, int hi) {
    LAS float* scr = (LAS float*)(F.lds + F.wave * 8448);
    unsigned* ctr = (unsigned*)(F.ws + WS_CTL) + qword;
    for (;;) {
        unsigned b = 0; if (F.lane == 0) b = __hip_atomic_fetch_add(ctr, 8u, __ATOMIC_RELAXED, __HIP_MEMORY_SCOPE_AGENT);
        const int base = lo + (int)__builtin_amdgcn_readfirstlane(b);
        if (base >= hi) break;
        for (int q = 0; q < 8 && base + q < hi; ++q) conv_item(F, base + q, scr);
    }
}

__device__ __forceinline__ void norm_mod_row(const float* xrow, const float* g, const float* scale, const float* shift, bf16* hrow, int lane) {
    f32x4 v[16]; float ss = 0.f;
#pragma unroll
    for (int j = 0; j < 8; ++j) { const float* p = xrow + 512 * j + 8 * lane; v[2 * j] = __builtin_nontemporal_load((const f32x4*)p); v[2 * j + 1] = __builtin_nontemporal_load((const f32x4*)(p + 4)); }
#pragma unroll
    for (int j = 0; j < 16; ++j) ss += (v[j][0] * v[j][0] + v[j][1] * v[j][1]) + (v[j][2] * v[j][2] + v[j][3] * v[j][3]);
    const float rstd = 1.0f / sqrtf(wave_sum(ss) * (1.0f / DM) + EPS);
#pragma unroll
    for (int j = 0; j < 8; ++j) { const int o = 512 * j + 8 * lane;
        const f32x4 g0 = *(const f32x4*)(g + o), g1 = *(const f32x4*)(g + o + 4), s0 = *(const f32x4*)(scale + o), s1 = *(const f32x4*)(scale + o + 4), t0 = *(const f32x4*)(shift + o), t1 = *(const f32x4*)(shift + o + 4);
        const f32x4 a = v[2 * j] * rstd * g0 * (1.0f + s0) + t0, b = v[2 * j + 1] * rstd * g1 * (1.0f + s1) + t1;
        u32x4 w; w.x = pk_bf16q(a[0], a[1]); w.y = pk_bf16q(a[2], a[3]); w.z = pk_bf16q(b[0], b[1]); w.w = pk_bf16q(b[2], b[3]);
        *(u32x4*)(hrow + o) = w; }
}
template <bool STORE_X, bool DO_H, bool YSPLIT = false, bool XIN_BF = false, bool XOUT_BF = false, bool HQ = false>
__device__ __forceinline__ void res_norm_row(const void* xin_, const bf16* yrow, void* xout_, bf16* hrow, float coef, const float* gate, const float* gpost,
                                             const float* gpre, const float* scale, const float* shift, int lane, const float* ysplit = nullptr, float ymul = 1.0f) {
    u32x4 yv[8]; float ssy = 0.f;
    if (YSPLIT) {
#pragma unroll
        for (int j = 0; j < 8; ++j) { f32x4 a = (f32x4){0.f, 0.f, 0.f, 0.f}, b = a;
#pragma unroll
            for (int s = 0; s < 8; ++s) { const float* p = ysplit + (size_t)s * 512 * DM + 512 * j + 8 * lane; a += *(const f32x4*)p; b += *(const f32x4*)(p + 4); }
            yv[j].x = pk_f16(a[0], a[1]); yv[j].y = pk_f16(a[2], a[3]); yv[j].z = pk_f16(b[0], b[1]); yv[j].w = pk_f16(b[2], b[3]); }
    } else {
#pragma unroll
    for (int j = 0; j < 8; ++j) yv[j] = __builtin_nontemporal_load((const u32x4*)(yrow + 512 * j + 8 * lane));
    }
    f32x4 v[16];
#pragma unroll
    for (int j = 0; j < 8; ++j) {
        if (XIN_BF) { float f[8]; unpack8h(__builtin_nontemporal_load((const u32x4*)((const bf16*)xin_ + 512 * j + 8 * lane)), f); v[2 * j] = (f32x4){f[0], f[1], f[2], f[3]}; v[2 * j + 1] = (f32x4){f[4], f[5], f[6], f[7]}; }
        else { const float* p = (const float*)xin_ + 512 * j + 8 * lane; v[2 * j] = __builtin_nontemporal_load((const f32x4*)p); v[2 * j + 1] = __builtin_nontemporal_load((const f32x4*)(p + 4)); } }
#pragma unroll
    for (int j = 0; j < 8; ++j) { float f[8]; unpack8h(yv[j], f);
#pragma unroll
        for (int e = 0; e < 8; ++e) ssy += f[e] * f[e]; }
    const float ry = coef * ymul / sqrtf(wave_sum(ssy) * (ymul * ymul) * (1.0f / DM) + EPS);
    float ss = 0.f;
#pragma unroll
    for (int j = 0; j < 8; ++j) { const int o = 512 * j + 8 * lane; float f[8]; unpack8h(yv[j], f);
        const f32x4 ga0 = *(const f32x4*)(gate + o), ga1 = *(const f32x4*)(gate + o + 4), gp0 = *(const f32x4*)(gpost + o), gp1 = *(const f32x4*)(gpost + o + 4);
        const f32x4 y0 = (f32x4){f[0], f[1], f[2], f[3]}, y1 = (f32x4){f[4], f[5], f[6], f[7]};
        v[2 * j] += ga0 * gp0 * (y0 * ry); v[2 * j + 1] += ga1 * gp1 * (y1 * ry);
        if (STORE_X) {
            if (XOUT_BF) { u32x4 w; w.x = pk_f16(v[2 * j][0], v[2 * j][1]); w.y = pk_f16(v[2 * j][2], v[2 * j][3]); w.z = pk_f16(v[2 * j + 1][0], v[2 * j + 1][1]); w.w = pk_f16(v[2 * j + 1][2], v[2 * j + 1][3]);
                __builtin_nontemporal_store(w, (u32x4*)((bf16*)xout_ + o)); }
            else { __builtin_nontemporal_store(v[2 * j], (f32x4*)((float*)xout_ + o)); __builtin_nontemporal_store(v[2 * j + 1], (f32x4*)((float*)xout_ + o + 4)); } }
        if (DO_H) ss += (v[2 * j][0] * v[2 * j][0] + v[2 * j][1] * v[2 * j][1]) + (v[2 * j][2] * v[2 * j][2] + v[2 * j][3] * v[2 * j][3])
                      + (v[2 * j + 1][0] * v[2 * j + 1][0] + v[2 * j + 1][1] * v[2 * j + 1][1]) + (v[2 * j + 1][2] * v[2 * j + 1][2] + v[2 * j + 1][3] * v[2 * j + 1][3]); }
    if (DO_H) {
        const float rstd = 1.0f / sqrtf(wave_sum(ss) * (1.0f / DM) + EPS);
#pragma unroll
        for (int j = 0; j < 8; ++j) { const int o = 512 * j + 8 * lane;
            const f32x4 g0 = *(const f32x4*)(gpre + o), g1 = *(const f32x4*)(gpre + o + 4), s0 = *(const f32x4*)(scale + o), s1 = *(const f32x4*)(scale + o + 4), t0 = *(const f32x4*)(shift + o), t1 = *(const f32x4*)(shift + o + 4);
            const f32x4 a = v[2 * j] * rstd * g0 * (1.0f + s0) + t0, b = v[2 * j + 1] * rstd * g1 * (1.0f + s1) + t1;
            u32x4 w;
            if (HQ) { w.x = pk_bf16q(a[0], a[1]); w.y = pk_bf16q(a[2], a[3]); w.z = pk_bf16q(b[0], b[1]); w.w = pk_bf16q(b[2], b[3]); }
            else { w.x = pk_bf16(a[0], a[1]); w.y = pk_bf16(a[2], a[3]); w.z = pk_bf16(b[0], b[1]); w.w = pk_bf16(b[2], b[3]); }
            *(u32x4*)(hrow + o) = w; }
    }
}
__device__ __forceinline__ int mod_row_of(int m) { return m < NLAT ? (m >> 13) : 2; }
__device__ __forceinline__ const float* xin_row(Fr& F, int m) { return m < NLAT ? F.in[0] + (size_t)m * DM : F.in[2] + (size_t)(m - NLAT) * DM; }

__device__ __forceinline__ void p1_norm(Fr& F) {
    const int gw = F.bid * NWAVES + F.wave, NGW = F.G * NWAVES; const float* MOD = WSP(float, WS_MOD);
    for (int m = gw; m < MROWS; m += NGW) { const float* md = MOD + (size_t)mod_row_of(m) * NMOD;
        norm_mod_row(xin_row(F, m), F.in[6], md + 1 * DM, md + 0 * DM, WSP(bf16, WS_H) + (size_t)m * DM, F.lane); }
}
__device__ __forceinline__ void p4_resnorm(Fr& F) {
    const int gw = F.bid * NWAVES + F.wave, NGW = F.G * NWAVES; const float* MOD = WSP(float, WS_MOD);
    for (int m = gw; m < MROWS; m += NGW) { const float* md = MOD + (size_t)mod_row_of(m) * NMOD; const bf16* y = WSP(bf16, WS_Y) + (size_t)m * DM; bf16* h = WSP(bf16, WS_H) + (size_t)m * DM;
        if (m < NLAT) res_norm_row<true, true, false, false, true>(xin_row(F, m), y, WSP(bf16, WS_X1) + (size_t)m * DM, h, 0.5f, md + 2 * DM, F.in[7], F.in[6] + DM, md + 4 * DM, md + 3 * DM, F.lane);
        else res_norm_row<false, true, true>(xin_row(F, m), y, nullptr, h, 0.5f, md + 2 * DM, F.in[7], F.in[6] + DM, md + 4 * DM, md + 3 * DM, F.lane, WSP(float, WS_YCP) + (size_t)(m - NLAT) * DM); }
}
__device__ __forceinline__ void p12_resnorm(Fr& F) {
    const int gw = F.bid * NWAVES + F.wave, NGW = F.G * NWAVES; const float* MOD = WSP(float, WS_MOD);
    for (int m = gw; m < NLAT; m += NGW) { const float* md = MOD + (size_t)(m >> 13) * NMOD;
        const float rs = 1.0f / sqrtf(WSP(float, WS_ROWSS)[NLAT + m] * (1.0f / 2048.f) + EPS);
        res_norm_row<true, true, false, true, true, true>(WSP(bf16, WS_X1) + (size_t)m * DM, WSP(bf16, WS_Y) + (size_t)m * DM, WSP(bf16, WS_X1) + (size_t)m * DM, WSP(bf16, WS_H) + (size_t)m * DM, 1.0f, md + 5 * DM, F.in[7] + DM, F.in[6] + 2 * DM, md + 7 * DM, md + 6 * DM, F.lane, nullptr, rs); }
}
__device__ __forceinline__ void p15_final(Fr& F) {
    const int gw = F.bid * NWAVES + F.wave, NGW = F.G * NWAVES; const float* MOD = WSP(float, WS_MOD);
    for (int m = gw; m < NLAT; m += NGW) { const float* md = MOD + (size_t)(m >> 13) * NMOD;
        res_norm_row<true, false, false, true, false>(WSP(bf16, WS_X1) + (size_t)m * DM, WSP(bf16, WS_Y) + (size_t)m * DM, F.out + (size_t)m * DM, nullptr, 0.5f, md + 8 * DM, F.in[7] + 2 * DM, nullptr, nullptr, nullptr, F.lane); }
}
__device__ __forceinline__ void p10_merge(Fr& F) {
    const int gw = F.bid * NWAVES + F.wave, NGW = F.G * NWAVES;
    for (int m = gw; m < NLAT; m += NGW) {
        const bf16* a = WSP(bf16, WS_OATT) + (size_t)m * 2048; const bf16* s = WSP(bf16, WS_YS) + (size_t)m * 2048; bf16* h = WSP(bf16, WS_H) + (size_t)m * DM;
        u32x4 av[4], sv[4]; float sa = 0.f, ssm = 0.f;
#pragma unroll
        for (int j = 0; j < 4; ++j) { av[j] = *(const u32x4*)(a + 512 * j + 8 * F.lane); sv[j] = *(const u32x4*)(s + 512 * j + 8 * F.lane); }
#pragma unroll
        for (int j = 0; j < 4; ++j) { float f[8], q[8]; unpack8(av[j], f); unpack8(sv[j], q);
#pragma unroll
            for (int e = 0; e < 8; ++e) { sa += f[e] * f[e]; ssm += q[e] * q[e]; } }
        const float ra = 1.0f / sqrtf(wave_sum(sa) * (1.0f / 2048.f) + EPS), rs = 1.0f / sqrtf(wave_sum(ssm) * (1.0f / 2048.f) + EPS);
#pragma unroll
        for (int j = 0; j < 4; ++j) { float f[8], q[8]; unpack8(av[j], f); unpack8(sv[j], q);
            u32x4 w; w.x = pk_bf16(f[0] * ra, f[1] * ra); w.y = pk_bf16(f[2] * ra, f[3] * ra); w.z = pk_bf16(f[4] * ra, f[5] * ra); w.w = pk_bf16(f[6] * ra, f[7] * ra);
            *(u32x4*)(h + 512 * j + 8 * F.lane) = w;
            w.x = pk_bf16(q[0] * rs, q[1] * rs); w.y = pk_bf16(q[2] * rs, q[3] * rs); w.z = pk_bf16(q[4] * rs, q[5] * rs); w.w = pk_bf16(q[6] * rs, q[7] * rs);
            *(u32x4*)(h + 2048 + 512 * j + 8 * F.lane) = w; }
    }
}

__device__ __forceinline__ void p6_conv(Fr& F) {
    const int gw = F.bid * NWAVES + F.wave, NGW = F.G * NWAVES;
    const bf16* P = WSP(bf16, WS_P); bf16* XC = WSP(bf16, WS_XC); const float* cw = F.in[14]; const float* cb = F.in[15];
    u32x4 nxt[20];
#define CV_ROWS(itx) do { const int rb_ = (itx) / 6, cgi_ = (itx) - rb_ * 6, m0_ = rb_ * 16, c0_ = (cgi_ * 64 + F.lane) * 8; \
        int s0_, s1_; if (m0_ < NLAT) { s0_ = m0_ & ~(SEQ - 1); s1_ = s0_ + SEQ; } else { s0_ = NLAT + ((m0_ - NLAT) & ~(CTXL - 1)); s1_ = s0_ + CTXL; } \
        _Pragma("unroll") for (int r = 0; r < 20; ++r) { const int row = m0_ - 2 + r; const bool ok = row >= s0_ && row < s1_; const int rc = row < s0_ ? s0_ : (row >= s1_ ? s1_ - 1 : row); \
            const u32x4 v = *(const u32x4*)(P + (size_t)rc * NINP + PXBC + c0_); nxt[r] = ok ? v : (u32x4){0u, 0u, 0u, 0u}; } } while (0)
    if (gw < (MROWS / 16) * 6) CV_ROWS(gw);
    for (int it = gw; it < (MROWS / 16) * 6; it += NGW) {
        const int rb = it / 6, cgi = it - rb * 6, m0 = rb * 16, c0 = (cgi * 64 + F.lane) * 8;
        u32x4 raw[20];
#pragma unroll
        for (int r = 0; r < 20; ++r) raw[r] = nxt[r];
        if (it + NGW < (MROWS / 16) * 6) CV_ROWS(it + NGW);
        float w[5][8], bias[8];
#pragma unroll
        for (int k = 0; k < 5; ++k) { const f32x4 a = *(const f32x4*)(cw + k * XBCW + c0), b = *(const f32x4*)(cw + k * XBCW + c0 + 4);
            w[k][0] = a[0]; w[k][1] = a[1]; w[k][2] = a[2]; w[k][3] = a[3]; w[k][4] = b[0]; w[k][5] = b[1]; w[k][6] = b[2]; w[k][7] = b[3]; }
        { const f32x4 a = *(const f32x4*)(cb + c0), b = *(const f32x4*)(cb + c0 + 4); bias[0] = a[0]; bias[1] = a[1]; bias[2] = a[2]; bias[3] = a[3]; bias[4] = b[0]; bias[5] = b[1]; bias[6] = b[2]; bias[7] = b[3]; }
#pragma unroll
        for (int t = 0; t < 16; ++t) {
            float acc[8];
#pragma unroll
            for (int e = 0; e < 8; ++e) acc[e] = bias[e];
#pragma unroll
            for (int k = 0; k < 5; ++k) { float f[8]; unpack8(raw[t + k], f);
#pragma unroll
                for (int e = 0; e < 8; ++e) acc[e] += w[k][e] * f[e]; }
            u32x4 o; o.x = pk_bf16(silu_f(acc[0]), silu_f(acc[1])); o.y = pk_bf16(silu_f(acc[2]), silu_f(acc[3])); o.z = pk_bf16(silu_f(acc[4]), silu_f(acc[5])); o.w = pk_bf16(silu_f(acc[6]), silu_f(acc[7]));
            *(u32x4*)(XC + (size_t)(m0 + t) * XBCW + c0) = o;
        }
    }
#undef CV_ROWS
}

constexpr int AT_KS = 288, AT_VS = 144, AT_K_OFF = 0, AT_V_OFF = 64 * AT_KS, AT_STG = 64 * AT_KS + 128 * AT_VS;
__device__ __forceinline__ bool attn_tile(int idx, int b, int qb, int& rowbase, int& mt) {
    if (idx < 5) { const int kt = qb + idx - 2; mt = (idx == 0) ? -1 : ((idx == 4) ? 1 : 0); rowbase = b * SEQ + kt * 64; return kt >= 0 && kt < 128; }
    mt = 0; rowbase = NLAT + b * CTXL + (idx - 5) * 64; return true;
}
#ifndef AT_DEPHASE
#define AT_DEPHASE 0
#endif
template <int ABL, int ORD>
__device__ __forceinline__ void attn_unit(Fr& F, const int u, const bool doatom) {
    const bf16* P = WSP(bf16, WS_P); bf16* O = ABL ? WSP(bf16, WS_SLOC) : WSP(bf16, WS_H); float* SSA = WSP(float, WS_ROWSS);
    const int fr = F.lane & 15, g = F.lane >> 4, w = F.wave, hg = w >> 1, half = w & 1;
    const int srow = F.tid >> 3, sd0 = (F.tid & 7) * 16;
    const int vkp = F.tid >> 4, vdq = F.tid & 15;
    const int kfo = fr * AT_KS + 16 * g, vlo0 = fr * AT_VS + (4 * g) * 2, vlo1 = fr * AT_VS + ((4 * g) ^ 8) * 2;
    int vhi0 = vlo0, vhi1 = vlo1; asm volatile("" : "+v"(vhi0), "+v"(vhi1));
    {
        const int qb = u & 127, kvh = (u >> 7) & 3, b = u >> 9, head = kvh * 4 + hg;
        const int r0 = b * SEQ + qb * 64 + half * 32;
        bf16x8 qf[2][4];
#pragma unroll
        for (int m = 0; m < 2; ++m)
#pragma unroll
            for (int ks = 0; ks < 4; ++ks) qf[m][ks] = *(const bf16x8*)(P + (size_t)(r0 + 16 * m + fr) * NINP + PQ + head * 128 + 32 * ks + 8 * g);
        f32x4 accO[8][2];
#pragma unroll
        for (int n = 0; n < 8; ++n) { accO[n][0] = (f32x4){0.f, 0.f, 0.f, 0.f}; accO[n][1] = (f32x4){0.f, 0.f, 0.f, 0.f}; }
        const float sink = F.in[12][head] * LOG2E;
        float mrun[2] = {sink, sink}, lpart[2] = {g == 0 ? 1.0f : 0.0f, g == 0 ? 1.0f : 0.0f};
        int idx = 0, rowbase = 0, mt = 0;
        while (!attn_tile(idx, b, qb, rowbase, mt)) ++idx;
        int nidx = idx + 1, nrow = 0, nmt = 0;
        while (nidx < 9 && !attn_tile(nidx, b, qb, nrow, nmt)) ++nidx;
        u32x4 kr[2][2], vr[2][2];
#define AT_LOAD(rb, S_) do { const bf16* kp = P + (size_t)((rb) + srow) * NINP + PK + kvh * 128 + sd0; kr[S_][0] = *(const u32x4*)kp; kr[S_][1] = *(const u32x4*)(kp + 8); \
                         const bf16* vp = P + (size_t)((rb) + 2 * vkp) * NINP + PV + kvh * 128 + 8 * vdq; vr[S_][0] = *(const u32x4*)vp; vr[S_][1] = *(const u32x4*)(vp + NINP); } while (0)
#define AT_WRITE(st, S_) do { LAS unsigned char* kt_ = F.lds + (st) * AT_STG; LAS unsigned char* vt_ = kt_ + AT_V_OFF; \
            *(LAS u32x4*)(kt_ + srow * AT_KS + sd0 * 2) = kr[S_][0]; *(LAS u32x4*)(kt_ + srow * AT_KS + sd0 * 2 + 16) = kr[S_][1]; \
            const unsigned va_[4] = {vr[S_][0].x, vr[S_][0].y, vr[S_][0].z, vr[S_][0].w}, vb2_[4] = {vr[S_][1].x, vr[S_][1].y, vr[S_][1].z, vr[S_][1].w}; const int vsw_ = ((2 * vkp) ^ (8 * (vdq >> 1))) * 2;     \
            _Pragma("unroll") for (int j = 0; j < 4; ++j) { *(LAS unsigned*)(vt_ + (8 * vdq + 2 * j) * AT_VS + vsw_) = __builtin_amdgcn_perm(vb2_[j], va_[j], 0x05040100u); *(LAS unsigned*)(vt_ + (8 * vdq + 2 * j + 1) * AT_VS + vsw_) = __builtin_amdgcn_perm(vb2_[j], va_[j], 0x07060302u); } } while (0)
        int n2 = (nidx < 9) ? nidx + 1 : 9, n2row = 0, n2mt = 0;
        while (n2 < 9 && !attn_tile(n2, b, qb, n2row, n2mt)) ++n2;
        AT_LOAD(rowbase, 0);
        if (nidx < 9) AT_LOAD(nrow, 1);
        __syncthreads();
        AT_WRITE(0, 0);
        if (n2 < 9) AT_LOAD(n2row, 0);
        __syncthreads();
        int st = 0;
        bf16x8 pf[2][2];
        LAS unsigned char* VTp = F.lds + AT_V_OFF;
        if (ORD) {
#pragma unroll
            for (int m = 0; m < 2; ++m)
#pragma unroll
                for (int s = 0; s < 2; ++s) pf[m][s] = (bf16x8){0, 0, 0, 0, 0, 0, 0, 0}; }
        for (;;) {
#pragma unroll
          for (int par = 0; par < 2; ++par) {
            LAS unsigned char* Kt = F.lds + st * AT_STG; LAS unsigned char* VT = Kt + AT_V_OFF;
#define AT_KF(n, ks) (*(const LAS bf16x8*)(Kt + kfo + (16 * (n)) * AT_KS + (32 * (ks)) * 2))
#define AT_VF(i, dst) do { const LAS unsigned char* vb_ = VT + ((((i) & 7) & 1) ? vlo1 : vlo0) + (16 * ((i) & 7)) * AT_VS; const LAS unsigned char* vc_ = VT + ((((i) & 7) & 1) ? vhi1 : vhi0) + (16 * ((i) & 7)) * AT_VS; \
                const u32x2 v0_ = *(const LAS u32x2*)(vb_ + ((32 * ((i) >> 3)) ^ ((8 * ((i) & 7)) & 48)) * 2), v1_ = *(const LAS u32x2*)(vc_ + ((32 * ((i) >> 3) + 16) ^ ((8 * ((i) & 7)) & 48)) * 2); \
                dst = __builtin_bit_cast(bf16x8, (u32x4){v0_.x, v0_.y, v1_.x, v1_.y}); } while (0)
#define AT_QK(M0, M1) \
            f32x4 accS[4][2]; \
            _Pragma("unroll") for (int n = 0; n < 4; ++n) _Pragma("unroll") for (int m = M0; m < M1; ++m) accS[n][m] = (f32x4){0.f, 0.f, 0.f, 0.f}; \
            bf16x8 kf[2][4]; \
            _Pragma("unroll") for (int n = 0; n < 4; ++n) kf[0][n] = AT_KF(n, 0); \
            __builtin_amdgcn_s_setprio(1); \
            _Pragma("unroll") for (int ks = 0; ks < 4; ++ks) { \
                if (ks < 3) { _Pragma("unroll") for (int n = 0; n < 4; ++n) kf[(ks + 1) & 1][n] = AT_KF(n, ks + 1); } \
                __builtin_amdgcn_sched_barrier(0); \
                _Pragma("unroll") for (int n = 0; n < 4; ++n) _Pragma("unroll") for (int m = M0; m < M1; ++m) accS[n][m] = __builtin_amdgcn_mfma_f32_16x16x32_bf16(kf[ks & 1][n], qf[m][ks], accS[n][m], 0, 0, 0); \
                __builtin_amdgcn_sched_barrier(0); } \
            __builtin_amdgcn_s_setprio(0);
#define AT_VPRE() \
            if (ABL != 2) { _Pragma("unroll") for (int i = 0; i < 3; ++i) AT_VF(i, vq[i]); }     \
            __builtin_amdgcn_sched_barrier(0);
#define AT_SMX(M0, M1) \
            if (mt != 0) {   \
                _Pragma("unroll") for (int m = M0; m < M1; ++m) { const int ii = half * 32 + 16 * m + fr; \
                    _Pragma("unroll") for (int n = 0; n < 4; ++n) _Pragma("unroll") for (int r = 0; r < 4; ++r) { const int jj = 16 * n + 4 * g + r; const bool ok = (mt < 0) ? (jj >= ii) : (jj <= ii); if (!ok) accS[n][m][r] = -1e30f; } } } \
            _Pragma("unroll") for (int m = M0; m < M1; ++m) { \
                if (ABL == 0) { \
                    float mx = __builtin_fmaxf(__builtin_fmaxf(accS[0][m][0], accS[0][m][1]), __builtin_fmaxf(accS[0][m][2], accS[0][m][3])); \
                    _Pragma("unroll") for (int n = 1; n < 4; ++n) { mx = __builtin_fmaxf(__builtin_fmaxf(mx, accS[n][m][0]), accS[n][m][1]); mx = __builtin_fmaxf(__builtin_fmaxf(mx, accS[n][m][2]), accS[n][m][3]); } \
                    mx = row_max(mx); \
                    const float mn = __any(mx > mrun[m] + 8.0f) ? fmaxf(mrun[m], mx) : mrun[m];     \
                    const float alpha = __builtin_amdgcn_exp2f(mrun[m] - mn); mrun[m] = mn; \
                    f32x4 ps4 = (f32x4){0.f, 0.f, 0.f, 0.f}; \
                    _Pragma("unroll") for (int n = 0; n < 4; ++n) { const f32x4 d = accS[n][m] - mn; f32x4 pv; \
                        pv[0] = __builtin_amdgcn_exp2f(d[0]); pv[1] = __builtin_amdgcn_exp2f(d[1]); pv[2] = __builtin_amdgcn_exp2f(d[2]); pv[3] = __builtin_amdgcn_exp2f(d[3]); \
                        accS[n][m] = pv; ps4 += pv; } \
                    lpart[m] = lpart[m] * alpha + ((ps4[0] + ps4[1]) + (ps4[2] + ps4[3])); \
                    if (!__all(alpha == 1.0f)) { _Pragma("unroll") for (int n = 0; n < 8; ++n) accO[n][m] *= alpha; } \
                } \
                _Pragma("unroll") for (int s = 0; s < 2; ++s) { u32x4 t; t.x = pk_bf16(accS[2 * s][m][0], accS[2 * s][m][1]); t.y = pk_bf16(accS[2 * s][m][2], accS[2 * s][m][3]); \
                    t.z = pk_bf16(accS[2 * s + 1][m][0], accS[2 * s + 1][m][1]); t.w = pk_bf16(accS[2 * s + 1][m][2], accS[2 * s + 1][m][3]); pf[m][s] = __builtin_bit_cast(bf16x8, t); } }
#define AT_PVX(M0, M1) \
            __builtin_amdgcn_sched_barrier(0); \
            __builtin_amdgcn_s_setprio(1); \
            if (ABL != 2) { _Pragma("unroll") for (int i = 0; i < 16; ++i) { \
                if (i + 3 < 16) AT_VF(i + 3, vq[(i + 3) % 6]);     \
                __builtin_amdgcn_sched_barrier(0); \
                _Pragma("unroll") for (int m = M0; m < M1; ++m) accO[i & 7][m] = __builtin_amdgcn_mfma_f32_16x16x32_bf16(vq[i % 6], pf[m][i >> 3], accO[i & 7][m], 0, 0, 0); \
                __builtin_amdgcn_sched_barrier(0); } } \
            __builtin_amdgcn_s_setprio(0);
            bf16x8 vq[6];
            if (ORD == 0) { AT_QK(0, 2); AT_VPRE(); AT_SMX(0, 2); AT_PVX(0, 2); }
            else {
                { LAS unsigned char* VT = VTp; AT_VPRE(); AT_PVX(0, 2); }
                AT_QK(0, 2); AT_SMX(0, 2);
                VTp = VT; }
            if (nidx >= 9) goto at_done;
            const int sn = (st == 2) ? 0 : st + 1;
            AT_WRITE(sn, par ^ 1);
            int n3 = (n2 < 9) ? n2 + 1 : 9, n3row = 0, n3mt = 0;
            while (n3 < 9 && !attn_tile(n3, b, qb, n3row, n3mt)) ++n3;
            if (n3 < 9) AT_LOAD(n3row, par ^ 1);
            __syncthreads();
            st = sn; mt = nmt; nidx = n2; nmt = n2mt; n2 = n3; n2mt = n3mt;
          }
        }
        at_done:
        if (ORD) { bf16x8 vq[6]; LAS unsigned char* VT = VTp; AT_VPRE(); AT_PVX(0, 2); }
#undef AT_QK
#undef AT_VPRE
#undef AT_SMX
#undef AT_PVX
#undef AT_VF
#undef AT_KF
#undef AT_LOAD
#undef AT_WRITE
#pragma unroll
        for (int m = 0; m < 2; ++m) {
            const float l = row_sum(lpart[m]), inv = 1.0f / l;
            bf16* op = O + (size_t)(r0 + 16 * m + fr) * DM + head * 128 + 4 * g; float ss = 0.f;
#pragma unroll
            for (int n = 0; n < 8; ++n) { const f32x4 o = accO[n][m] * inv; ss += (o[0] * o[0] + o[1] * o[1]) + (o[2] * o[2] + o[3] * o[3]);
                u32x2 t; t.x = pk_bf16(o[0], o[1]); t.y = pk_bf16(o[2], o[3]); *(u32x2*)(op + 16 * n) = t; }
            ss = row_sum(ss);
            if (g == 0 && doatom) __hip_atomic_fetch_add(SSA + r0 + 16 * m + fr, ss, __ATOMIC_RELAXED, __HIP_MEMORY_SCOPE_AGENT);
        }
    }
}
template <int ABL = 0>
__device__ __forceinline__ void p6_attn(Fr& F, bool doatom = true) {
    for (int u = F.bid; u < 1024; u += F.G) { if (AT_DEPHASE && F.wave < 4) attn_unit<ABL, 1>(F, u, doatom); else attn_unit<ABL, 0>(F, u, doatom); }
    __syncthreads();
}
__device__ __forceinline__ void chunk_scan(const float* dtp  , float a, bool rev, int lane, int& t0, int& t1, float& d0, float& d1, float& c0, float& c1, float& total) {
    t0 = rev ? 127 - 2 * lane : 2 * lane; t1 = rev ? 126 - 2 * lane : 2 * lane + 1;
    d0 = dtp[(size_t)t0 * 32]; d1 = dtp[(size_t)t1 * 32];
    const float v0 = d0 * a, v1 = d1 * a; float s = v0 + v1;
#pragma unroll
    for (int o = 1; o < 64; o <<= 1) { const float t = __shfl_up(s, o); if (lane >= o) s += t; }
    const float ex = s - (v0 + v1); c0 = ex + v0; c1 = s; total = __shfl(s, 63);
}
constexpr int SS = 272;
__device__ __forceinline__ int sc_row0(int sc) { return sc < 128 ? sc * 128 : NLAT + (sc - 128) * 128; }

__device__ __forceinline__ void p7_states(Fr& F) {
    const bf16* XC = WSP(bf16, WS_XC); bf16* SL = WSP(bf16, WS_SLOC); float* DEC = WSP(float, WS_DEC);
    const int fr = F.lane & 15, g4 = F.lane >> 4, w = F.wave;
    LAS unsigned char* BT = F.lds; LAS unsigned char* XTf = F.lds + 34816; LAS unsigned char* XTb = F.lds + 52224; LAS float* WF = (LAS float*)(F.lds + 69632); LAS float* WB = WF + 8 * 128;
    const int sj = F.tid >> 2, sps = (F.tid & 3) * 16;
    for (int u = F.bid; u < 512 + 64; u += F.G) {
        const int uq = u - 512;
        const int grp = (u < 512) ? (u & 3) : ((uq >> 2) & 3), sc = (u < 512) ? (u >> 2) : (128 + (uq >> 4)), m0 = sc_row0(sc);
        const int h_lo = (u < 512) ? 0 : (uq & 3) * 2, h_hi = (u < 512) ? 8 : h_lo + 2;
        __syncthreads();
        { const int ns = (F.tid & 3) * 32; const bf16* bp = XC + (size_t)(m0 + sj) * XBCW + 2048 + grp * 128 + ns;
#pragma unroll
          for (int q = 0; q < 4; ++q) { const u32x4 v = *(const u32x4*)(bp + 8 * q); const unsigned vw[4] = {v.x, v.y, v.z, v.w};
#pragma unroll
              for (int e = 0; e < 4; ++e) { *(LAS unsigned short*)(BT + (ns + 8 * q + 2 * e) * SS + sj * 2) = (unsigned short)(vw[e] & 0xffffu); *(LAS unsigned short*)(BT + (ns + 8 * q + 2 * e + 1) * SS + sj * 2) = (unsigned short)(vw[e] >> 16); } } }
        if (w >= h_lo && w < h_hi) { const int h = grp * 8 + w;
#pragma unroll
          for (int dir = 0; dir < 2; ++dir) { const float a = -__expf(F.in[16][dir * 32 + h]); int t0, t1; float d0, d1, c0, c1, tot;
              chunk_scan(WSP(float, dir ? WS_DTB : WS_DTF) + (size_t)m0 * 32 + h, a, dir == 1, F.lane, t0, t1, d0, d1, c0, c1, tot);
              LAS float* wa = (dir ? WB : WF) + w * 128; wa[t0] = __expf(tot - c0) * d0; wa[t1] = __expf(tot - c1) * d1;
              if (F.lane == 0) DEC[(sc * 2 + dir) * 32 + h] = __expf(tot); } }
        u32x4 xr[2];
        { const bf16* xp = XC + (size_t)(m0 + sj) * XBCW + (grp * 8 + h_lo) * 64 + sps; xr[0] = *(const u32x4*)xp; xr[1] = *(const u32x4*)(xp + 8); }
        __syncthreads();
        for (int hh = h_lo; hh < h_hi; ++hh) {
            const int h = grp * 8 + hh;
            { const float wf = WF[hh * 128 + sj], wb = WB[hh * 128 + sj];
#pragma unroll
              for (int q = 0; q < 2; ++q) { float f[8]; unpack8(xr[q], f);
#pragma unroll
                  for (int e = 0; e < 8; ++e) { *(LAS unsigned short*)(XTf + (sps + 8 * q + e) * SS + sj * 2) = f2bf(f[e] * wf); *(LAS unsigned short*)(XTb + (sps + 8 * q + e) * SS + sj * 2) = f2bf(f[e] * wb); } } }
            __syncthreads();
            if (hh < h_hi - 1) { const bf16* xp = XC + (size_t)(m0 + sj) * XBCW + (h + 1) * 64 + sps; xr[0] = *(const u32x4*)xp; xr[1] = *(const u32x4*)(xp + 8); }
            const int pt = w & 3, ntb = (w >> 2) * 4;
            f32x4 aF[4], aB[4];
#pragma unroll
            for (int n = 0; n < 4; ++n) { aF[n] = (f32x4){0.f, 0.f, 0.f, 0.f}; aB[n] = (f32x4){0.f, 0.f, 0.f, 0.f}; }
#pragma unroll
            for (int ks = 0; ks < 4; ++ks) {
                const bf16x8 xf = *(const LAS bf16x8*)(XTf + (16 * pt + fr) * SS + (32 * ks + 8 * g4) * 2), xb = *(const LAS bf16x8*)(XTb + (16 * pt + fr) * SS + (32 * ks + 8 * g4) * 2);
#pragma unroll
                for (int n = 0; n < 4; ++n) { const bf16x8 bt = *(const LAS bf16x8*)(BT + (16 * (ntb + n) + fr) * SS + (32 * ks + 8 * g4) * 2);
                    aF[n] = __builtin_amdgcn_mfma_f32_16x16x32_bf16(bt, xf, aF[n], 0, 0, 0); aB[n] = __builtin_amdgcn_mfma_f32_16x16x32_bf16(bt, xb, aB[n], 0, 0, 0); }
            }
            bf16* sf = SL + ((size_t)(sc * 2 + 0) * 32 + h) * 8192 + (16 * pt + fr) * 128 + 4 * g4; bf16* sb = SL + ((size_t)(sc * 2 + 1) * 32 + h) * 8192 + (16 * pt + fr) * 128 + 4 * g4;
#pragma unroll
            for (int n = 0; n < 4; ++n) { u32x2 o; o.x = pk_bf16(aF[n][0], aF[n][1]); o.y = pk_bf16(aF[n][2], aF[n][3]); *(u32x2*)(sf + 16 * (ntb + n)) = o;
                o.x = pk_bf16(aB[n][0], aB[n][1]); o.y = pk_bf16(aB[n][2], aB[n][3]); *(u32x2*)(sb + 16 * (ntb + n)) = o; }
            __syncthreads();
        }
    }
}

__device__ __forceinline__ void p8_scan(Fr& F) {
    const bf16* SL = WSP(bf16, WS_SLOC); const float* DEC = WSP(float, WS_DEC); bf16* HIN = WSP(bf16, WS_HIN);
    for (int e = F.bid * NTHR + F.tid; e < 2 * 2 * 32 * 1024; e += F.G * NTHR) {
        const int el = (e & 1023) * 8, h = (e >> 10) & 31, dir = (e >> 15) & 1, b = e >> 16;
        const int sA = 128 + 2 * b + (dir ? 1 : 0), sB = 128 + 2 * b + (dir ? 0 : 1);
        float fa[8], fb[8], hc[8];
        unpack8(*(const u32x4*)(SL + ((size_t)(sA * 2 + dir) * 32 + h) * 8192 + el), fa); unpack8(*(const u32x4*)(SL + ((size_t)(sB * 2 + dir) * 32 + h) * 8192 + el), fb);
        const float db = DEC[(sB * 2 + dir) * 32 + h];
#pragma unroll
        for (int q = 0; q < 8; ++q) hc[q] = fb[q] + db * fa[q];
        u32x4 qs[8]; float qd[8];
#define P8_LD(cc_, slot_) do { const int c_ = dir ? 63 - (cc_) : (cc_), sc_ = b * 64 + c_; qs[slot_] = *(const u32x4*)(SL + ((size_t)(sc_ * 2 + dir) * 32 + h) * 8192 + el); qd[slot_] = DEC[(sc_ * 2 + dir) * 32 + h]; } while (0)
#pragma unroll
        for (int i = 0; i < 8; ++i) P8_LD(i, i);
        for (int cb = 0; cb < 64; cb += 8)
#pragma unroll
        for (int j = 0; j < 8; ++j) { const int cc = cb + j;
            const int c = dir ? 63 - cc : cc, sc = b * 64 + c; const size_t off = ((size_t)(sc * 2 + dir) * 32 + h) * 8192 + el;
            float s[8]; unpack8(qs[j], s); const float d = qd[j];
            if (cc + 8 < 64) P8_LD(cc + 8, j);
            u32x4 o; o.x = pk_bf16(hc[0], hc[1]); o.y = pk_bf16(hc[2], hc[3]); o.z = pk_bf16(hc[4], hc[5]); o.w = pk_bf16(hc[6], hc[7]);
            *(u32x4*)(HIN + off) = o;
#pragma unroll
            for (int q = 0; q < 8; ++q) hc[q] = d * hc[q] + s[q];
        }
#undef P8_LD
    }
}

__device__ __forceinline__ void p9_ssd_out(Fr& F, bool doatom = true) {
    const bf16* XC = WSP(bf16, WS_XC); const bf16* P = WSP(bf16, WS_P); const bf16* HIN = WSP(bf16, WS_HIN); bf16* YS = WSP(bf16, WS_H) + 2048; float* SSS = WSP(float, WS_ROWSS) + NLAT;
    const int fr = F.lane & 15, g4 = F.lane >> 4, w = F.wave;
    LAS unsigned char* Cs = F.lds; LAS unsigned char* Bm = F.lds + 34816;
    LAS unsigned char* XT = F.lds + 34816; LAS unsigned char* Hf = F.lds + 52224; LAS unsigned char* Hb = F.lds + 69632;
    LAS float* ACF = (LAS float*)(F.lds + 87040); LAS float* ACB = ACF + 1024; LAS float* DFA = ACF + 2048; LAS float* DBA = ACF + 3072;
    const int sj = F.tid >> 2, sps = (F.tid & 3) * 16, hp = F.tid >> 3, hn0 = (F.tid & 7) * 16;
    for (int u = F.bid; u < 512; u += F.G) {
        const int grp = u & 3, sc = u >> 2, m0 = sc * 128;
        __syncthreads();
        { const int ns = (F.tid & 3) * 32; const bf16* bp = XC + (size_t)(m0 + sj) * XBCW + 2048 + grp * 128 + ns; const bf16* cp = bp + 512;
#pragma unroll
          for (int q = 0; q < 4; ++q) { *(LAS u32x4*)(Bm + sj * SS + (ns + 8 * q) * 2) = *(const u32x4*)(bp + 8 * q); *(LAS u32x4*)(Cs + sj * SS + (ns + 8 * q) * 2) = *(const u32x4*)(cp + 8 * q); } }
        { const int h = grp * 8 + w;
#pragma unroll
          for (int dir = 0; dir < 2; ++dir) { const float a = -__expf(F.in[16][dir * 32 + h]); int t0, t1; float d0, d1, c0, c1, tot;
              chunk_scan(WSP(float, dir ? WS_DTB : WS_DTF) + (size_t)m0 * 32 + h, a, dir == 1, F.lane, t0, t1, d0, d1, c0, c1, tot);
              LAS float* ca = (dir ? ACB : ACF) + w * 128; LAS float* da = (dir ? DBA : DFA) + w * 128; ca[t0] = c0; ca[t1] = c1; da[t0] = d0; da[t1] = d1; } }
        __syncthreads();
        bf16x8 cfr[4]; f32x4 G[8];
#pragma unroll
        for (int ks = 0; ks < 4; ++ks) cfr[ks] = *(const LAS bf16x8*)(Cs + (16 * w + fr) * SS + (32 * ks + 8 * g4) * 2);
#pragma unroll
        for (int n = 0; n < 8; ++n) { G[n] = (f32x4){0.f, 0.f, 0.f, 0.f};
#pragma unroll
            for (int ks = 0; ks < 4; ++ks) { const bf16x8 bf = *(const LAS bf16x8*)(Bm + (16 * n + fr) * SS + (32 * ks + 8 * g4) * 2); G[n] = __builtin_amdgcn_mfma_f32_16x16x32_bf16(bf, cfr[ks], G[n], 0, 0, 0); } }
        const int i = 16 * w + fr;
        float rowss = 0.f;
        u32x4 xr[2], hfr[2], hbr[2];
        { const int h = grp * 8; const bf16* xp = XC + (size_t)(m0 + sj) * XBCW + h * 64 + sps; xr[0] = *(const u32x4*)xp; xr[1] = *(const u32x4*)(xp + 8);
          const bf16* hf = HIN + ((size_t)(sc * 2 + 0) * 32 + h) * 8192 + hp * 128 + hn0; const bf16* hb = HIN + ((size_t)(sc * 2 + 1) * 32 + h) * 8192 + hp * 128 + hn0;
          hfr[0] = *(const u32x4*)hf; hfr[1] = *(const u32x4*)(hf + 8); hbr[0] = *(const u32x4*)hb; hbr[1] = *(const u32x4*)(hb + 8); }
        u32x2 zn[4];
#define P9_ZLD(hd) do { _Pragma("unroll") for (int pt = 0; pt < 4; ++pt) zn[pt] = *(const u32x2*)(P + (size_t)(m0 + i) * NINP + PZ + (grp * 8 + (hd)) * 64 + 16 * pt + 4 * g4); } while (0)
        P9_ZLD(0);
        __syncthreads();
        for (int hh = 0; hh < 8; ++hh) {
            const int h = grp * 8 + hh;
            {
#pragma unroll
              for (int q = 0; q < 2; ++q) { const unsigned vw[4] = {xr[q].x, xr[q].y, xr[q].z, xr[q].w};
#pragma unroll
                  for (int e = 0; e < 4; ++e) { *(LAS unsigned short*)(XT + (sps + 8 * q + 2 * e) * SS + sj * 2) = (unsigned short)(vw[e] & 0xffffu); *(LAS unsigned short*)(XT + (sps + 8 * q + 2 * e + 1) * SS + sj * 2) = (unsigned short)(vw[e] >> 16); } }
              *(LAS u32x4*)(Hf + hp * SS + hn0 * 2) = hfr[0]; *(LAS u32x4*)(Hf + hp * SS + hn0 * 2 + 16) = hfr[1];
              *(LAS u32x4*)(Hb + hp * SS + hn0 * 2) = hbr[0]; *(LAS u32x4*)(Hb + hp * SS + hn0 * 2 + 16) = hbr[1]; }
            __syncthreads();
            if (hh < 7) { const bf16* xp = XC + (size_t)(m0 + sj) * XBCW + (h + 1) * 64 + sps; xr[0] = *(const u32x4*)xp; xr[1] = *(const u32x4*)(xp + 8);
                const bf16* hf = HIN + ((size_t)(sc * 2 + 0) * 32 + h + 1) * 8192 + hp * 128 + hn0; const bf16* hb = HIN + ((size_t)(sc * 2 + 1) * 32 + h + 1) * 8192 + hp * 128 + hn0;
                hfr[0] = *(const u32x4*)hf; hfr[1] = *(const u32x4*)(hf + 8); hbr[0] = *(const u32x4*)hb; hbr[1] = *(const u32x4*)(hb + 8); }
            bf16x8 xq[2], hfq[2], hbq[2];
#define P9_LD(st_) do { const int pt_ = (st_) >> 2, s_ = (st_) & 3; \
                const u32x2 v0_ = *(const LAS u32x2*)(XT + (16 * pt_ + fr) * SS + (32 * s_ + 4 * g4) * 2), v1_ = *(const LAS u32x2*)(XT + (16 * pt_ + fr) * SS + (32 * s_ + 16 + 4 * g4) * 2); \
                xq[(st_) & 1] = __builtin_bit_cast(bf16x8, (u32x4){v0_.x, v0_.y, v1_.x, v1_.y}); \
                hfq[(st_) & 1] = *(const LAS bf16x8*)(Hf + (16 * pt_ + fr) * SS + (32 * s_ + 8 * g4) * 2); hbq[(st_) & 1] = *(const LAS bf16x8*)(Hb + (16 * pt_ + fr) * SS + (32 * s_ + 8 * g4) * 2); } while (0)
            u32x2 zv[4];
#pragma unroll
            for (int pt = 0; pt < 4; ++pt) zv[pt] = zn[pt];
            if (hh < 7) P9_ZLD(hh + 1);
            const LAS float* acf = ACF + hh * 128; const LAS float* acb = ACB + hh * 128; const LAS float* dfa = DFA + hh * 128; const LAS float* dba = DBA + hh * 128;
            const float aif = acf[i], aib = acb[i];
            bf16x8 pf[4];
#pragma unroll
            for (int s = 0; s < 4; ++s) { unsigned pw[4];
#pragma unroll
                for (int t = 0; t < 2; ++t) { const int n = 2 * s + t, j0 = 16 * n + 4 * g4;
                    float gw[4];
                    if (n < w) {
                        const f32x4 cf = *(const LAS f32x4*)(acf + j0), df = *(const LAS f32x4*)(dfa + j0);
#pragma unroll
                        for (int r = 0; r < 4; ++r) gw[r] = G[n][r] * (__expf(aif - cf[r]) * df[r]);
                    } else if (n > w) {
                        const f32x4 cb = *(const LAS f32x4*)(acb + j0), db = *(const LAS f32x4*)(dba + j0);
#pragma unroll
                        for (int r = 0; r < 4; ++r) gw[r] = G[n][r] * (__expf(aib - cb[r]) * db[r]);
                    } else {
                        const f32x4 cf = *(const LAS f32x4*)(acf + j0), cb = *(const LAS f32x4*)(acb + j0), df = *(const LAS f32x4*)(dfa + j0), db = *(const LAS f32x4*)(dba + j0);
#pragma unroll
                        for (int r = 0; r < 4; ++r) { const int j = j0 + r;
                            const float wf = (j <= i) ? __expf(aif - cf[r]) * df[r] : 0.f, wb = (j >= i) ? __expf(aib - cb[r]) * db[r] : 0.f;
                            gw[r] = G[n][r] * (wf + wb); }
                    }
                    pw[2 * t] = pk_bf16(gw[0], gw[1]); pw[2 * t + 1] = pk_bf16(gw[2], gw[3]); }
                pf[s] = __builtin_bit_cast(bf16x8, (u32x4){pw[0], pw[1], pw[2], pw[3]}); }
            const float ef = __expf(aif), eb = __expf(aib), dsk = F.in[18][h];
#pragma unroll
            for (int hf2 = 0; hf2 < 2; ++hf2) {
                f32x4 aY[2], aF[2], aB[2];
#pragma unroll
                for (int q = 0; q < 2; ++q) { aY[q] = (f32x4){0.f, 0.f, 0.f, 0.f}; aF[q] = aY[q]; aB[q] = aY[q]; }
                P9_LD(8 * hf2);
                __builtin_amdgcn_s_setprio(1);
#pragma unroll
                for (int st = 8 * hf2; st < 8 * hf2 + 8; ++st) {
                    if (st + 1 < 8 * hf2 + 8) P9_LD(st + 1);
                    __builtin_amdgcn_sched_barrier(0);
                    aY[(st >> 2) & 1] = __builtin_amdgcn_mfma_f32_16x16x32_bf16(xq[st & 1], pf[st & 3], aY[(st >> 2) & 1], 0, 0, 0);
                    aF[(st >> 2) & 1] = __builtin_amdgcn_mfma_f32_16x16x32_bf16(hfq[st & 1], cfr[st & 3], aF[(st >> 2) & 1], 0, 0, 0); aB[(st >> 2) & 1] = __builtin_amdgcn_mfma_f32_16x16x32_bf16(hbq[st & 1], cfr[st & 3], aB[(st >> 2) & 1], 0, 0, 0);
                    __builtin_amdgcn_sched_barrier(0);
                }
                __builtin_amdgcn_s_setprio(0);
#pragma unroll
                for (int q = 0; q < 2; ++q) { const int pt = 2 * hf2 + q, col = h * 64 + 16 * pt + 4 * g4;
                    const LAS unsigned char* xtp = XT + (16 * pt + 4 * g4) * SS + i * 2;
                    const float x4[4] = {__uint_as_float((unsigned)*(const LAS unsigned short*)xtp << 16), __uint_as_float((unsigned)*(const LAS unsigned short*)(xtp + SS) << 16),
                                         __uint_as_float((unsigned)*(const LAS unsigned short*)(xtp + 2 * SS) << 16), __uint_as_float((unsigned)*(const LAS unsigned short*)(xtp + 3 * SS) << 16)};
                    const float z4[4] = {bf_lo(zv[pt].x), bf_hi(zv[pt].x), bf_lo(zv[pt].y), bf_hi(zv[pt].y)};
                    float y4[4];
#pragma unroll
                    for (int r = 0; r < 4; ++r) { y4[r] = (aY[q][r] + ef * aF[q][r] + eb * aB[q][r] + dsk * x4[r]) * silu_f(z4[r]); rowss += y4[r] * y4[r]; }
                    u32x2 o; o.x = pk_bf16(y4[0], y4[1]); o.y = pk_bf16(y4[2], y4[3]); *(u32x2*)(YS + (size_t)(m0 + i) * DM + col) = o; }
            }
#undef P9_LD
#undef P9_ZLD
            __syncthreads();
        }
        rowss = row_sum(rowss);
        if (g4 == 0 && doatom) __hip_atomic_fetch_add(SSS + m0 + i, rowss, __ATOMIC_RELAXED, __HIP_MEMORY_SCOPE_AGENT);
    }
}
#ifndef MK_PER_PHASE
#define MK_PER_PHASE 0
#endif
constexpr int N_PHASES = 16;
#ifndef WGM_DOWN
#define WGM_DOWN 2
#endif
#ifndef PROBE_MASK
#define PROBE_MASK 0
#endif
#define REP(k) _Pragma("unroll") for (int _rep = 0; _rep < (((PROBE_MASK >> (k)) & 1) ? 2 : 1); ++_rep)
struct Args { const float* in[21]; float* out; unsigned char* ws; int ph_lo, ph_hi, li, pad; };
__global__ void __launch_bounds__(NTHR, 2) fwd(Args args) {
    extern __shared__ __attribute__((aligned(16))) unsigned char lds_raw[];
    Fr F;
    F.lds = (LAS unsigned char*)lds_raw;
    F.tid = threadIdx.x; F.lane = F.tid & 63; F.wave = __builtin_amdgcn_readfirstlane(F.tid >> 6);
    F.G = gridDim.x; F.bid = blockIdx.x;
#pragma unroll
    for (int i = 0; i < 21; ++i) F.in[i] = args.in[i];
    F.out = args.out; F.ws = args.ws;
    volatile LAS unsigned* MISC = (volatile LAS unsigned*)(F.lds + MISC_OFF);
    if (F.tid < 32) MISC[F.tid] = 0u;
    __syncthreads();
    unsigned* ctl = (unsigned*)(F.ws + WS_CTL);
    XcdBarrier bar = xcd_barrier_post(ctl + CW_BAR + args.li * XCD_BAR_WORDS, MISC + 8);
    const int lo = args.ph_lo, hi = args.ph_hi;
#define IN(k) (lo <= (k) && (k) < hi)
#define SEAM(k) do { if (IN(k) && IN((k) + 1)) xcd_barrier(bar); } while (0)
    LAS unsigned char* ring = F.lds;

    if (IN(0)) REP(0) { p0_prologue(F, _rep); } SEAM(0);
    if (IN(1)) REP(1) { p1_norm(F); } SEAM(1);
    if (IN(2)) REP(2) {
        pg8::Gemm g{WSP(bf16, WS_H), WSP(bf16, WS_WGU0), MROWS, NGU, DM}; pg8::HalfNOrder S; S.init(MROWS, F.G, F.bid);
        pg8::EpiSwiGLU E{WSP(bf16, WS_ACT), FF};
        pg8::gemm_phase<pg8::EpiSwiGLU, pg8::HalfNOrder, true, true>(ring, g, S, E);
        if (_rep == 0) conv_queue(F, CW_Q2, CV_Q2_LO, CV_Q2_HI);
    } SEAM(2);
    if (IN(3)) REP(3) {
        pg8::Gemm g{WSP(bf16, WS_ACT), WSP(bf16, WS_WD0), MROWS, DM, FF};
        { pg8::StaticOrder S; S.init(NLAT, DM, FF, F.G, F.bid, WGM_DOWN); pg8::EpiPlain E{WSP(bf16, WS_Y), DM};
          pg8::gemm_phase<pg8::EpiPlain, pg8::StaticOrder, true, true>(ring, g, S, E); }
        { pg8::CtxSplitOrder S; S.init(F.G, F.bid); pg8::EpiSplitF32 E{WSP(float, WS_YCP), DM};
          pg8::gemm_phase<pg8::EpiSplitF32, pg8::CtxSplitOrder, true, true>(ring, g, S, E); }
    } SEAM(3);
    if (IN(4)) REP(4) { p4_resnorm(F); } SEAM(4);
    if (IN(5)) REP(5) {
        pg8::Gemm g{WSP(bf16, WS_H), WSP(bf16, WS_WIN), MROWS, NINP, DM}; pg8::InProjOrder S; S.init(F.G, F.bid);
        pg8::EpiInProj E{WSP(bf16, WS_P), NINP, WSP(float, WS_DTF), WSP(float, WS_DTB), WSP(float, WS_ROPE), WSP(float, WS_ROPE) + 4096, F.in[17], QSCALE};
        pg8::gemm_phase<pg8::EpiInProj, pg8::InProjOrder, true, true>(ring, g, S, E);
        if (_rep == 0) conv_queue(F, CW_Q5, CV_Q5_LO, CV_Q5_HI);
    } SEAM(5);
    #ifndef PROBE_ATT
#define PROBE_ATT -1
#endif
    if (IN(6)) { p6_attn<0>(F, true); if (PROBE_ATT >= 0) { p6_attn<(PROBE_ATT < 0 ? 0 : PROBE_ATT)>(F, false); } p6_conv(F); } SEAM(6);
    if (IN(7)) REP(7) { p7_states(F); } SEAM(7);
    if (IN(8)) REP(8) { p8_scan(F); } SEAM(8);
    if (IN(9)) REP(9) { p9_ssd_out(F, _rep == 0); } SEAM(9);
    if (IN(11)) REP(11) {
        pg8::Gemm g{WSP(bf16, WS_H), WSP(bf16, WS_WOUT), NLAT, DM, DM}; pg8::OutProjOrder S; S.init(F.G, F.bid);
        LAS float* qt = (LAS float*)(F.lds + RING_BYTES + 1024);
        { const float* ssa = WSP(float, WS_ROWSS); const float* sss = ssa + NLAT;
          for (int e = F.tid; e < 1024; e += NTHR) { pg8::Unit u; if (S.t.next(e >> 8, u)) { const int r = u.pm * 256 + (e & 255);
              qt[e] = sqrtf((sss[r] * (1.0f / 2048.f) + EPS) / (ssa[r] * (1.0f / 2048.f) + EPS)); } }
          __syncthreads(); }
        pg8::EpiOutProj E{WSP(bf16, WS_Y), DM, qt};
        pg8::gemm_phase<pg8::EpiOutProj, pg8::OutProjOrder, true, true, false, true>(ring, g, S, E);
#ifdef PROBE_ZEROB
        xcd_barrier(bar);
        { bf16* zb = WSP(bf16, WS_HIN);
          if (PROBE_ZEROB) { for (size_t e = (size_t)F.bid * NTHR + F.tid; e < (size_t)DM * DM / 8; e += (size_t)F.G * NTHR) ((u32x4*)zb)[e] = (u32x4){0u, 0u, 0u, 0u}; }
          xcd_barrier(bar);
          pg8::Gemm g2{WSP(bf16, WS_H), PROBE_ZEROB ? zb : WSP(bf16, WS_WOUT), NLAT, DM, DM}; pg8::StaticOrder S2; S2.init(NLAT, DM, DM, F.G, F.bid);
          pg8::EpiPlain E2{WSP(bf16, WS_SLOC), DM};
          pg8::gemm_phase<pg8::EpiPlain, pg8::StaticOrder, true, true>(ring, g2, S2, E2); }
#endif
    } SEAM(11);
    if (IN(12)) REP(12) { p12_resnorm(F); } SEAM(12);
    if (IN(13)) REP(13) {
        pg8::Gemm g{WSP(bf16, WS_H), WSP(bf16, WS_WGU1), NLAT, NGU, DM}; pg8::HalfNOrder S; S.init(NLAT, F.G, F.bid);
        pg8::EpiSwiGLU8 E{WSP(unsigned char, WS_ACT), FF};
        pg8::gemm_phase<pg8::EpiSwiGLU8, pg8::HalfNOrder, true, true>(ring, g, S, E);
        if (_rep == 0) conv_queue(F, CW_Q13, CV_Q13_LO, CV_Q13_HI);
    } SEAM(13);
    if (IN(14)) REP(14) {
        pg8::Gemm g{WSP(bf16, WS_ACT), WSP(bf16, WS_WD1), NLAT, DM, FF / 2}; pg8::StaticOrder S; S.init(NLAT, DM, FF / 2, F.G, F.bid, WGM_DOWN);
        pg8::EpiPlainS E{WSP(bf16, WS_Y), DM, 1.0f / (8.0f * 2048.0f)};
        pg8::gemm_phase<pg8::EpiPlainS, pg8::StaticOrder, true, true, true>(ring, g, S, E);
    } SEAM(14);
    if (IN(15)) REP(15) { p15_final(F); }
#undef IN
#undef SEAM
}

extern "C" void kernel_launch(void* const* d_in, const int* in_sizes, int n_in, void* d_out, int out_size, void* d_ws, size_t ws_size, hipStream_t stream) {
    static int grid = 0;
    if (grid == 0) {
        if (n_in != 21 || in_sizes[0] != NLAT * DM || out_size != NLAT * DM || ws_size < WS_END) {
            fprintf(stderr, "kernel_launch: unexpected problem (n_in %d, in0 %d, out %d, ws %zu, need %zu)\n", n_in, n_in > 0 ? in_sizes[0] : -1, out_size, ws_size, (size_t)WS_END); grid = -1; return; }
        int dev = 0, cus = 0, per_cu = 0;
        if (hipGetDevice(&dev) != hipSuccess || hipDeviceGetAttribute(&cus, hipDeviceAttributeMultiprocessorCount, dev) != hipSuccess) { grid = -1; return; }
        if (hipFuncSetAttribute((const void*)fwd, hipFuncAttributeMaxDynamicSharedMemorySize, LDS_BYTES) != hipSuccess) { fprintf(stderr, "kernel_launch: hipFuncSetAttribute failed\n"); grid = -1; return; }
        if (hipOccupancyMaxActiveBlocksPerMultiprocessor(&per_cu, (const void*)fwd, NTHR, LDS_BYTES) != hipSuccess || per_cu < 1)
            fprintf(stderr, "kernel_launch: note: occupancy query reports %d workgroups per CU\n", per_cu);
        (void)hipGetLastError();
        grid = cus;
    }
    if (grid < 0) return;
    if (hipMemsetAsync((char*)d_ws + WS_CTL, 0, ZERO_BYTES, stream) != hipSuccess) { fprintf(stderr, "kernel_launch: memset failed\n"); return; }
    Args a{};
    for (int i = 0; i < 21; ++i) a.in[i] = (const float*)d_in[i];
    a.out = (float*)d_out; a.ws = (unsigned char*)d_ws; a.pad = 0;
#if MK_PER_PHASE
    for (int ph = 0; ph < N_PHASES; ++ph) { a.ph_lo = ph; a.ph_hi = ph + 1; a.li = ph;
        hipLaunchKernelGGL(fwd, dim3(grid), dim3(NTHR), LDS_BYTES, stream, a); }
#else
    a.ph_lo = 0; a.ph_hi = N_PHASES; a.li = 0;
    hipLaunchKernelGGL(fwd, dim3(grid), dim3(NTHR), LDS_BYTES, stream, a);
#endif
    const hipError_t le = hipPeekAtLastError();
    if (le != hipSuccess) fprintf(stderr, "kernel_launch: launch failed: %s\n", hipGetErrorName(le));
}
```
